# Optimizing an MI355X kernel written in HIP

```python
import math
import jax, jax.numpy as jnp
from jax import lax
import numpy as np

D_MODEL = 1024
BATCH = 8
SEQ = 2048
DEPTH = 4
DEC_BATCH = 128
DEC_SEQ = 8
PAST_LEN = 16384
PAGE_SIZE = 128

N_EVEN = (DEPTH + 1) // 2
N_ODD = DEPTH // 2
CONV_W = 4
NORM_EPS = 1e-6
RWKV_HEADS = 8
RWKV_HD = 64
RWKV_W = RWKV_HEADS * RWKV_HD
DECAY_LORA = 64
AAA_LORA = 64
GATE_LORA = 128
RWKV_PROJ = 3 * RWKV_W + DECAY_LORA + AAA_LORA + GATE_LORA
RWKV_GN_EPS = 64e-5
GDN_HEADS = 4
GDN_HD = 128
GDN_W = GDN_HEADS * GDN_HD
GDN_QKV = 3 * GDN_W
GDN_PROJ = GDN_QKV + GDN_W + 2 * GDN_HEADS
GDN_CHUNK = 64
EVEN_PROJ = RWKV_PROJ + GDN_PROJ
MIX_W = RWKV_W + GDN_W
LRU_W = D_MODEL
LRU_HEADS = 8
LRU_BW = LRU_W // LRU_HEADS
LRU_C = 8.0
D_FF = 4 * D_MODEL

kernel_name = 'rwkv7_gdn_rglru_hybrid_step'


def rmsnorm(x, w, eps=NORM_EPS):
    xf = x.astype(jnp.float32)
    y = xf * lax.rsqrt(jnp.mean(xf * xf, -1, keepdims=True) + eps)
    return (y * w.astype(jnp.float32)).astype(x.dtype)


def l2norm(x, eps=1e-6):
    xf = x.astype(jnp.float32)
    return xf * lax.rsqrt(jnp.sum(xf * xf, -1, keepdims=True) + eps)


def causal_conv(x, buf, w):
    T = x.shape[1]
    xp = jnp.concatenate([buf.astype(x.dtype), x], axis=1)
    y = sum(w[j] * xp[:, j:j + T] for j in range(CONV_W))
    return y, xp[:, T:]


def wkv7_scan(r, w, k, v, a, b, S0):
    def step(S, inp):
        r_t, w_t, k_t, v_t, a_t, b_t = inp
        sa = jnp.einsum('bhvk,bhk->bhv', S, a_t)
        S = S * w_t[:, :, None, :] + sa[..., None] * b_t[:, :, None, :] + v_t[..., None] * k_t[:, :, None, :]
        return S, jnp.einsum('bhvk,bhk->bhv', S, r_t)
    xs = tuple(jnp.swapaxes(t, 0, 1) for t in (r, w, k, v, a, b))
    S, y = lax.scan(step, S0, xs)
    return jnp.swapaxes(y, 0, 1), S


def rwkv7_mix(p, prev, mu, w0, w2, a0, a2, g2, k_k, k_a, r_k, ln_w, ln_b, S0):
    B, T, _ = p.shape
    f32 = jnp.float32
    shifted = jnp.concatenate([prev[:, None].astype(p.dtype), p[:, :-1]], axis=1)
    xs = p + mu * (shifted - p)
    o1, o2, o3 = RWKV_W, 2 * RWKV_W, 3 * RWKV_W
    o4 = o3 + DECAY_LORA
    o5 = o4 + AAA_LORA
    r, k, v = xs[..., :o1], xs[..., o1:o2], xs[..., o2:o3]
    xw, xa, xg = xs[..., o3:o4], xs[..., o4:o5], xs[..., o5:]
    w_log = -jax.nn.softplus(-(w0 + jnp.tanh(xw) @ w2).astype(f32)) - 0.5
    decay = jnp.exp(-jnp.exp(w_log))
    a = jax.nn.sigmoid((a0 + xa @ a2).astype(f32))
    g = jax.nn.sigmoid(xg) @ g2
    heads = lambda t: t.astype(f32).reshape(B, T, RWKV_HEADS, RWKV_HD)
    hk = lambda t: t.astype(f32).reshape(RWKV_HEADS, RWKV_HD)
    r, k, v, decay, a = heads(r), heads(k), heads(v), heads(decay), heads(a)
    kk = l2norm(k * hk(k_k))
    k = k * (1.0 + (a - 1.0) * hk(k_a))
    y, S = wkv7_scan(r, decay, k, v, -kk, kk * a, S0.astype(f32))
    mean = jnp.mean(y, -1, keepdims=True)
    var = jnp.mean(jnp.square(y - mean), -1, keepdims=True)
    y = (y - mean) * lax.rsqrt(var + RWKV_GN_EPS) * hk(ln_w) + hk(ln_b)
    y = y + jnp.sum(r * k * r_k.astype(f32), -1, keepdims=True) * v
    out = y.reshape(B, T, RWKV_W).astype(p.dtype) * g
    return out, S, p[:, -1]


def gated_delta_chunked(q, k, v, g, beta, S0):
    B, T, H, _ = q.shape
    C = min(GDN_CHUNK, T)
    pad = (-T) % C
    N = (T + pad) // C

    def chunks(t):
        t = jnp.pad(t, [(0, 0), (0, pad)] + [(0, 0)] * (t.ndim - 2))
        t = t.reshape((B, N, C) + t.shape[2:])
        perm = (1, 0, 3, 2, 4) if t.ndim == 5 else (1, 0, 3, 2)
        return t.transpose(perm)

    q, k, v, g, beta = chunks(q), chunks(k), chunks(v), chunks(g), chunks(beta)
    gc = jnp.cumsum(g, axis=-1)
    kb = k * beta[..., None]
    vb = v * beta[..., None]
    idx = jnp.arange(C)
    incl = idx[:, None] >= idx[None, :]
    strict = idx[:, None] > idx[None, :]
    diff = gc[..., :, None] - gc[..., None, :]
    decay = jnp.where(incl, jnp.exp(jnp.where(incl, diff, 0.0)), 0.0)
    L = jnp.where(strict, jnp.einsum('nbhid,nbhjd->nbhij', kb, k) * decay, 0.0)
    eye = jnp.broadcast_to(jnp.eye(C, dtype=L.dtype), L.shape)
    Tinv = lax.linalg.triangular_solve(eye + L, eye, left_side=True, lower=True, unit_diagonal=True)
    u = jnp.einsum('nbhij,nbhjd->nbhid', Tinv, vb)
    w = jnp.einsum('nbhij,nbhjd->nbhid', Tinv, kb * jnp.exp(gc)[..., None])
    qk = jnp.where(incl, jnp.einsum('nbhid,nbhjd->nbhij', q, k) * decay, 0.0)

    def step(S, inp):
        q_c, k_c, u_c, w_c, qk_c, gc_c = inp
        v_new = u_c - jnp.einsum('bhck,bhkv->bhcv', w_c, S)
        o = jnp.einsum('bhck,bhkv->bhcv', q_c * jnp.exp(gc_c)[..., None], S) + jnp.einsum('bhij,bhjv->bhiv', qk_c, v_new)
        g_last = gc_c[..., -1:]
        S = S * jnp.exp(g_last)[..., None] + jnp.einsum('bhck,bhcv->bhkv', k_c * jnp.exp(g_last - gc_c)[..., None], v_new)
        return S, o

    S, o = lax.scan(step, S0, (q, k, u, w, qk, gc))
    o = o.transpose(1, 0, 3, 2, 4).reshape(B, N * C, H, -1)[:, :T]
    return o, S


def gdn_mix(p, buf, conv_w, A_log, dt_bias, norm_w, S0):
    B, T, _ = p.shape
    f32 = jnp.float32
    qkv, new_buf = causal_conv(p[..., :GDN_QKV], buf, conv_w)
    qkv = jax.nn.silu(qkv)
    z = p[..., GDN_QKV:GDN_QKV + GDN_W]
    b_raw = p[..., GDN_QKV + GDN_W:GDN_QKV + GDN_W + GDN_HEADS]
    a_raw = p[..., GDN_QKV + GDN_W + GDN_HEADS:]
    heads = lambda t: t.reshape(B, T, GDN_HEADS, GDN_HD)
    q = l2norm(heads(qkv[..., :GDN_W])) * (GDN_HD ** -0.5)
    k = l2norm(heads(qkv[..., GDN_W:2 * GDN_W]))
    v = heads(qkv[..., 2 * GDN_W:]).astype(f32)
    beta = jax.nn.sigmoid(b_raw.astype(f32))
    g = -jnp.exp(A_log.astype(f32)) * jax.nn.softplus(a_raw.astype(f32) + dt_bias.astype(f32))
    o, S = gated_delta_chunked(q, k, v, g, beta, S0.astype(f32))
    o = o * lax.rsqrt(jnp.mean(o * o, -1, keepdims=True) + NORM_EPS) * norm_w.astype(f32)
    o = o * jax.nn.silu(heads(z).astype(f32))
    return o.reshape(B, T, GDN_W).astype(p.dtype), S, new_buf


def lru_mix(xn, w_in, conv_w, conv_b, wa, ba, wi, bi, L, h0, buf):
    B, T, _ = xn.shape
    f32 = jnp.float32
    proj = xn @ w_in
    gate_branch, xb = proj[..., :LRU_W], proj[..., LRU_W:]
    xc, new_buf = causal_conv(xb, buf, conv_w)
    xc = xc + conv_b
    xh = xc.reshape(B, T, LRU_HEADS, LRU_BW)
    r = jax.nn.sigmoid((jnp.einsum('bthi,hij->bthj', xh, wa) + ba).astype(f32))
    i = jax.nn.sigmoid((jnp.einsum('bthi,hij->bthj', xh, wi) + bi).astype(f32))
    log_a = -LRU_C * r * jax.nn.softplus(-L.astype(f32))
    mult = jnp.sqrt(-jnp.expm1(2.0 * log_a))
    a = jnp.exp(log_a).reshape(B, T, LRU_W)
    bvals = (mult * i * xh.astype(f32)).reshape(B, T, LRU_W)
    bvals = bvals.at[:, 0].add(a[:, 0] * h0.astype(f32))

    def comb(c1, c2):
        a1, b1 = c1
        a2, b2 = c2
        return a1 * a2, a2 * b1 + b2

    _, h = lax.associative_scan(comb, (a, bvals), axis=1)
    y = h.astype(xn.dtype) * jax.nn.gelu(gate_branch, approximate=True)
    return y, h[:, -1], new_buf


def sq_relu_mlp(x, up, down):
    return jnp.square(jax.nn.relu(x @ up)) @ down


def setup_inputs(seed: int = 0) -> dict:
    key = jax.random.key(seed)
    ks = jax.random.split(key, 48)
    f32 = jnp.float32

    def nrm(i, shape, scale):
        return jax.random.normal(ks[i], shape, f32) * scale

    def uni(i, shape, lo, hi):
        return jax.random.uniform(ks[i], shape, f32, lo, hi)

    dt = jnp.exp(uni(26, (N_EVEN, GDN_HEADS), math.log(1e-3), math.log(1e-1)))
    a_base = uni(36, (N_ODD, LRU_HEADS, LRU_BW), 0.9, 0.999)
    s = a_base ** (1.0 / LRU_C)
    return {
        'x_prompt': nrm(0, (BATCH, SEQ, D_MODEL), 1.0),
        'x_sample': nrm(1, (DEC_BATCH, DEC_SEQ, D_MODEL), 1.0),
        'state_rwkv': nrm(2, (N_EVEN, DEC_BATCH, RWKV_HEADS, RWKV_HD, RWKV_HD), 0.3),
        'state_rwkv_shift': nrm(3, (N_EVEN, DEC_BATCH, RWKV_PROJ), 1.0),
        'state_gdn': nrm(4, (N_EVEN, DEC_BATCH, GDN_HEADS, GDN_HD, GDN_HD), 0.3),
        'state_gdn_conv': nrm(5, (N_EVEN, DEC_BATCH, CONV_W - 1, GDN_QKV), 1.0),
        'state_lru': nrm(6, (N_ODD, DEC_BATCH, LRU_W), 0.5),
        'state_lru_conv': nrm(7, (N_ODD, DEC_BATCH, CONV_W - 1, LRU_W), 1.0),
        'norm_mix': 1.0 + nrm(8, (DEPTH, D_MODEL), 0.02),
        'norm_mlp': 1.0 + nrm(9, (DEPTH, D_MODEL), 0.02),
        'norm_final': 1.0 + nrm(10, (D_MODEL,), 0.02),
        'w_in_even': nrm(11, (N_EVEN, D_MODEL, EVEN_PROJ), D_MODEL ** -0.5),
        'w_out_even': nrm(12, (N_EVEN, MIX_W, D_MODEL), MIX_W ** -0.5),
        'rwkv_mu': uni(13, (N_EVEN, RWKV_PROJ), 0.0, 1.0),
        'rwkv_w0': uni(14, (N_EVEN, RWKV_W), -6.0, 0.0),
        'rwkv_w2': nrm(15, (N_EVEN, DECAY_LORA, RWKV_W), 0.5 * DECAY_LORA ** -0.5),
        'rwkv_a0': nrm(16, (N_EVEN, RWKV_W), 0.1),
        'rwkv_a2': nrm(17, (N_EVEN, AAA_LORA, RWKV_W), 0.5 * AAA_LORA ** -0.5),
        'rwkv_g2': nrm(18, (N_EVEN, GATE_LORA, RWKV_W), GATE_LORA ** -0.5),
        'rwkv_k_k': 0.85 + nrm(19, (N_EVEN, RWKV_W), 0.05),
        'rwkv_k_a': 1.0 + nrm(20, (N_EVEN, RWKV_W), 0.05),
        'rwkv_r_k': nrm(21, (N_EVEN, RWKV_HEADS, RWKV_HD), 0.1),
        'rwkv_ln_w': 1.0 + nrm(22, (N_EVEN, RWKV_W), 0.02),
        'rwkv_ln_b': nrm(23, (N_EVEN, RWKV_W), 0.02),
        'gdn_conv_w': nrm(24, (N_EVEN, CONV_W, GDN_QKV), CONV_W ** -0.5),
        'gdn_A_log': jnp.log(uni(25, (N_EVEN, GDN_HEADS), 1.0, 16.0)),
        'gdn_dt_bias': dt + jnp.log(-jnp.expm1(-dt)),
        'gdn_norm_w': 1.0 + nrm(27, (N_EVEN, GDN_HD), 0.02),
        'w_in_odd': nrm(28, (N_ODD, D_MODEL, 2 * LRU_W), D_MODEL ** -0.5),
        'w_out_odd': nrm(29, (N_ODD, LRU_W, D_MODEL), LRU_W ** -0.5),
        'lru_conv_w': nrm(30, (N_ODD, CONV_W, LRU_W), CONV_W ** -0.5),
        'lru_conv_b': nrm(31, (N_ODD, LRU_W), 0.02),
        'lru_wa': nrm(32, (N_ODD, LRU_HEADS, LRU_BW, LRU_BW), LRU_BW ** -0.5),
        'lru_ba': nrm(33, (N_ODD, LRU_HEADS, LRU_BW), 0.1),
        'lru_wi': nrm(34, (N_ODD, LRU_HEADS, LRU_BW, LRU_BW), LRU_BW ** -0.5),
        'lru_bi': nrm(35, (N_ODD, LRU_HEADS, LRU_BW), 0.1),
        'lru_L': jnp.log(s) - jnp.log1p(-s),
        'mlp_up': nrm(37, (DEPTH, D_MODEL, D_FF), D_MODEL ** -0.5),
        'mlp_down': nrm(38, (DEPTH, D_FF, D_MODEL), D_FF ** -0.5),
    }


def reference(x_prompt, x_sample, state_rwkv, state_rwkv_shift, state_gdn, state_gdn_conv, state_lru, state_lru_conv,
              norm_mix, norm_mlp, norm_final, w_in_even, w_out_even,
              rwkv_mu, rwkv_w0, rwkv_w2, rwkv_a0, rwkv_a2, rwkv_g2, rwkv_k_k, rwkv_k_a, rwkv_r_k, rwkv_ln_w, rwkv_ln_b,
              gdn_conv_w, gdn_A_log, gdn_dt_bias, gdn_norm_w,
              w_in_odd, w_out_odd, lru_conv_w, lru_conv_b, lru_wa, lru_ba, lru_wi, lru_bi, lru_L,
              mlp_up, mlp_down):

    def trunk(x, st_rwkv, st_shift, st_gdn, st_gconv, st_lru, st_lconv):
        h = x
        n_rwkv, n_shift, n_gdn, n_gconv, n_lru, n_lconv = [], [], [], [], [], []
        for l in range(DEPTH):
            i = l // 2
            xn = rmsnorm(h, norm_mix[l])
            if l % 2 == 0:
                proj = xn @ w_in_even[i]
                ya, S_a, sh = rwkv7_mix(proj[..., :RWKV_PROJ], st_shift[i], rwkv_mu[i], rwkv_w0[i], rwkv_w2[i],
                                        rwkv_a0[i], rwkv_a2[i], rwkv_g2[i], rwkv_k_k[i], rwkv_k_a[i], rwkv_r_k[i],
                                        rwkv_ln_w[i], rwkv_ln_b[i], st_rwkv[i])
                yb, S_b, cb = gdn_mix(proj[..., RWKV_PROJ:], st_gconv[i], gdn_conv_w[i], gdn_A_log[i],
                                      gdn_dt_bias[i], gdn_norm_w[i], st_gdn[i])
                h = h + jnp.concatenate([ya, yb], axis=-1) @ w_out_even[i]
                n_rwkv.append(S_a.astype(x.dtype))
                n_shift.append(sh)
                n_gdn.append(S_b.astype(x.dtype))
                n_gconv.append(cb)
            else:
                yc, hl, cl = lru_mix(xn, w_in_odd[i], lru_conv_w[i], lru_conv_b[i], lru_wa[i], lru_ba[i],
                                     lru_wi[i], lru_bi[i], lru_L[i], st_lru[i], st_lconv[i])
                h = h + yc @ w_out_odd[i]
                n_lru.append(hl.astype(x.dtype))
                n_lconv.append(cl)
            h = h + sq_relu_mlp(rmsnorm(h, norm_mlp[l]), mlp_up[l], mlp_down[l])
        y = rmsnorm(h, norm_final)
        return (y, jnp.stack(n_rwkv), jnp.stack(n_shift), jnp.stack(n_gdn), jnp.stack(n_gconv),
                jnp.stack(n_lru), jnp.stack(n_lconv))

    Bp = x_prompt.shape[0]
    dt = x_prompt.dtype
    y_prompt, rwkv_p, shift_p, gdn_p, gconv_p, lru_p, lconv_p = trunk(
        x_prompt,
        jnp.zeros((N_EVEN, Bp, RWKV_HEADS, RWKV_HD, RWKV_HD), dt),
        jnp.zeros((N_EVEN, Bp, RWKV_PROJ), dt),
        jnp.zeros((N_EVEN, Bp, GDN_HEADS, GDN_HD, GDN_HD), dt),
        jnp.zeros((N_EVEN, Bp, CONV_W - 1, GDN_QKV), dt),
        jnp.zeros((N_ODD, Bp, LRU_W), dt),
        jnp.zeros((N_ODD, Bp, CONV_W - 1, LRU_W), dt))
    y_sample, rwkv_s, shift_s, gdn_s, gconv_s, lru_s, lconv_s = trunk(
        x_sample, state_rwkv, state_rwkv_shift, state_gdn, state_gdn_conv, state_lru, state_lru_conv)
    return (y_prompt, y_sample, rwkv_p, rwkv_s, shift_p, shift_s, gdn_p, gdn_s, gconv_p, gconv_s, lru_p, lru_s, lconv_p, lconv_s)
```

```cpp
#include <hip/hip_runtime.h>
#include <hip/hip_cooperative_groups.h>
#include <cstdio>
#include <cstdint>
namespace cg = cooperative_groups;
#define DUPMASK 0ull
#define EXTRA_SYNCS 0
namespace pg8 {
#define PG8_LAS __attribute__((address_space(3)))
typedef unsigned short bf16_t;
typedef short bf16x8 __attribute__((ext_vector_type(8)));
typedef float f32x4 __attribute__((ext_vector_type(4)));
typedef unsigned u32x4 __attribute__((ext_vector_type(4)));
constexpr int BM = 256, BK = 64, HALF = 128, HTB = HALF * BK * 2  , STAGE_BYTES = 8 * HTB, NXCD = 8, WGM = 8;

__host__ __device__ __forceinline__ int lds_byte(int r, int c) { const int st = (r >> 4) * 2 + (c >> 5), rr = r & 15, cc = c & 31, ob = rr * 64 + cc * 2; return st * 1024 + (ob ^ (((ob >> 9) & 1) << 5)); }
__host__ __device__ __forceinline__ void stage_rc(int b, int& R, int& C) { const int st = b / 1024, sb = b % 1024, swz = sb ^ (((sb >> 9) & 1) << 5); R = (st >> 1) * 16 + swz / 64; C = (st & 1) * 32 + (swz % 64) / 2; }
__host__ __device__ __forceinline__ int perm32(int rho) { const int n = rho >> 4, i = rho & 15; return 8 * (i >> 2) + 4 * n + (i & 3); }

struct Unit { int pm, pn, kofs, nt, atomic; };
struct Gemm { const bf16_t* A; const bf16_t* Bt; int M, N, K; };

struct StaticOrder {
    int nM, nN, nwg, G, c, ntK;
    __host__ __device__ void init(int M, int N, int G_, int c_, int K_) { nM = M / BM; nN = N / BM; nwg = nM * nN; G = G_; c = c_; ntK = K_ / BK; }
    __host__ __device__ bool next(int i, Unit& u) const {
        const long L = (long)i * G + c; if (L >= nwg) return false;
        int wgid = (int)L; { const int q = nwg / NXCD, r = nwg % NXCD, xcd = wgid % NXCD, off = wgid / NXCD; wgid = (xcd < r ? xcd * (q + 1) : r * (q + 1) + (xcd - r) * q) + off; }
        const int nig = WGM * nN, gid = wgid / nig, fm = gid * WGM, gsz = (nM - fm) < WGM ? (nM - fm) : WGM;
        u.pm = fm + ((wgid % nig) % gsz); u.pn = (wgid % nig) / gsz; u.kofs = 0; u.nt = ntK; u.atomic = 0; return true;
    }
    __device__ __forceinline__ void a_ready(const Unit&) const {}
    __device__ __forceinline__ void done(const Unit&) const {}
};

__device__ __forceinline__ unsigned cvt_pk_bf16(float lo, float hi) { unsigned r; asm volatile("v_cvt_pk_bf16_f32 %0, %1, %2" : "=v"(r) : "v"(lo), "v"(hi)); return r; }
typedef float f32x2 __attribute__((ext_vector_type(2)));
__device__ __forceinline__ f32x2 gelu_pk(f32x2 v) {
    const f32x2 av = __builtin_elementwise_abs(v), d = av * 0.2316418882f + 1.0f;
    f32x2 t; t.x = __builtin_amdgcn_rcpf(d.x); t.y = __builtin_amdgcn_rcpf(d.y);
    f32x2 q = t * 0.5307027145f + (-0.7265760135f); q = q * t + 0.7107068705f; q = q * t + (-0.142248368f); q = q * t + 0.127414796f; q = q * t;
    const f32x2 s = (v * v) * (-0.72134752044f);
    f32x2 e; e.x = __builtin_amdgcn_exp2f(s.x); e.y = __builtin_amdgcn_exp2f(s.y);
    const f32x2 m = v * (q * e), r = v - m;
    f32x2 o; o.x = v.x < 0.f ? m.x : r.x; o.y = v.y < 0.f ? m.y : r.y; return o;
}

template <int ACT  > struct EpiBf16 {
    static constexpr bool PERM = true, AFTER_DRAIN = false, HAS_INIT = false; static_assert(ACT == 0 || ACT == 1 || ACT == 2, "EpiBf16: ACT is 0 (none), 1 (gelu_pk) or 2 (squared relu)");
    bf16_t* O; int ldc; const float* bias; int split_cols; size_t split_stride; float scale0;
    __device__ __forceinline__ void operator()(const f32x4 (&acc)[2][2][4][2], const Unit& u, int wr, int wc, int fr, int fq) const {
        const int row0 = u.pm * BM + wr * 64 + fr; int colt = u.pn * BM; bf16_t* base = O;
        float sc = 1.f; if (split_cols) { const int t = colt / split_cols; base += (size_t)t * split_stride; colt -= t * split_cols; if (t == 0) sc = scale0; }
        const int col0 = colt + wc * 32 + 8 * fq, bcol0 = u.pn * BM + wc * 32 + 8 * fq;
        f32x4 bv[2][2];
#pragma unroll
        for (int bj = 0; bj < 2; ++bj)
#pragma unroll
            for (int n = 0; n < 2; ++n) bv[bj][n] = bias ? *(const f32x4*)(bias + bcol0 + bj * HALF + 4 * n) : (f32x4){0.f, 0.f, 0.f, 0.f};
#pragma unroll
        for (int ai = 0; ai < 2; ++ai)
#pragma unroll
            for (int m = 0; m < 4; ++m) { bf16_t* rowp = base + (size_t)(row0 + ai * HALF + m * 16) * ldc + col0;
#pragma unroll
                for (int bj = 0; bj < 2; ++bj) { f32x4 v0 = acc[ai][bj][m][0] + bv[bj][0], v1 = acc[ai][bj][m][1] + bv[bj][1];
                    if (ACT == 1) { f32x2 a = gelu_pk((f32x2){v0[0], v0[1]}), b = gelu_pk((f32x2){v0[2], v0[3]}), c = gelu_pk((f32x2){v1[0], v1[1]}), d = gelu_pk((f32x2){v1[2], v1[3]});
                        v0 = (f32x4){a.x, a.y, b.x, b.y}; v1 = (f32x4){c.x, c.y, d.x, d.y}; }
                    if (ACT == 2) {
#pragma unroll
                        for (int e = 0; e < 4; ++e) { const float p0 = v0[e] > 0.f ? v0[e] : 0.f, p1 = v1[e] > 0.f ? v1[e] : 0.f; v0[e] = p0 * p0; v1[e] = p1 * p1; } }
                    v0 = v0 * sc; v1 = v1 * sc; u32x4 w; w.x = cvt_pk_bf16(v0[0], v0[1]); w.y = cvt_pk_bf16(v0[2], v0[3]); w.z = cvt_pk_bf16(v1[0], v1[1]); w.w = cvt_pk_bf16(v1[2], v1[3]);
                    *(u32x4*)(rowp + bj * HALF) = w; } }
    }
};
template <class Epi, class Sched, bool ALIGN_EPI = false, bool SP2 = false>
__device__ __forceinline__ void gemm_phase(PG8_LAS unsigned char* lds, const Gemm g, const Sched& S, const Epi& E) {
    int tid_ = threadIdx.x; asm volatile("" : "+v"(tid_));
    const int tid = tid_, wid = __builtin_amdgcn_readfirstlane(tid >> 6), lane = tid & 63, wr = wid >> 2, wc = wid & 3, fr = lane & 15, fq = lane >> 4;
    const int K = g.K;
    unsigned voffA[2], voffB[2];
#pragma unroll
    for (int i = 0; i < 2; ++i) { int R, C; stage_rc(tid * 16 + i * 8192, R, C); const int Rb = Epi::PERM ? ((R & ~31) + perm32(R & 31)) : R;
        voffA[i] = (unsigned)(R * K + C) * 2u; voffB[i] = (unsigned)(Rb * K + C) * 2u; }
    const size_t kstep = (size_t)(BK * 2);
    const size_t hstep = (size_t)HALF * K * 2;
    const size_t tstep = 2 * hstep;
    const unsigned ldsw = (unsigned)wid * 1024u;
    const int aoff = lds_byte(wr * 64 + fr, fq * 8), boff = lds_byte(wc * 32 + fr, fq * 8);
#define PG8_SA(b, h) (((b) * 2 + (h)) * HTB)
#define PG8_SB(b, h) ((4 + (b) * 2 + (h)) * HTB)
#define PG8_STAGE(bufoff, gbase, voff) do { _Pragma("unroll") for (int _i = 0; _i < 2; ++_i) \
        __builtin_amdgcn_global_load_lds((const unsigned*)((const char*)(gbase) + (voff)[_i]), (PG8_LAS unsigned*)(lds + (bufoff) + ldsw + _i * 8192), 16, 0, 0); } while (0)
#define PG8_LDA(dst, b, h) do { _Pragma("unroll") for (int m = 0; m < 4; ++m) _Pragma("unroll") for (int k = 0; k < 2; ++k) dst[m][k] = *(const PG8_LAS bf16x8*)(lds + PG8_SA(b, h) + aoff + m * 2048 + k * 1024); } while (0)
#define PG8_LDB(dst, b, h) do { _Pragma("unroll") for (int n = 0; n < 2; ++n) _Pragma("unroll") for (int k = 0; k < 2; ++k) dst[n][k] = *(const PG8_LAS bf16x8*)(lds + PG8_SB(b, h) + boff + n * 2048 + k * 1024); } while (0)
#define PG8_MMA(ai, bj, At, Bt) do { __builtin_amdgcn_s_setprio(1); _Pragma("unroll") for (int m = 0; m < 4; ++m) _Pragma("unroll") for (int n = 0; n < 2; ++n) _Pragma("unroll") for (int k = 0; k < 2; ++k) \
        acc[ai][bj][m][n] = __builtin_amdgcn_mfma_f32_16x16x32_bf16(Bt[n][k], At[m][k], acc[ai][bj][m][n], 0, 0, 0); __builtin_amdgcn_s_setprio(0); } while (0)
#define PG8_WAIT_V(n) asm volatile("s_waitcnt vmcnt(" #n ")" ::: "memory")
#define PG8_WAIT_L(n) asm volatile("s_waitcnt lgkmcnt(" #n ")" ::: "memory")
#define PG8_BAR __builtin_amdgcn_s_barrier()
#define PG8_SCHED __builtin_amdgcn_sched_barrier(0)
    Unit cur, nxt; int ui = 0;
    if (!S.next(0, cur)) return;
    f32x4 acc[2][2][4][2];
    if constexpr (Epi::HAS_INIT) E.init(acc, cur, wr, wc, fr, fq);
    else {
#pragma unroll
    for (int a = 0; a < 2; ++a)
#pragma unroll
        for (int b = 0; b < 2; ++b)
#pragma unroll
            for (int m = 0; m < 4; ++m)
#pragma unroll
                for (int n = 0; n < 2; ++n) acc[a][b][m][n] = (f32x4){0.f, 0.f, 0.f, 0.f};
    }
    bf16x8 At[4][2], B0[2][2], B1[2][2];
    const char* cA = (const char*)g.A + (size_t)cur.pm * tstep + (size_t)cur.kofs * 2; const char* cB = (const char*)g.Bt + (size_t)cur.pn * tstep + (size_t)cur.kofs * 2;
    S.a_ready(cur);
    if constexpr (SP2) {
        PG8_STAGE(PG8_SB(0, 0), cB, voffB); PG8_STAGE(PG8_SB(0, 1), cB + hstep, voffB); PG8_STAGE(PG8_SA(0, 0), cA, voffA); PG8_STAGE(PG8_SA(0, 1), cA + hstep, voffA);
        if (wr == 1) PG8_BAR;
        PG8_WAIT_V(2); PG8_BAR;
        PG8_STAGE(PG8_SB(1, 0), cB + kstep, voffB); PG8_STAGE(PG8_SA(1, 0), cA + kstep, voffA); PG8_STAGE(PG8_SB(1, 1), cB + hstep + kstep, voffB);
        PG8_WAIT_V(6); PG8_BAR;
    } else {
        PG8_STAGE(PG8_SB(0, 0), cB, voffB); PG8_STAGE(PG8_SA(0, 0), cA, voffA); PG8_STAGE(PG8_SB(0, 1), cB + hstep, voffB); PG8_STAGE(PG8_SA(0, 1), cA + hstep, voffA);
        if (wr == 1) PG8_BAR;
        PG8_WAIT_V(4); PG8_BAR;
        PG8_STAGE(PG8_SB(1, 0), cB + kstep, voffB); PG8_STAGE(PG8_SA(1, 0), cA + kstep, voffA); PG8_STAGE(PG8_SB(1, 1), cB + hstep + kstep, voffB);
        PG8_WAIT_V(6); PG8_BAR;
    }
    for (;;) {
        const bool has_next = S.next(ui + 1, nxt);
        const char* nA = has_next ? (const char*)g.A + (size_t)nxt.pm * tstep + (size_t)nxt.kofs * 2 : cA; const char* nB = has_next ? (const char*)g.Bt + (size_t)nxt.pn * tstep + (size_t)nxt.kofs * 2 : cB;
        const int nt = cur.nt;
        for (int t = 0; t < nt; t += 2) {
            const bool last = (t == nt - 2);
            const char* a1 = cA + (size_t)(t + 1) * kstep;
            const char* a2 = last ? nA : cA + (size_t)(t + 2) * kstep; const char* b2 = last ? nB : cB + (size_t)(t + 2) * kstep;
            const char* a3 = a2 + kstep; const char* b3 = b2 + kstep;
            if (last && has_next) S.a_ready(nxt);
            if constexpr (SP2) {
            PG8_LDB(B0, 0, 0); PG8_LDB(B1, 0, 1); PG8_SCHED; PG8_LDA(At, 0, 0); PG8_STAGE(PG8_SA(1, 1), a1 + hstep, voffA);
            PG8_WAIT_V(8); PG8_WAIT_L(0); PG8_BAR; PG8_MMA(0, 0, At, B0); PG8_MMA(0, 1, At, B1); PG8_BAR; PG8_SCHED;
            PG8_LDA(At, 0, 1); PG8_STAGE(PG8_SB(0, 0), b2, voffB); PG8_STAGE(PG8_SB(0, 1), b2 + hstep, voffB); PG8_STAGE(PG8_SA(0, 0), a2, voffA);
            PG8_WAIT_V(8); PG8_WAIT_L(0); PG8_BAR; PG8_MMA(1, 0, At, B0); PG8_MMA(1, 1, At, B1); PG8_BAR; PG8_SCHED;
            PG8_LDB(B0, 1, 0); PG8_LDB(B1, 1, 1); PG8_SCHED; PG8_LDA(At, 1, 0); PG8_STAGE(PG8_SA(0, 1), a2 + hstep, voffA);
            PG8_WAIT_V(8); PG8_WAIT_L(0); PG8_BAR; PG8_MMA(0, 0, At, B0); PG8_MMA(0, 1, At, B1); PG8_BAR; PG8_SCHED;
            PG8_LDA(At, 1, 1); PG8_STAGE(PG8_SB(1, 0), b3, voffB); PG8_STAGE(PG8_SB(1, 1), b3 + hstep, voffB); PG8_STAGE(PG8_SA(1, 0), a3, voffA);
            PG8_WAIT_V(8); PG8_WAIT_L(0); PG8_BAR; PG8_MMA(1, 0, At, B0); PG8_MMA(1, 1, At, B1); PG8_BAR; PG8_SCHED;
            } else {
            PG8_LDB(B0, 0, 0); PG8_SCHED; PG8_LDA(At, 0, 0); PG8_STAGE(PG8_SA(1, 1), a1 + hstep, voffA);
            PG8_WAIT_L(8); PG8_BAR; PG8_WAIT_L(0); PG8_MMA(0, 0, At, B0); PG8_BAR; PG8_SCHED;
            PG8_LDB(B1, 0, 1); PG8_STAGE(PG8_SB(0, 0), b2, voffB);
            PG8_BAR; PG8_WAIT_L(0); PG8_MMA(0, 1, At, B1); PG8_BAR;
            PG8_LDA(At, 0, 1); PG8_STAGE(PG8_SA(0, 0), a2, voffA);
            PG8_BAR; PG8_WAIT_L(0); PG8_MMA(1, 0, At, B0); PG8_BAR; PG8_SCHED;
            PG8_STAGE(PG8_SB(0, 1), b2 + hstep, voffB);
            PG8_WAIT_V(6); PG8_BAR; PG8_MMA(1, 1, At, B1); PG8_BAR;
            PG8_LDB(B0, 1, 0); PG8_SCHED; PG8_LDA(At, 1, 0); PG8_STAGE(PG8_SA(0, 1), a2 + hstep, voffA);
            PG8_WAIT_L(8); PG8_BAR; PG8_WAIT_L(0); PG8_MMA(0, 0, At, B0); PG8_BAR; PG8_SCHED;
            PG8_LDB(B1, 1, 1); PG8_STAGE(PG8_SB(1, 0), b3, voffB);
            PG8_BAR; PG8_WAIT_L(0); PG8_MMA(0, 1, At, B1); PG8_BAR;
            PG8_LDA(At, 1, 1); PG8_STAGE(PG8_SA(1, 0), a3, voffA);
            PG8_BAR; PG8_WAIT_L(0); PG8_MMA(1, 0, At, B0); PG8_BAR; PG8_SCHED;
            PG8_STAGE(PG8_SB(1, 1), b3 + hstep, voffB);
            PG8_WAIT_V(6); PG8_BAR; PG8_MMA(1, 1, At, B1); PG8_BAR;
            }
        }
        if constexpr (ALIGN_EPI) { if (wr == 0) PG8_BAR; }
        if constexpr (!Epi::AFTER_DRAIN) { E(acc, cur, wr, wc, fr, fq); S.done(cur); }
        if (!has_next) break;
        if constexpr (Epi::HAS_INIT) E.init(acc, nxt, wr, wc, fr, fq);
        else {
#pragma unroll
        for (int a = 0; a < 2; ++a)
#pragma unroll
            for (int b = 0; b < 2; ++b)
#pragma unroll
                for (int m = 0; m < 4; ++m)
#pragma unroll
                    for (int n = 0; n < 2; ++n) acc[a][b][m][n] = (f32x4){0.f, 0.f, 0.f, 0.f};
        }
        cur = nxt; cA = nA; cB = nB; ++ui;
        if constexpr (ALIGN_EPI) { if (wr == 1) PG8_BAR; }
    }
    PG8_WAIT_V(0);
    if constexpr (!ALIGN_EPI) { if (wr == 0) PG8_BAR; }
    PG8_BAR;
    if constexpr (Epi::AFTER_DRAIN) { E.fused(acc, cur, wr, wc, fr, fq, lds, wid, lane); S.done(cur); }
#undef PG8_SA
#undef PG8_SB
#undef PG8_STAGE
#undef PG8_LDA
#undef PG8_LDB
#undef PG8_MMA
#undef PG8_WAIT_V
#undef PG8_WAIT_L
#undef PG8_BAR
#undef PG8_SCHED
}
}

#define LAS __attribute__((address_space(3)))
typedef unsigned short bf16;
typedef unsigned v4u __attribute__((ext_vector_type(4)));
typedef unsigned v2u __attribute__((ext_vector_type(2)));
typedef float f32x4 __attribute__((ext_vector_type(4)));
typedef float f32x2 __attribute__((ext_vector_type(2)));
typedef short bf16x8 __attribute__((ext_vector_type(8)));

constexpr int NWAVES = 8, NTHR = 512;
constexpr int D = 1024, MP = 16384, MS = 1024, M = MP + MS, TP = 2048, NB = 8, SB = 128, TS = 8, DEPTH = 4;
constexpr int RH = 8, RHD = 64, RW = 512, RPROJ = 1792;
constexpr int GH = 4, GHD = 128, GW = 512, GQKV = 1536, GPR = 2048;
constexpr int EPROJ = 3848, FF = 4096;
constexpr int NSEQ = NB + SB;

constexpr size_t O_Y = 0;
constexpr size_t O_RWKV_P = (size_t)M * D;
constexpr size_t O_RWKV_S = O_RWKV_P + (size_t)2 * NB * RH * 4096;
constexpr size_t O_SH_P = O_RWKV_S + (size_t)2 * SB * RH * 4096;
constexpr size_t O_SH_S = O_SH_P + (size_t)2 * NB * RPROJ;
constexpr size_t O_GDN_P = O_SH_S + (size_t)2 * SB * RPROJ;
constexpr size_t O_GDN_S = O_GDN_P + (size_t)2 * NB * GH * 16384;
constexpr size_t O_GC_P = O_GDN_S + (size_t)2 * SB * GH * 16384;
constexpr size_t O_GC_S = O_GC_P + (size_t)2 * NB * 3 * GQKV;
constexpr size_t O_LRU_P = O_GC_S + (size_t)2 * SB * 3 * GQKV;
constexpr size_t O_LRU_S = O_LRU_P + (size_t)2 * NB * D;
constexpr size_t O_LC_P = O_LRU_S + (size_t)2 * SB * D;
constexpr size_t O_LC_S = O_LC_P + (size_t)2 * NB * 3 * D;
constexpr size_t O_END = O_LC_S + (size_t)2 * SB * 3 * D;
static_assert(O_END == 47419392, "output size");

constexpr size_t MiB = 1u << 20;
constexpr size_t WS_WIN = 0, WS_WOUT = 8 * MiB, WS_WUP = 10 * MiB, WS_WDN = 18 * MiB, WS_WA = 26 * MiB, WS_WI = 26 * MiB + 512 * 1024;
constexpr size_t WS_CTL = 27 * MiB, CTL_BYTES = 16384;
constexpr size_t WS_W2T = 26 * MiB, WS_A2T = 26 * MiB + 65536, WS_G2T = 26 * MiB + 131072;
constexpr size_t WS_XN = 28 * MiB;
constexpr size_t WS_PROJ = 62 * MiB;
constexpr size_t WS_YRAW = WS_PROJ, WS_ORAW = WS_PROJ + 34 * MiB;
constexpr size_t WS_SCN = 130 * MiB;
constexpr size_t A17 = 17 * MiB;
constexpr size_t WS_RU = WS_SCN, WS_RA = WS_SCN + A17, WS_RB = WS_SCN + 2 * A17, WS_RK = WS_SCN + 3 * A17, WS_RWR = WS_SCN + 4 * A17, WS_RV = WS_SCN + 5 * A17, WS_RG = WS_SCN + 6 * A17;
constexpr size_t WS_GQ = WS_SCN + 7 * A17, WS_GK = WS_SCN + 8 * A17, WS_GV = WS_SCN + 9 * A17, WS_GZ = WS_SCN + 10 * A17;
constexpr size_t WS_RSC = WS_SCN + 11 * A17;
constexpr size_t WS_GSC = WS_RSC + 3 * MiB;
constexpr size_t WS_P8 = WS_GSC + 2 * MiB;
constexpr size_t WS_END_EVEN = WS_P8 + 1 * MiB;
constexpr size_t WS_LP = WS_SCN, WS_LH = WS_SCN + 68 * MiB, WS_LTOT = WS_SCN + 136 * MiB;
constexpr size_t WS_HID = WS_PROJ;
constexpr size_t WS_PART = 200 * MiB;
constexpr size_t WS_H = WS_END_EVEN;
constexpr size_t WS_TOTAL = WS_H + 34 * MiB;
static_assert(WS_PART >= WS_HID + (size_t)M * FF * 2 && WS_PART + 64 * MiB <= WS_TOTAL, "PART placement");
static_assert(WS_HID + (size_t)M * FF * 2 <= WS_TOTAL && WS_LTOT + 544 * 1024 * 8 <= WS_TOTAL, "ws map");

constexpr int LDS_BYTES = 147456, MISC_OFF = 131072 + 256;

struct Args { const float* in[39]; float* out; unsigned char* ws; int ph_lo, ph_hi; };

__device__ __forceinline__ float bf2f(bf16 b) { return __builtin_bit_cast(float, (unsigned)b << 16); }
__device__ __forceinline__ float bflo(unsigned w) { return __builtin_bit_cast(float, w << 16); }
__device__ __forceinline__ float bfhi(unsigned w) { return __builtin_bit_cast(float, w & 0xffff0000u); }
__device__ __forceinline__ unsigned f2bf(float f) { unsigned u = __builtin_bit_cast(unsigned, f); return (u + 0x7fffu + ((u >> 16) & 1u)) >> 16; }
__device__ __forceinline__ unsigned pk2(float lo, float hi) { return f2bf(lo) | (f2bf(hi) << 16); }
__device__ __forceinline__ float wave_sum(float v) {
#pragma unroll
    for (int o = 1; o < 64; o <<= 1) v += __shfl_xor(v, o);
    return v;
}
template <int CTRL> __device__ __forceinline__ float dppf(float x) { return __builtin_bit_cast(float, __builtin_amdgcn_update_dpp(0, __builtin_bit_cast(int, x), CTRL, 0xf, 0xf, false)); }
__device__ __forceinline__ float allsum16(float x) { x += dppf<0x128>(x); x += dppf<0x124>(x); x += dppf<0x122>(x); x += dppf<0x121>(x); return x; }
__device__ __forceinline__ float sigmoidf_(float x) { return __builtin_amdgcn_rcpf(1.0f + __expf(-x)); }
__device__ __forceinline__ float softplusf_(float x) { return fmaxf(x, 0.f) + log1pf(__expf(-fabsf(x))); }
__device__ __forceinline__ float siluf_(float x) { return x * __builtin_amdgcn_rcpf(1.0f + __expf(-x)); }
__device__ __forceinline__ float tanhf_(float x) { return 1.0f - 2.0f * __builtin_amdgcn_rcpf(1.0f + __expf(2.0f * x)); }
#define LDS_WAIT() asm volatile("s_waitcnt lgkmcnt(0)" ::: "memory")

#define XB_TMO      128
#define XB_XCNT(j)  (256  + 64 * (j))
#define XB_XSUB(j)  (1280 + 64 * (j))
#define XB_XGEN(j)  (2304 + 64 * (j))
#define XB_TOP      3328
#define XB_TOPGEN   3392
#define XCD_BAR_WORDS 3456
#define XB_SPIN_CAP (1u << 18)

__device__ __forceinline__ unsigned xb_ld(unsigned* p)              { return __hip_atomic_load(p, __ATOMIC_RELAXED, __HIP_MEMORY_SCOPE_AGENT); }
__device__ __forceinline__ unsigned xb_add(unsigned* p, unsigned v) { return __hip_atomic_fetch_add(p, v, __ATOMIC_RELAXED, __HIP_MEMORY_SCOPE_AGENT); }
__device__ __forceinline__ unsigned xb_xcc_id() { return (unsigned)__builtin_amdgcn_s_getreg((3 << 11) | 20) & 0xFu; }
#define XB_SPIN(cond, bar) do { unsigned _sp = 0; while (cond) { __builtin_amdgcn_s_sleep(1); \
    if ((++_sp & 255u) == 0u) { if (xb_ld(&(bar)[XB_TMO])) break; if (_sp > XB_SPIN_CAP) { atomicAdd(&(bar)[XB_TMO], 1u); break; } } } } while (0)

struct XcdBarrier {
    unsigned* bar; unsigned x;
    volatile LAS unsigned* st;
};

__device__ __forceinline__ XcdBarrier xcd_barrier_post(unsigned* bar, volatile LAS unsigned* st) {
    XcdBarrier b; b.bar = bar; b.x = xb_xcc_id(); b.st = st;
    if (threadIdx.x == 0) (void)xb_add(&bar[XB_XCNT(b.x)], 1u);
    return b;
}
__device__ __forceinline__ void xcd_barrier_complete(unsigned* bar, unsigned x, unsigned& nloc, unsigned& nx) {
    const unsigned G = gridDim.x * gridDim.y * gridDim.z;
    unsigned sum, cnt, mine, sp = 0u;
    for (;;) {
        sum = 0u; cnt = 0u; mine = 0u;
#pragma unroll
        for (unsigned j = 0; j < 16; ++j) { const unsigned c = xb_ld(&bar[XB_XCNT(j)]); sum += c; cnt += (c > 0u) ? 1u : 0u; mine = (j == x) ? c : mine; }
        if (sum == G) break;
        __builtin_amdgcn_s_sleep(1);
        if ((++sp & 255u) == 0u) { if (xb_ld(&bar[XB_TMO])) break; if (sp > XB_SPIN_CAP) { atomicAdd(&bar[XB_TMO], 1u); break; } }
    }
    nloc = mine > 0u ? mine : 1u; nx = cnt > 0u ? cnt : 1u;
}

__device__ __forceinline__ void xcd_barrier(const XcdBarrier& b) {
    asm volatile("s_waitcnt vmcnt(0)" ::: "memory");
    __syncthreads();
    if (threadIdx.x == 0) {
        unsigned* bar = b.bar;
        __builtin_amdgcn_s_waitcnt(0);
        unsigned nloc = b.st[0], nx = b.st[1];
        if (nloc == 0u) { xcd_barrier_complete(bar, b.x, nloc, nx); b.st[0] = nloc; b.st[1] = nx; }
        const unsigned old = xb_add(&bar[XB_XSUB(b.x)], 1u);
        const unsigned gen = old / nloc;
        if (old + 1u == (gen + 1u) * nloc) {
            __builtin_amdgcn_fence(__ATOMIC_RELEASE, "agent");
            asm volatile("s_waitcnt vmcnt(0)" ::: "memory");
            const unsigned og = xb_add(&bar[XB_TOP], 1u);
            const unsigned tg = og / nx;
            if (og + 1u == (tg + 1u) * nx) xb_add(&bar[XB_TOPGEN], 1u);
            else XB_SPIN(xb_ld(&bar[XB_TOPGEN]) == tg, bar);
            __builtin_amdgcn_fence(__ATOMIC_ACQUIRE, "agent");
            xb_add(&bar[XB_XGEN(b.x)], 1u);
            asm volatile("s_waitcnt vmcnt(0)" ::: "memory");
        } else {
            XB_SPIN(xb_ld(&bar[XB_XGEN(b.x)]) == gen, bar);
            __builtin_amdgcn_fence(__ATOMIC_ACQUIRE, "agent");
            asm volatile("s_waitcnt vmcnt(0)" ::: "memory");
        }
    }
    __syncthreads();
}

struct Ctx {
    LAS unsigned char* lds;
    const float* const* in;
    float* out; unsigned char* ws;
    int bid, G;
};
#define PHASE_IDS int tid = threadIdx.x; asm volatile("" : "+v"(tid)); const int lane = tid & 63; const int wave = __builtin_amdgcn_readfirstlane(tid >> 6); (void)lane; (void)wave;

__device__ __forceinline__ void transpose_item(const float* W, int ldw, int K, int N, bf16* WT, LAS float* scr, int item, int lane) {
    const int nblk = N / 32, kb = item / nblk, nb = item % nblk, k0 = 64 * kb, n0 = 32 * nb;
#pragma unroll 8
    for (int i = 0; i < 32; ++i) { const int kk = 2 * i + (lane >> 5); scr[kk * 33 + (lane & 31)] = W[(size_t)(k0 + kk) * ldw + n0 + (lane & 31)]; }
    LDS_WAIT(); asm volatile("" ::: "memory");
    const int c = lane & 7;
#pragma unroll
    for (int j = 0; j < 4; ++j) { const int n = (lane >> 3) + 8 * j; const LAS float* s = scr + (8 * c) * 33 + n;
        v4u o; o.x = pk2(s[0 * 33], s[1 * 33]); o.y = pk2(s[2 * 33], s[3 * 33]); o.z = pk2(s[4 * 33], s[5 * 33]); o.w = pk2(s[6 * 33], s[7 * 33]);
        *(v4u*)(WT + (size_t)(n0 + n) * K + k0 + 8 * c) = o; }
    LDS_WAIT(); asm volatile("" ::: "memory");
}

__device__ __forceinline__ void phase_convert(Ctx& C, int l) {
    PHASE_IDS
    const int i = l >> 1; const bool even = (l & 1) == 0;
    LAS float* scr = (LAS float*)(C.lds + wave * 8448);
    const int gw = C.bid * NWAVES + wave, NGW = C.G * NWAVES;
    bf16* WIN = (bf16*)(C.ws + WS_WIN); bf16* WOUT = (bf16*)(C.ws + WS_WOUT); bf16* WUP = (bf16*)(C.ws + WS_WUP); bf16* WDN = (bf16*)(C.ws + WS_WDN);
    const float* up = C.in[37] + (size_t)l * D * FF; const float* dn = C.in[38] + (size_t)l * FF * D;
    const int NIN = even ? 3840 : 2048, LDIN = even ? EPROJ : 2048;
    const float* win = even ? C.in[11] + (size_t)i * D * EPROJ : C.in[28] + (size_t)i * D * 2048;
    const float* wout = even ? C.in[12] + (size_t)i * D * D : C.in[29] + (size_t)i * D * D;
    const int I_IN = (D / 64) * (NIN / 32), I_OUT = (D / 64) * (D / 32), I_UP = (D / 64) * (FF / 32), I_DN = (FF / 64) * (D / 32), I_G = even ? 0 : 8 * 8, I_L = even ? 16 : 0;
    const int NITEMS = I_IN + I_OUT + I_UP + I_DN + 2 * I_G + 4 * I_L;
    for (int it = gw; it < NITEMS; it += NGW) {
        int r = it;
        if (r < I_IN) { transpose_item(win, LDIN, D, NIN, WIN, scr, r, lane); continue; } r -= I_IN;
        if (r < I_OUT) { transpose_item(wout, D, D, D, WOUT, scr, r, lane); continue; } r -= I_OUT;
        if (r < I_UP) { transpose_item(up, FF, D, FF, WUP, scr, r, lane); continue; } r -= I_UP;
        if (r < I_DN) { transpose_item(dn, D, FF, D, WDN, scr, r, lane); continue; } r -= I_DN;
        if (even) {
            if (r < I_L) { transpose_item(C.in[15] + (size_t)i * 64 * RW, RW, 64, RW, (bf16*)(C.ws + WS_W2T), scr, r, lane); continue; } r -= I_L;
            if (r < I_L) { transpose_item(C.in[17] + (size_t)i * 64 * RW, RW, 64, RW, (bf16*)(C.ws + WS_A2T), scr, r, lane); continue; } r -= I_L;
            transpose_item(C.in[18] + (size_t)i * 128 * RW, RW, 128, RW, (bf16*)(C.ws + WS_G2T), scr, r, lane); continue;
        }
        if (r < I_G) { const int h = r >> 3; transpose_item(C.in[32] + (size_t)(i * 8 + h) * 16384, 128, 128, 128, (bf16*)(C.ws + WS_WA) + h * 16384, scr, r & 7, lane); continue; } r -= I_G;
        { const int h = r >> 3; transpose_item(C.in[34] + (size_t)(i * 8 + h) * 16384, 128, 128, 128, (bf16*)(C.ws + WS_WI) + h * 16384, scr, r & 7, lane); }
    }
}

template <bool FIRST, bool P8>
__device__ __forceinline__ void phase_norm(Ctx& C, const float* nw, const float* w8src  , int ld8, int npart) {
    PHASE_IDS
    LAS float* w8 = (LAS float*)(C.lds + 96 * 1024);
    if (P8) {
        for (int idx = tid; idx < 8192; idx += NTHR) w8[idx] = w8src[(size_t)(idx >> 3) * ld8 + (idx & 7)];
        __syncthreads();
    }
    const int gw = C.bid * NWAVES + wave, NGW = C.G * NWAVES;
    bf16* XN = (bf16*)(C.ws + WS_XN); float* P8o = (float*)(C.ws + WS_P8);
    f32x4 wv[4];
#pragma unroll
    for (int j = 0; j < 4; ++j) wv[j] = *(const f32x4*)(nw + 4 * lane + 256 * j);
    for (int m = gw; m < M; m += NGW) {
        bf16* hrow = (bf16*)(C.ws + WS_H) + (size_t)m * D + 4 * lane;
        f32x4 v[4]; float ss = 0.f;
        if (FIRST) { const float* src = (m < MP ? C.in[0] + (size_t)m * D : C.in[1] + (size_t)(m - MP) * D);
#pragma unroll
            for (int j = 0; j < 4; ++j) v[j] = *(const f32x4*)(src + 4 * lane + 256 * j); }
        else {
#pragma unroll
            for (int j = 0; j < 4; ++j) { const v2u hw = *(const v2u*)(hrow + 256 * j); v[j] = (f32x4){bflo(hw.x), bfhi(hw.x), bflo(hw.y), bfhi(hw.y)}; } }
        if (!FIRST && m >= MP && npart > 0) {
            const bf16* pp = (const bf16*)(C.ws + WS_PART) + (size_t)(m - MP) * D + 4 * lane;
            for (int ks = 0; ks < npart; ++ks) {
#pragma unroll
                for (int j = 0; j < 4; ++j) { const v2u pw = *(const v2u*)(pp + (size_t)ks * MS * D + 256 * j); v[j] += (f32x4){bflo(pw.x), bfhi(pw.x), bflo(pw.y), bfhi(pw.y)}; } }
#pragma unroll
            for (int j = 0; j < 4; ++j) { v2u hw; hw.x = pk2(v[j].x, v[j].y); hw.y = pk2(v[j].z, v[j].w); *(v2u*)(hrow + 256 * j) = hw; }
        }
#pragma unroll
        for (int j = 0; j < 4; ++j) ss += (v[j].x * v[j].x + v[j].y * v[j].y) + (v[j].z * v[j].z + v[j].w * v[j].w);
        if (FIRST && m >= MP) {
#pragma unroll
            for (int j = 0; j < 4; ++j) { v2u hw; hw.x = pk2(v[j].x, v[j].y); hw.y = pk2(v[j].z, v[j].w); *(v2u*)(hrow + 256 * j) = hw; }
        }
        const float rs = rsqrtf(wave_sum(ss) * (1.f / D) + 1e-6f);
        float d8[8];
#pragma unroll
        for (int q = 0; q < 8; ++q) d8[q] = 0.f;
#pragma unroll
        for (int j = 0; j < 4; ++j) {
            v[j] = v[j] * rs * wv[j];
            v2u o; o.x = pk2(v[j].x, v[j].y); o.y = pk2(v[j].z, v[j].w);
            *(v2u*)(XN + (size_t)m * D + 4 * lane + 256 * j) = o;
            if (P8) {
#pragma unroll
                for (int e = 0; e < 4; ++e) { const int k = 4 * lane + 256 * j + e; const f32x4 a = *(const LAS f32x4*)(w8 + k * 8), b = *(const LAS f32x4*)(w8 + k * 8 + 4); const float x = v[j][e];
                    d8[0] += x * a.x; d8[1] += x * a.y; d8[2] += x * a.z; d8[3] += x * a.w; d8[4] += x * b.x; d8[5] += x * b.y; d8[6] += x * b.z; d8[7] += x * b.w; }
            }
        }
        if (P8) {
#pragma unroll
            for (int q = 0; q < 8; ++q) d8[q] = wave_sum(d8[q]);
            if (lane == 0) { *(f32x4*)(P8o + (size_t)m * 8) = (f32x4){d8[0], d8[1], d8[2], d8[3]}; *(f32x4*)(P8o + (size_t)m * 8 + 4) = (f32x4){d8[4], d8[5], d8[6], d8[7]}; }
        }
    }
}

__device__ __forceinline__ void phase_final(Ctx& C) {
    PHASE_IDS
    const int gw = C.bid * NWAVES + wave, NGW = C.G * NWAVES; const float* nw = C.in[10];
    f32x4 wv[4];
#pragma unroll
    for (int j = 0; j < 4; ++j) wv[j] = *(const f32x4*)(nw + 4 * lane + 256 * j);
    for (int m = gw; m < M; m += NGW) {
        float* row = C.out + (size_t)m * D; f32x4 v[4]; float ss = 0.f; const bf16* hrow = (const bf16*)(C.ws + WS_H) + (size_t)m * D + 4 * lane;
#pragma unroll
        for (int j = 0; j < 4; ++j) { const v2u hw = *(const v2u*)(hrow + 256 * j); v[j] = (f32x4){bflo(hw.x), bfhi(hw.x), bflo(hw.y), bfhi(hw.y)}; }
        if (m >= MP) { const bf16* pp = (const bf16*)(C.ws + WS_PART) + (size_t)(m - MP) * D + 4 * lane;
            for (int ks = 0; ks < 16; ++ks) {
#pragma unroll
                for (int j = 0; j < 4; ++j) { const v2u pw = *(const v2u*)(pp + (size_t)ks * MS * D + 256 * j); v[j] += (f32x4){bflo(pw.x), bfhi(pw.x), bflo(pw.y), bfhi(pw.y)}; } } }
#pragma unroll
        for (int j = 0; j < 4; ++j) ss += (v[j].x * v[j].x + v[j].y * v[j].y) + (v[j].z * v[j].z + v[j].w * v[j].w);
        const float rs = rsqrtf(wave_sum(ss) * (1.f / D) + 1e-6f);
#pragma unroll
        for (int j = 0; j < 4; ++j) *(f32x4*)(row + 4 * lane + 256 * j) = v[j] * rs * wv[j];
    }
}

struct EpiRes {
    static constexpr bool PERM = false, AFTER_DRAIN = false, HAS_INIT = true;
    bf16* H; bf16* PART; const float* Hin;
    __device__ __forceinline__ void init(pg8::f32x4 (&acc)[2][2][4][2], const pg8::Unit& u, int wr, int wc, int fr, int fq) const {
        const size_t uo = (size_t)(u.pm * 256 + wr * 64) * D + u.pn * 256 + wc * 32;
        const float* ub = Hin + uo; const bf16* ubh = H + uo;
        const int loff = fr * D + 4 * fq;
#pragma unroll
        for (int ai = 0; ai < 2; ++ai)
#pragma unroll
            for (int m = 0; m < 4; ++m) { const float* rowp = ub + (size_t)(ai * 128 + m * 16) * D; const bf16* rowh = ubh + (size_t)(ai * 128 + m * 16) * D;
#pragma unroll
                for (int bj = 0; bj < 2; ++bj)
#pragma unroll
                    for (int n = 0; n < 2; ++n) { if (u.atomic) acc[ai][bj][m][n] = (pg8::f32x4){0.f, 0.f, 0.f, 0.f}; else if (Hin) { const f32x4 o = *(const f32x4*)(rowp + loff + bj * 128 + n * 16); acc[ai][bj][m][n] = (pg8::f32x4){o.x, o.y, o.z, o.w}; }
                        else { const v2u hw = *(const v2u*)(rowh + loff + bj * 128 + n * 16); acc[ai][bj][m][n] = (pg8::f32x4){bflo(hw.x), bfhi(hw.x), bflo(hw.y), bfhi(hw.y)}; } } }
    }
    __device__ __forceinline__ void operator()(const pg8::f32x4 (&acc)[2][2][4][2], const pg8::Unit& u, int wr, int wc, int fr, int fq) const {
        const int row0 = u.pm * 256 + wr * 64 + fr, col0 = u.pn * 256 + wc * 32 + 4 * fq;
#pragma unroll
        for (int ai = 0; ai < 2; ++ai)
#pragma unroll
            for (int m = 0; m < 4; ++m) { const size_t ro = (size_t)(row0 + ai * 128 + m * 16) * D + col0;
#pragma unroll
                for (int bj = 0; bj < 2; ++bj)
#pragma unroll
                    for (int n = 0; n < 2; ++n) { const size_t eo = ro + bj * 128 + n * 16; const pg8::f32x4 a = acc[ai][bj][m][n]; v2u pw; pw.x = pk2(a[0], a[1]); pw.y = pk2(a[2], a[3]);
                        if (u.atomic) { *(v2u*)(PART + ((size_t)(u.atomic - 1) * MS * D) + eo - (size_t)MP * D) = pw; }
                        else { *(v2u*)(H + eo) = pw; } } }
    }
};

struct SplitOrder {
    pg8::StaticOrder base; int nsplit, K, c;
    __device__ void init(int N, int G_, int c_, int K_, int nsplit_) { base.init(MP, N, G_, c_, K_); nsplit = nsplit_; K = K_; c = c_; }
    __device__ bool next(int i, pg8::Unit& u) const {
        if (i == 0) return base.next(0, u);
        if (i == 1 && c < 16 * nsplit) { const int tile = c / nsplit, ks = c - tile * nsplit; u.pm = 64 + (tile >> 2); u.pn = tile & 3; u.kofs = ks * (K / nsplit); u.nt = K / nsplit / 64; u.atomic = ks + 1; return true; }
        return false;
    }
    __device__ __forceinline__ void a_ready(const pg8::Unit&) const {}
    __device__ __forceinline__ void done(const pg8::Unit&) const {}
};
__device__ __forceinline__ void run_gemm_res(Ctx& C, const bf16* A, const bf16* Bt, int K, int nsplit, const float* hin) {
    pg8::Gemm g{A, Bt, M, D, K}; SplitOrder S; S.init(D, C.G, C.bid, K, nsplit); EpiRes E{(bf16*)(C.ws + WS_H), (bf16*)(C.ws + WS_PART), hin};
    pg8::gemm_phase<EpiRes, SplitOrder, true, true>(C.lds, g, S, E);
}
struct ProjAOrder {
    pg8::StaticOrder base; int G, c;
    __device__ void init(int G_, int c_) { base.init(M, RPROJ, G_, c_, D); G = G_; c = c_; }
    __device__ bool next(int i, pg8::Unit& u) const {
        if (base.next(i, u)) return true;
        const int L = i * G + c;
        if (L < 476 + 32) { const int idx = L - 476; u.pm = 64 + (idx >> 3); u.pn = 7 + (idx & 7); u.kofs = 0; u.nt = D / 64; u.atomic = 0; return true; }
        return false;
    }
    __device__ __forceinline__ void a_ready(const pg8::Unit&) const {}
    __device__ __forceinline__ void done(const pg8::Unit&) const {}
};
struct EpiProjA {
    static constexpr bool PERM = true, AFTER_DRAIN = false, HAS_INIT = false;
    pg8::bf16_t* O;
    __device__ __forceinline__ void operator()(const pg8::f32x4 (&acc)[2][2][4][2], const pg8::Unit& u, int wr, int wc, int fr, int fq) const {
        const int gt = __builtin_amdgcn_readfirstlane(u.pn >= 7 ? 1 : 0); const int ldc = RPROJ + gt * 256; const int colt = (u.pn - 7 * gt) * 256;
        const int row0 = u.pm * 256 + wr * 64 + fr, col0 = colt + wc * 32 + 8 * fq;
#pragma unroll
        for (int ai = 0; ai < 2; ++ai)
#pragma unroll
            for (int m = 0; m < 4; ++m) { pg8::bf16_t* rowp = O + (size_t)(row0 + ai * 128 + m * 16) * ldc + col0;
#pragma unroll
                for (int bj = 0; bj < 2; ++bj) { const pg8::f32x4 v0 = acc[ai][bj][m][0], v1 = acc[ai][bj][m][1];
                    pg8::u32x4 w; w.x = pg8::cvt_pk_bf16(v0[0], v0[1]); w.y = pg8::cvt_pk_bf16(v0[2], v0[3]); w.z = pg8::cvt_pk_bf16(v1[0], v1[1]); w.w = pg8::cvt_pk_bf16(v1[2], v1[3]);
                    *(pg8::u32x4*)(rowp + bj * 128) = w; } }
    }
};
template <class Epi>
__device__ __forceinline__ void run_gemm(Ctx& C, const bf16* A, const bf16* Bt, int N, int K, const Epi& E) {
    pg8::Gemm g{A, Bt, M, N, K}; pg8::StaticOrder S; S.init(M, N, C.G, C.bid, K);
    pg8::gemm_phase<Epi, pg8::StaticOrder, true, true>(C.lds, g, S, E);
}

constexpr int RP_TILE = 0, RP_SH = 61440, RP_LIN = 76800, RP_LINS = 264, RP_CST = 86016;
__device__ __forceinline__ void phase_rwkv_prep(Ctx& C, int i) {
    PHASE_IDS
    LAS bf16* TILE = (LAS bf16*)(C.lds + RP_TILE); LAS float* SH = (LAS float*)(C.lds + RP_SH); LAS bf16* LIN = (LAS bf16*)(C.lds + RP_LIN);
    const bf16* PR = (const bf16*)(C.ws + WS_PROJ);
    bf16* RU = (bf16*)(C.ws + WS_RU); bf16* RA = (bf16*)(C.ws + WS_RA); bf16* RB = (bf16*)(C.ws + WS_RB); bf16* RK = (bf16*)(C.ws + WS_RK);
    bf16* RWR = (bf16*)(C.ws + WS_RWR); bf16* RV = (bf16*)(C.ws + WS_RV); bf16* RG = (bf16*)(C.ws + WS_RG); float* RSC = (float*)(C.ws + WS_RSC);
    const bf16* W2T = (const bf16*)(C.ws + WS_W2T); const bf16* A2T = (const bf16*)(C.ws + WS_A2T); const bf16* G2T = (const bf16*)(C.ws + WS_G2T);
    const float* mu = C.in[13] + (size_t)i * RPROJ; const float* w0 = C.in[14] + i * RW; const float* a0 = C.in[16] + i * RW;
    const float* k_k = C.in[19] + i * RW; const float* k_a = C.in[20] + i * RW; const float* r_k = C.in[21] + i * RW;
    const int fr = lane & 15, fq = lane >> 4, h = wave;
    LAS float* CST = (LAS float*)(C.lds + RP_CST);
    { const int c = tid; CST[c] = mu[c]; CST[512 + c] = mu[512 + c]; CST[1024 + c] = mu[1024 + c]; CST[1536 + c] = w0[c]; CST[2048 + c] = a0[c]; CST[2560 + c] = k_k[c]; CST[3072 + c] = k_a[c]; CST[3584 + c] = r_k[c]; }
    const int lcol = tid & 255, ltg = tid >> 8; const float mul_ = mu[1536 + lcol];
    for (int tile = C.bid; tile < M / 16; tile += C.G) {
        const int m0 = tile * 16; const bool prompt = m0 < MP; const int sb = (m0 - MP) >> 3;
        const bool pfirst = prompt && ((m0 & (TP - 1)) == 0);
#pragma unroll
        for (int q = 0; q < 8; ++q) { const int id = tid + 512 * q;
            if (id < 17 * 224) { const int r = id / 224, ch = id - r * 224; v4u v = {0u, 0u, 0u, 0u};
                if (r > 0 || (prompt && !pfirst)) v = *(const v4u*)(PR + (size_t)(m0 - 1 + r) * RPROJ + ch * 8);
                *(LAS v4u*)(TILE + r * RPROJ + ch * 8) = v; } }
        if (!prompt) { const float* sh = C.in[3] + ((size_t)i * SB + sb) * RPROJ;
#pragma unroll
            for (int q = 0; q < 7; ++q) SH[tid + 512 * q] = sh[tid + 512 * q]; }
        __syncthreads();
        bf16x8 Bw[4][2], Ba[4][2];
#pragma unroll
        for (int nt = 0; nt < 4; ++nt) { const int n = h * 64 + fr * 4 + nt;
#pragma unroll
            for (int ks = 0; ks < 2; ++ks) { Bw[nt][ks] = *(const bf16x8*)(W2T + n * 64 + ks * 32 + fq * 8); Ba[nt][ks] = *(const bf16x8*)(A2T + n * 64 + ks * 32 + fq * 8); } }
#pragma unroll
        for (int t8 = 0; t8 < 8; ++t8) { const int t = ltg * 8 + t8;
            const float p = bf2f(TILE[(t + 1) * RPROJ + 1536 + lcol]);
            const float pv = (!prompt && t8 == 0) ? SH[ltg * RPROJ + 1536 + lcol] : bf2f(TILE[t * RPROJ + 1536 + lcol]);
            const float xs = p + mul_ * (pv - p);
            LIN[t * RP_LINS + lcol] = (bf16)f2bf((lcol < 64) ? tanhf_(xs) : ((lcol < 128) ? xs : sigmoidf_(xs))); }
        __syncthreads();
        pg8::f32x4 aw[4], aa[4], ag[4];
        {
            bf16x8 ax[4];
#pragma unroll
            for (int ks = 0; ks < 4; ++ks) ax[ks] = *(const LAS bf16x8*)(LIN + fr * RP_LINS + ks * 32 + fq * 8);
#pragma unroll
            for (int nt = 0; nt < 4; ++nt) {
                pg8::f32x4 z = {0.f, 0.f, 0.f, 0.f};
                aw[nt] = __builtin_amdgcn_mfma_f32_16x16x32_bf16(ax[0], Bw[nt][0], z, 0, 0, 0); aw[nt] = __builtin_amdgcn_mfma_f32_16x16x32_bf16(ax[1], Bw[nt][1], aw[nt], 0, 0, 0);
                aa[nt] = __builtin_amdgcn_mfma_f32_16x16x32_bf16(ax[2], Ba[nt][0], z, 0, 0, 0); aa[nt] = __builtin_amdgcn_mfma_f32_16x16x32_bf16(ax[3], Ba[nt][1], aa[nt], 0, 0, 0);
            }
        }
        asm volatile("" ::: "memory");
        {
            bf16x8 ax[4];
#pragma unroll
            for (int ks = 0; ks < 4; ++ks) ax[ks] = *(const LAS bf16x8*)(LIN + fr * RP_LINS + 128 + ks * 32 + fq * 8);
#pragma unroll
            for (int nt = 0; nt < 4; ++nt) { const int n = h * 64 + fr * 4 + nt;
                bf16x8 Bg[4];
#pragma unroll
                for (int ks = 0; ks < 4; ++ks) Bg[ks] = *(const bf16x8*)(G2T + n * 128 + ks * 32 + fq * 8);
                pg8::f32x4 z = {0.f, 0.f, 0.f, 0.f};
                ag[nt] = __builtin_amdgcn_mfma_f32_16x16x32_bf16(ax[0], Bg[0], z, 0, 0, 0);
#pragma unroll
                for (int ks = 1; ks < 4; ++ks) ag[nt] = __builtin_amdgcn_mfma_f32_16x16x32_bf16(ax[ks], Bg[ks], ag[nt], 0, 0, 0);
            }
        }
        asm volatile("" ::: "memory");
        const int c0 = h * 64 + fr * 4;
#define LD4(dst, p) do { const v2u w_ = *(const LAS v2u*)(p); dst[0] = bflo(w_.x); dst[1] = bfhi(w_.x); dst[2] = bflo(w_.y); dst[3] = bfhi(w_.y); } while (0)
#define LDF4(dst, p) do { const f32x4 w_ = *(const LAS f32x4*)(p); dst[0] = w_.x; dst[1] = w_.y; dst[2] = w_.z; dst[3] = w_.w; } while (0)
#pragma unroll
        for (int j = 0; j < 4; ++j) {
            const int tk = fq * 4 + j; const size_t m = (size_t)(m0 + tk);
            const bool sfirst = !prompt && ((tk & 7) == 0);
            float r4[4], k4[4], v4[4], pr[4], pk[4], pv[4], cm[4];
            LD4(r4, TILE + (tk + 1) * RPROJ + c0); LD4(k4, TILE + (tk + 1) * RPROJ + 512 + c0); LD4(v4, TILE + (tk + 1) * RPROJ + 1024 + c0);
            if (sfirst) { LDF4(pr, SH + (tk >> 3) * RPROJ + c0); LDF4(pk, SH + (tk >> 3) * RPROJ + 512 + c0); LDF4(pv, SH + (tk >> 3) * RPROJ + 1024 + c0); }
            else { LD4(pr, TILE + tk * RPROJ + c0); LD4(pk, TILE + tk * RPROJ + 512 + c0); LD4(pv, TILE + tk * RPROJ + 1024 + c0); }
            float xr[4], xk[4], xv[4], av[4], k2[4], krw[4]; float ssq = 0.f;
            LDF4(cm, CST + c0);
#pragma unroll
            for (int nt = 0; nt < 4; ++nt) xr[nt] = r4[nt] + cm[nt] * (pr[nt] - r4[nt]);
            LDF4(cm, CST + 512 + c0);
#pragma unroll
            for (int nt = 0; nt < 4; ++nt) xk[nt] = k4[nt] + cm[nt] * (pk[nt] - k4[nt]);
            LDF4(cm, CST + 1024 + c0);
#pragma unroll
            for (int nt = 0; nt < 4; ++nt) xv[nt] = v4[nt] + cm[nt] * (pv[nt] - v4[nt]);
            LDF4(cm, CST + 2560 + c0);
#pragma unroll
            for (int nt = 0; nt < 4; ++nt) { krw[nt] = xk[nt] * cm[nt]; ssq += krw[nt] * krw[nt]; }
            LDF4(cm, CST + 2048 + c0);
#pragma unroll
            for (int nt = 0; nt < 4; ++nt) av[nt] = sigmoidf_(cm[nt] + aa[nt][j]);
            LDF4(cm, CST + 3072 + c0);
#pragma unroll
            for (int nt = 0; nt < 4; ++nt) k2[nt] = xk[nt] * (1.0f + (av[nt] - 1.0f) * cm[nt]);
            ssq = allsum16(ssq);
            const float rn = rsqrtf(ssq + 1e-6f);
            float br = 0.f, kr = 0.f, rk = 0.f, w0v[4], rkv[4];
            LDF4(w0v, CST + 1536 + c0); LDF4(rkv, CST + 3584 + c0);
            float ou[4], oa[4], ob[4], ok[4], ow[4], og[4];
#pragma unroll
            for (int nt = 0; nt < 4; ++nt) {
                const float kk = krw[nt] * rn, bb = kk * av[nt], r = xr[nt];
                const float ew = 0.6065306597126334f * sigmoidf_(w0v[nt] + aw[nt][j]); const float dec = __expf(-ew);
                ob[nt] = bf2f((bf16)f2bf(bb)); ok[nt] = bf2f((bf16)f2bf(k2[nt]));
                br += ob[nt] * r; kr += ok[nt] * r; rk += r * k2[nt] * rkv[nt];
                ou[nt] = 1.0f - dec; oa[nt] = -kk; ow[nt] = dec * r; og[nt] = ag[nt][j]; }
            const size_t o = m * RW + c0;
#define ST4(ARR, f) do { v2u w_; w_.x = pk2(f[0], f[1]); w_.y = pk2(f[2], f[3]); *(v2u*)(ARR + o) = w_; } while (0)
            ST4(RU, ou); ST4(RA, oa); ST4(RB, ob); ST4(RK, ok); ST4(RWR, ow); ST4(RV, xv); ST4(RG, og);
#undef ST4
            br = allsum16(br); kr = allsum16(kr); rk = allsum16(rk);
            if (fr == 0) *(f32x4*)(RSC + (m * 8 + h) * 4) = (f32x4){br, kr, rk, 0.f};
        }
#undef LD4
#undef LDF4
        if (prompt) { if ((m0 & (TP - 1)) == TP - 16) { float* o = C.out + O_SH_P + ((size_t)i * NB + (m0 >> 11)) * RPROJ; for (int cc = tid; cc < RPROJ; cc += NTHR) o[cc] = bf2f(TILE[16 * RPROJ + cc]); } }
        else { float* o = C.out + O_SH_S + ((size_t)i * SB + sb) * RPROJ; for (int cc = tid; cc < 2 * RPROJ; cc += NTHR) { const int s = cc >= RPROJ ? 1 : 0; o[cc] = bf2f(TILE[(8 + 8 * s) * RPROJ + (cc - s * RPROJ)]); } }
        __syncthreads();
    }
}

__device__ __forceinline__ void unpack8(v4u c, float (&f)[8]) { f[0] = bflo(c.x); f[1] = bfhi(c.x); f[2] = bflo(c.y); f[3] = bfhi(c.y); f[4] = bflo(c.z); f[5] = bfhi(c.z); f[6] = bflo(c.w); f[7] = bfhi(c.w); }
__device__ __forceinline__ v4u pack8(const float (&f)[8]) { v4u o; o.x = pk2(f[0], f[1]); o.y = pk2(f[2], f[3]); o.z = pk2(f[4], f[5]); o.w = pk2(f[6], f[7]); return o; }
__device__ __forceinline__ void phase_gdn_prep(Ctx& C, int i) {
    PHASE_IDS
    LAS float* cwl = (LAS float*)C.lds;
    const bf16* PG = (const bf16*)(C.ws + WS_PROJ);
    bf16* GQ = (bf16*)(C.ws + WS_GQ); bf16* GK = (bf16*)(C.ws + WS_GK); bf16* GV = (bf16*)(C.ws + WS_GV); bf16* GZ = (bf16*)(C.ws + WS_GZ);
    float* GSC = (float*)(C.ws + WS_GSC); const float* P8 = (const float*)(C.ws + WS_P8);
    const float* cw = C.in[24] + (size_t)i * 4 * GQKV; const float* A_log = C.in[25] + i * GH; const float* dtb = C.in[26] + i * GH;
    for (int e = tid; e < 4 * GQKV; e += NTHR) cwl[e] = cw[e];
    __syncthreads();
    for (int tile = C.bid; tile < M / 8; tile += C.G) {
        const int m = tile * 8 + wave; const bool prompt = m < MP;
        const int t = prompt ? (m & (TP - 1)) : ((m - MP) & 7); const int b = prompt ? (m >> 11) : ((m - MP) >> 3);
        const bool last = prompt ? (t == TP - 1) : (t == 7);
        const bf16* P = PG + (size_t)m * GPR;
        const float* cs = C.in[5] + ((size_t)i * SB + (prompt ? 0 : b)) * 3 * GQKV;
        float* go = prompt ? C.out + O_GC_P + ((size_t)i * NB + b) * 3 * GQKV : C.out + O_GC_S + ((size_t)i * SB + b) * 3 * GQKV;
        float val[3][8];
#pragma unroll
        for (int blk = 0; blk < 3; ++blk) {
            const int col0 = blk * 512 + lane * 8;
            float xr[4][8];
            unpack8(*(const v4u*)(P + col0), xr[0]);
#pragma unroll
            for (int j = 1; j < 4; ++j) {
                if (t - j >= 0) unpack8(*(const v4u*)(P - (size_t)j * GPR + col0), xr[j]);
                else if (prompt) {
#pragma unroll
                    for (int e = 0; e < 8; ++e) xr[j][e] = 0.f; }
                else { const f32x4 a = *(const f32x4*)(cs + (3 + t - j) * GQKV + col0), c4 = *(const f32x4*)(cs + (3 + t - j) * GQKV + col0 + 4);
                    xr[j][0] = a.x; xr[j][1] = a.y; xr[j][2] = a.z; xr[j][3] = a.w; xr[j][4] = c4.x; xr[j][5] = c4.y; xr[j][6] = c4.z; xr[j][7] = c4.w; }
            }
#pragma unroll
            for (int h4 = 0; h4 < 2; ++h4) {
                const f32x4 w0 = *(const LAS f32x4*)(cwl + col0 + h4 * 4), w1 = *(const LAS f32x4*)(cwl + GQKV + col0 + h4 * 4), w2 = *(const LAS f32x4*)(cwl + 2 * GQKV + col0 + h4 * 4), w3 = *(const LAS f32x4*)(cwl + 3 * GQKV + col0 + h4 * 4);
#pragma unroll
                for (int e = 0; e < 4; ++e) { const int ee = h4 * 4 + e; val[blk][ee] = siluf_(w0[e] * xr[3][ee] + w1[e] * xr[2][ee] + w2[e] * xr[1][ee] + w3[e] * xr[0][ee]); }
            }
            if (last) {
#pragma unroll
                for (int j = 0; j < 3; ++j) { *(f32x4*)(go + j * GQKV + col0) = (f32x4){xr[2 - j][0], xr[2 - j][1], xr[2 - j][2], xr[2 - j][3]}; *(f32x4*)(go + j * GQKV + col0 + 4) = (f32x4){xr[2 - j][4], xr[2 - j][5], xr[2 - j][6], xr[2 - j][7]}; }
            }
        }
        float sq = 0.f, sk = 0.f;
#pragma unroll
        for (int e = 0; e < 8; ++e) { sq += val[0][e] * val[0][e]; sk += val[1][e] * val[1][e]; }
        sq = allsum16(sq); sk = allsum16(sk);
        const float nq = rsqrtf(sq + 1e-6f) * 0.08838834764831845f, nk = rsqrtf(sk + 1e-6f);
        float qh[8], kh[8];
#pragma unroll
        for (int e = 0; e < 8; ++e) { qh[e] = val[0][e] * nq; kh[e] = val[1][e] * nk; }
        const v4u qp = pack8(qh), kp = pack8(kh);
        const size_t o = (size_t)m * GW + lane * 8;
        *(v4u*)(GQ + o) = qp; *(v4u*)(GK + o) = kp; *(v4u*)(GV + o) = pack8(val[2]);
        float qr[8], kr[8]; unpack8(qp, qr); unpack8(kp, kr);
        float qk = 0.f;
#pragma unroll
        for (int e = 0; e < 8; ++e) qk += qr[e] * kr[e];
        qk = allsum16(qk);
        float z[8]; unpack8(*(const v4u*)(P + GQKV + lane * 8), z);
#pragma unroll
        for (int e = 0; e < 8; ++e) z[e] = siluf_(z[e]);
        *(v4u*)(GZ + o) = pack8(z);
        if ((lane & 15) == 0) { const int hh = lane >> 4;
            const float braw = P8[(size_t)m * 8 + hh], araw = P8[(size_t)m * 8 + 4 + hh];
            const float g = -__expf(A_log[hh]) * softplusf_(araw + dtb[hh]);
            *(f32x4*)(GSC + ((size_t)m * 4 + hh) * 4) = (f32x4){__expf(g), sigmoidf_(braw), qk, 0.f}; }
    }
}

__device__ __forceinline__ void bf8_to_lds(LAS float* dst, v4u c) {
    *(LAS f32x4*)dst = (f32x4){bflo(c.x), bfhi(c.x), bflo(c.y), bfhi(c.y)};
    *(LAS f32x4*)(dst + 4) = (f32x4){bflo(c.z), bfhi(c.z), bflo(c.w), bfhi(c.w)};
}

__device__ __forceinline__ f32x2 fma2(f32x2 a, f32x2 b, f32x2 c) { return __builtin_elementwise_fma(a, b, c); }
constexpr int SCAN_UNR = 4;
constexpr int GVS = 132, GVEC = 16 * 2 * GVS;
struct ROps { f32x4 u, a, b, k, w; float v; f32x2 sc; };
__device__ __forceinline__ ROps r_ld(const LAS float* B, int t, int kq, int vidx) {
    ROps o; const LAS float* V = B + t * 320 + kq * 4;
    o.u = *(const LAS f32x4*)V; o.a = *(const LAS f32x4*)(V + 64); o.b = *(const LAS f32x4*)(V + 128); o.k = *(const LAS f32x4*)(V + 192); o.w = *(const LAS f32x4*)(V + 256);
    o.v = B[5120 + t * 16 + vidx]; o.sc = *(const LAS f32x2*)(B + 5376 + t * 2); return o;
}
template <int TB> __device__ __forceinline__ void rwkv_block(f32x4& S, const LAS float* B, int kq, int vidx, float* yo) {
    f32x2 S0 = {S.x, S.y}, S1 = {S.z, S.w}; float ykeep = 0.f;
    ROps c = r_ld(B, 0, kq, vidx);
#pragma unroll 1
    for (int t0 = 0; t0 < TB; t0 += SCAN_UNR)
#pragma unroll
    for (int tt = 0; tt < SCAN_UNR; ++tt) {
        const int t = t0 + tt;
        ROps n = r_ld(B, (t + 1) & 15, kq, vidx);
        const f32x2 a0 = {c.a.x, c.a.y}, a1 = {c.a.z, c.a.w}, w0 = {c.w.x, c.w.y}, w1 = {c.w.z, c.w.w};
        const f32x2 ps = fma2(S1, a1, S0 * a0), py = fma2(S1, w1, S0 * w0);
        const float sa = allsum16(ps.x + ps.y), yp = allsum16(py.x + py.y);
        const f32x2 u0 = {c.u.x, c.u.y}, u1 = {c.u.z, c.u.w}, b0 = {c.b.x, c.b.y}, b1 = {c.b.z, c.b.w}, k0 = {c.k.x, c.k.y}, k1 = {c.k.z, c.k.w};
        const f32x2 sa2 = {sa, sa}, v2 = {c.v, c.v};
        S0 = fma2(-u0, S0, S0); S1 = fma2(-u1, S1, S1);
        S0 = fma2(sa2, b0, S0); S1 = fma2(sa2, b1, S1);
        S0 = fma2(v2, k0, S0); S1 = fma2(v2, k1, S1);
        const float y = yp + sa * c.sc.x + c.v * c.sc.y;
        ykeep = (kq == t) ? y : ykeep;
        c = n;
    }
    if (TB == 16 || kq < TB) yo[(size_t)kq * RW] = ykeep;
    S = (f32x4){S0.x, S0.y, S1.x, S1.y};
}
struct GOps { f32x4 q0, q1, k0, k1; float v; f32x4 sc; };
__device__ __forceinline__ GOps g_ld(const LAS float* B, int t, int kq, int vidx) {
    GOps o; const LAS float* V = B + t * 256 + kq * 8;
    o.q0 = *(const LAS f32x4*)V; o.q1 = *(const LAS f32x4*)(V + 4); o.k0 = *(const LAS f32x4*)(V + 128); o.k1 = *(const LAS f32x4*)(V + 132);
    o.v = B[4096 + t * 16 + vidx]; o.sc = *(const LAS f32x4*)(B + 4352 + t * 4); return o;
}
template <int TB> __device__ __forceinline__ void gdn_block(f32x2 (&S)[4], const LAS float* B, int kq, int vidx, float* oo) {
    float okeep = 0.f;
    GOps c = g_ld(B, 0, kq, vidx);
#pragma unroll 1
    for (int t0 = 0; t0 < TB; t0 += SCAN_UNR)
#pragma unroll
    for (int tt = 0; tt < SCAN_UNR; ++tt) {
        const int t = t0 + tt;
        GOps n = g_ld(B, (t + 1) & 15, kq, vidx);
        const f32x2 k[4] = {{c.k0.x, c.k0.y}, {c.k0.z, c.k0.w}, {c.k1.x, c.k1.y}, {c.k1.z, c.k1.w}}, q[4] = {{c.q0.x, c.q0.y}, {c.q0.z, c.q0.w}, {c.q1.x, c.q1.y}, {c.q1.z, c.q1.w}};
        const f32x2 pk = fma2(S[3], k[3], fma2(S[2], k[2], fma2(S[1], k[1], S[0] * k[0]))), pq = fma2(S[3], q[3], fma2(S[2], q[2], fma2(S[1], q[1], S[0] * q[0])));
        const float kts = allsum16(pk.x + pk.y), qts = allsum16(pq.x + pq.y);
        const float alpha = c.sc.x, beta = c.sc.y, qk = c.sc.z;
        const float coef = beta * (c.v - alpha * kts);
        const f32x2 al2 = {alpha, alpha}, cf2 = {coef, coef};
#pragma unroll
        for (int e = 0; e < 4; ++e) S[e] = fma2(al2, S[e], k[e] * cf2);
        const float o = alpha * qts + qk * coef;
        okeep = (kq == t) ? o : okeep;
        c = n;
    }
    if (TB == 16 || kq < TB) oo[(size_t)kq * GW] = okeep;
}
__device__ __forceinline__ float sum8(float x) { x += dppf<0x141>(x); x += dppf<0x4E>(x); x += dppf<0xB1>(x); return x; }
struct ROps8 { f32x4 u[2], a[2], b[2], k[2], w[2]; float v; f32x2 sc; };
__device__ __forceinline__ ROps8 r_ld8(const LAS float* B, int t, int kq, int vidx) {
    ROps8 o; const LAS float* V = B + t * 320 + kq * 8;
#pragma unroll
    for (int h = 0; h < 2; ++h) { o.u[h] = *(const LAS f32x4*)(V + 4 * h); o.a[h] = *(const LAS f32x4*)(V + 64 + 4 * h); o.b[h] = *(const LAS f32x4*)(V + 128 + 4 * h); o.k[h] = *(const LAS f32x4*)(V + 192 + 4 * h); o.w[h] = *(const LAS f32x4*)(V + 256 + 4 * h); }
    o.v = B[5120 + t * 16 + vidx]; o.sc = *(const LAS f32x2*)(B + 5376 + t * 2); return o;
}
#define PAIRS(V_) {{V_[0].x, V_[0].y}, {V_[0].z, V_[0].w}, {V_[1].x, V_[1].y}, {V_[1].z, V_[1].w}}
template <int TB> __device__ __forceinline__ void rwkv_block8(f32x2 (&S)[4], const LAS float* B, int kq, int vidx, float* yo) {
    float ykA = 0.f, ykB = 0.f;
    ROps8 c = r_ld8(B, 0, kq, vidx);
#pragma unroll 1
    for (int t0 = 0; t0 < TB; t0 += SCAN_UNR)
#pragma unroll
    for (int tt = 0; tt < SCAN_UNR; ++tt) {
        const int t = t0 + tt;
        const ROps8 n = r_ld8(B, (t + 1) & 15, kq, vidx);
        const f32x2 a[4] = PAIRS(c.a), w[4] = PAIRS(c.w), u[4] = PAIRS(c.u), b[4] = PAIRS(c.b), k[4] = PAIRS(c.k);
        const f32x2 ps = fma2(S[3], a[3], fma2(S[2], a[2], fma2(S[1], a[1], S[0] * a[0]))), py = fma2(S[3], w[3], fma2(S[2], w[2], fma2(S[1], w[1], S[0] * w[0])));
        const float sa = sum8(ps.x + ps.y), yp = sum8(py.x + py.y);
        const f32x2 sa2 = {sa, sa}, v2 = {c.v, c.v};
#pragma unroll
        for (int e = 0; e < 4; ++e) { S[e] = fma2(-u[e], S[e], S[e]); S[e] = fma2(sa2, b[e], S[e]); S[e] = fma2(v2, k[e], S[e]); }
        const float y = yp + sa * c.sc.x + c.v * c.sc.y;
        ykA = (kq == t) ? y : ykA; ykB = (kq + 8 == t) ? y : ykB;
        c = n;
    }
    yo[(size_t)kq * RW] = ykA;
    if (TB == 16) yo[(size_t)(kq + 8) * RW] = ykB;
}
struct GOps8 { f32x4 q[4], k[4]; float v; f32x4 sc; };
__device__ __forceinline__ GOps8 g_ld8(const LAS float* B, int t, int kq, int vidx) {
    GOps8 o; const LAS float* V = B + t * (2 * GVS) + kq * 16 + (kq >> 2) * 4;
#pragma unroll
    for (int h = 0; h < 4; ++h) { o.q[h] = *(const LAS f32x4*)(V + 4 * h); o.k[h] = *(const LAS f32x4*)(V + GVS + 4 * h); }
    o.v = B[GVEC + t * 16 + vidx]; o.sc = *(const LAS f32x4*)(B + GVEC + 256 + t * 4); return o;
}
#define PAIRS8(V_) {{V_[0].x, V_[0].y}, {V_[0].z, V_[0].w}, {V_[1].x, V_[1].y}, {V_[1].z, V_[1].w}, {V_[2].x, V_[2].y}, {V_[2].z, V_[2].w}, {V_[3].x, V_[3].y}, {V_[3].z, V_[3].w}}
template <int TB> __device__ __forceinline__ void gdn_block8(f32x2 (&S)[8], const LAS float* B, int kq, int vidx, float* oo) {
    float okA = 0.f, okB = 0.f;
    GOps8 c = g_ld8(B, 0, kq, vidx);
#pragma unroll 1
    for (int t0 = 0; t0 < TB; t0 += SCAN_UNR)
#pragma unroll
    for (int tt = 0; tt < SCAN_UNR; ++tt) {
        const int t = t0 + tt;
        const GOps8 n = g_ld8(B, (t + 1) & 15, kq, vidx);
        const f32x2 k[8] = PAIRS8(c.k), q[8] = PAIRS8(c.q);
        f32x2 pk = S[0] * k[0], pq = S[0] * q[0];
#pragma unroll
        for (int e = 1; e < 8; ++e) { pk = fma2(S[e], k[e], pk); pq = fma2(S[e], q[e], pq); }
        const float kts = sum8(pk.x + pk.y), qts = sum8(pq.x + pq.y);
        const float alpha = c.sc.x, beta = c.sc.y, qk = c.sc.z;
        const float coef = beta * (c.v - alpha * kts);
        const f32x2 al2 = {alpha, alpha}, cf2 = {coef, coef};
#pragma unroll
        for (int e = 0; e < 8; ++e) S[e] = fma2(al2, S[e], k[e] * cf2);
        const float o = alpha * qts + qk * coef;
        okA = (kq == t) ? o : okA; okB = (kq + 8 == t) ? o : okB;
        c = n;
    }
    oo[(size_t)kq * GW] = okA;
    if (TB == 16) oo[(size_t)(kq + 8) * GW] = okB;
}
constexpr int SC_NBLK = 128 + 16;
constexpr int RBUF = 16 * 5 * 64 + 16 * 16 + 16 * 2;
constexpr int GBUF = GVEC + 16 * 16 + 16 * 4;
__device__ __forceinline__ void phase_scan(Ctx& C, int i) {
    PHASE_IDS
    const int w = wave & 1; const bool cw = (wave < 2) || (wave >= 6);
    int sub = lane >> 3, kq = lane & 7, ht = tid & 255;
#define RELAUNDER do { int tl_ = tid; asm volatile("" : "+v"(tl_)); ht = tl_ & 255; sub = (tl_ & 63) >> 3; kq = tl_ & 7; } while (0)
    LAS float* const ldsf = (LAS float*)C.lds;
    if (wave < 4) {
        LAS float* const buf0 = ldsf;
        const unsigned char* SCN = C.ws + WS_SCN; const bf16* RV = (const bf16*)(C.ws + WS_RV); const float* RSC = (const float*)(C.ws + WS_RSC);
        float* YRAW = (float*)(C.ws + WS_YRAW);
        v4u st[3]; v4u stv; f32x2 sts; f32x4 Snext = {0.f, 0.f, 0.f, 0.f}, Snext1 = {0.f, 0.f, 0.f, 0.f};
#define R_DESC(blk, m0, tb, head, quarter, b, isprompt) \
        size_t m0; int tb, head, quarter, b; bool isprompt; \
        if ((blk) < 128) { isprompt = true; const int seq = C.bid >> 5; b = seq; head = (C.bid >> 2) & 7; quarter = C.bid & 3; m0 = (size_t)seq * TP + (size_t)(blk) * 16; tb = 16; } \
        else { isprompt = false; const int su = C.bid * 16 + ((blk) - 128); b = su >> 5; head = (su >> 2) & 7; quarter = su & 3; m0 = (size_t)MP + (size_t)b * TS; tb = 8; }
#define R_STAGE_LOAD(blk) do { R_DESC(blk, m0_, tb_, head_, quarter_, b_, ip_) \
        _Pragma("unroll") for (int q = 0; q < 3; ++q) { const int id = ht + 256 * q; const int tok = id / 40, rem = id - tok * 40, vec = rem >> 3, part = rem & 7; \
            if (id < 640 && tok < tb_) st[q] = *(const v4u*)(SCN + (size_t)vec * A17 + ((m0_ + tok) * RW + head_ * 64 + part * 8) * 2); } \
        if (ht < 32) { const int tok = ht >> 1; if (tok < tb_) stv = *(const v4u*)(RV + (m0_ + tok) * RW + head_ * 64 + quarter_ * 16 + (ht & 1) * 8); } \
        else if (ht < 48) { const int tok = ht - 32; if (tok < tb_) sts = *(const f32x2*)(RSC + ((m0_ + tok) * 8 + head_) * 4); } \
        if (!ip_ && cw) { const float* s0_ = C.in[2] + ((size_t)(i * SB + b_) * RH + head_) * 4096 + (quarter_ * 16 + w * 8 + sub) * 64 + kq * 8; Snext = *(const f32x4*)s0_; Snext1 = *(const f32x4*)(s0_ + 4); } else { Snext = (f32x4){0.f, 0.f, 0.f, 0.f}; Snext1 = Snext; } } while (0)
#define R_STAGE_WRITE(blk) do { LAS float* B = buf0 + ((blk) & 1) * RBUF; \
        _Pragma("unroll") for (int q = 0; q < 3; ++q) { const int id = ht + 256 * q; const int tok = id / 40, rem = id - tok * 40, vec = rem >> 3, part = rem & 7; \
            if (id < 640) bf8_to_lds(B + (tok * 5 + vec) * 64 + part * 8, st[q]); } \
        if (ht < 32) bf8_to_lds(B + 5120 + (ht >> 1) * 16 + (ht & 1) * 8, stv); \
        else if (ht < 48) *(LAS f32x2*)(B + 5376 + (ht - 32) * 2) = sts; } while (0)
        R_STAGE_LOAD(0);
        f32x2 S[4] = {{Snext.x, Snext.y}, {Snext.z, Snext.w}, {Snext1.x, Snext1.y}, {Snext1.z, Snext1.w}};
        R_STAGE_WRITE(0);
        __syncthreads();
#pragma unroll 1
        for (int blk = 0; blk < SC_NBLK; ++blk) {
            RELAUNDER;
            R_DESC(blk, m0, tb, head, quarter, b, isprompt)
            const bool last = isprompt ? (blk == 127) : true;
            if (blk + 1 < SC_NBLK) R_STAGE_LOAD(blk + 1);
            const LAS float* B = buf0 + (blk & 1) * RBUF;
            const int row = quarter * 16 + w * 8 + sub;
            float* yo = YRAW + m0 * RW + head * 64 + row;
            if (cw) {
            if (tb == 16) rwkv_block8<16>(S, B, kq, w * 8 + sub, yo); else rwkv_block8<8>(S, B, kq, w * 8 + sub, yo);
            if (last) {
                float* So = (isprompt ? C.out + O_RWKV_P + ((size_t)(i * NB + b) * RH + head) * 4096 : C.out + O_RWKV_S + ((size_t)(i * SB + b) * RH + head) * 4096);
                *(f32x4*)(So + row * 64 + kq * 8) = (f32x4){S[0].x, S[0].y, S[1].x, S[1].y}; *(f32x4*)(So + row * 64 + kq * 8 + 4) = (f32x4){S[2].x, S[2].y, S[3].x, S[3].y};
                S[0] = (f32x2){Snext.x, Snext.y}; S[1] = (f32x2){Snext.z, Snext.w}; S[2] = (f32x2){Snext1.x, Snext1.y}; S[3] = (f32x2){Snext1.z, Snext1.w};
            }
            }
            if (blk + 1 < SC_NBLK) R_STAGE_WRITE(blk + 1);
            __syncthreads();
        }
#undef R_DESC
#undef R_STAGE_LOAD
#undef R_STAGE_WRITE
    } else {
        LAS float* const buf0 = ldsf + 2 * RBUF;
        const bf16* GQ = (const bf16*)(C.ws + WS_GQ); const bf16* GV = (const bf16*)(C.ws + WS_GV); const float* GSC = (const float*)(C.ws + WS_GSC);
        float* ORAW = (float*)(C.ws + WS_ORAW);
        v4u st[2]; v4u stv; f32x4 sts; float Snext[16];
#pragma unroll
        for (int e = 0; e < 16; ++e) Snext[e] = 0.f;
#define G_DESC(blk, m0, tb, head, cgp, b, isprompt) \
        size_t m0; int tb, head, cgp, b; bool isprompt; \
        if ((blk) < 128) { isprompt = true; const int seq = C.bid >> 5; b = seq; head = (C.bid >> 3) & 3; cgp = C.bid & 7; m0 = (size_t)seq * TP + (size_t)(blk) * 16; tb = 16; } \
        else { isprompt = false; const int su = C.bid * 16 + ((blk) - 128); b = su >> 5; head = (su >> 3) & 3; cgp = su & 7; m0 = (size_t)MP + (size_t)b * TS; tb = 8; }
#define G_STAGE_LOAD(blk) do { G_DESC(blk, m0_, tb_, head_, cgp_, b_, ip_) \
        _Pragma("unroll") for (int q = 0; q < 2; ++q) { const int id = ht + 256 * q; const int tok = id >> 5, vec = (id >> 4) & 1, part = id & 15; \
            if (tok < tb_) st[q] = *(const v4u*)(GQ + (size_t)vec * (A17 / 2) + (m0_ + tok) * GW + head_ * 128 + part * 8); } \
        if (ht < 32) { const int tok = ht >> 1; if (tok < tb_) stv = *(const v4u*)(GV + (m0_ + tok) * GW + head_ * 128 + cgp_ * 16 + (ht & 1) * 8); } \
        else if (ht < 48) { const int tok = ht - 32; if (tok < tb_) sts = *(const f32x4*)(GSC + ((m0_ + tok) * 4 + head_) * 4); } \
        if (!ip_ && cw) { const float* S0 = C.in[4] + ((size_t)(i * SB + b_) * GH + head_) * 16384 + cgp_ * 16 + w * 8 + sub; \
            _Pragma("unroll") for (int e = 0; e < 16; ++e) Snext[e] = S0[(size_t)(kq * 16 + e) * 128]; } \
        else { _Pragma("unroll") for (int e = 0; e < 16; ++e) Snext[e] = 0.f; } } while (0)
#define G_STAGE_WRITE(blk) do { LAS float* B = buf0 + ((blk) & 1) * GBUF; \
        _Pragma("unroll") for (int q = 0; q < 2; ++q) { const int id = ht + 256 * q; const int tok = id >> 5, vec = (id >> 4) & 1, part = id & 15; \
            bf8_to_lds(B + (tok * 2 + vec) * GVS + part * 8 + (part >> 3) * 4, st[q]); } \
        if (ht < 32) bf8_to_lds(B + GVEC + (ht >> 1) * 16 + (ht & 1) * 8, stv); \
        else if (ht < 48) *(LAS f32x4*)(B + GVEC + 256 + (ht - 32) * 4) = sts; } while (0)
        G_STAGE_LOAD(0);
        f32x2 S[8];
#pragma unroll
        for (int e = 0; e < 8; ++e) S[e] = (f32x2){Snext[2 * e], Snext[2 * e + 1]};
        G_STAGE_WRITE(0);
        __syncthreads();
#pragma unroll 1
        for (int blk = 0; blk < SC_NBLK; ++blk) {
            RELAUNDER;
            G_DESC(blk, m0, tb, head, cgp, b, isprompt)
            const bool last = isprompt ? (blk == 127) : true;
            if (blk + 1 < SC_NBLK) G_STAGE_LOAD(blk + 1);
            const LAS float* B = buf0 + (blk & 1) * GBUF;
            const int col = cgp * 16 + w * 8 + sub;
            float* oo = ORAW + m0 * GW + head * 128 + col;
            if (cw) {
            if (tb == 16) gdn_block8<16>(S, B, kq, w * 8 + sub, oo); else gdn_block8<8>(S, B, kq, w * 8 + sub, oo);
            if (last) {
                float* So = (isprompt ? C.out + O_GDN_P + ((size_t)(i * NB + b) * GH + head) * 16384 : C.out + O_GDN_S + ((size_t)(i * SB + b) * GH + head) * 16384) + col;
#pragma unroll
                for (int e = 0; e < 8; ++e) { So[(size_t)(kq * 16 + 2 * e) * 128] = S[e].x; So[(size_t)(kq * 16 + 2 * e + 1) * 128] = S[e].y; S[e] = (f32x2){Snext[2 * e], Snext[2 * e + 1]}; }
            }
            }
            if (blk + 1 < SC_NBLK) G_STAGE_WRITE(blk + 1);
            __syncthreads();
        }
#undef G_DESC
#undef G_STAGE_LOAD
#undef G_STAGE_WRITE
    }
}

__device__ __forceinline__ void phase_post(Ctx& C, int i) {
    PHASE_IDS
    const int gw = C.bid * NWAVES + wave, NGW = C.G * NWAVES;
    const float* YRAW = (const float*)(C.ws + WS_YRAW); const float* ORAW = (const float*)(C.ws + WS_ORAW);
    const bf16* RV = (const bf16*)(C.ws + WS_RV); const bf16* RG = (const bf16*)(C.ws + WS_RG); const float* RSC = (const float*)(C.ws + WS_RSC); const bf16* GZ = (const bf16*)(C.ws + WS_GZ);
    bf16* YM = (bf16*)(C.ws + WS_XN);
    const float* lnwp = C.in[22] + i * RW + lane * 8; const float* lnbp = C.in[23] + i * RW + lane * 8; const float* gnwp = C.in[27] + i * GHD + (lane & 15) * 8;
    float lnw[8], lnb[8], gnw[8];
#pragma unroll
    for (int e = 0; e < 8; ++e) { lnw[e] = lnwp[e]; lnb[e] = lnbp[e]; gnw[e] = gnwp[e]; }
    for (int m = gw; m < M; m += NGW) {
        const size_t mm = (size_t)m;
        const f32x4 y0 = *(const f32x4*)(YRAW + mm * RW + lane * 8), y1 = *(const f32x4*)(YRAW + mm * RW + lane * 8 + 4);
        const f32x4 o0 = *(const f32x4*)(ORAW + mm * GW + lane * 8), o1 = *(const f32x4*)(ORAW + mm * GW + lane * 8 + 4);
        const v4u vv = *(const v4u*)(RV + mm * RW + lane * 8), gg = *(const v4u*)(RG + mm * RW + lane * 8), zz = *(const v4u*)(GZ + mm * GW + lane * 8);
        const float rk = RSC[(mm * 8 + (lane >> 3)) * 4 + 2];
        float y[8] = {y0.x, y0.y, y0.z, y0.w, y1.x, y1.y, y1.z, y1.w}, v[8], g[8], o[8];
        unpack8(vv, v); unpack8(gg, g);
        float s = ((y[0] + y[1]) + (y[2] + y[3])) + ((y[4] + y[5]) + (y[6] + y[7]));
        const float mean = sum8(s) * (1.f / 64.f); float q = 0.f;
#pragma unroll
        for (int e = 0; e < 8; ++e) { y[e] -= mean; q += y[e] * y[e]; }
        const float rstd = rsqrtf(sum8(q) * (1.f / 64.f) + 64e-5f);
#pragma unroll
        for (int e = 0; e < 8; ++e) o[e] = (y[e] * rstd * lnw[e] + lnb[e] + rk * v[e]) * g[e];
        *(v4u*)(YM + mm * D + lane * 8) = pack8(o);
        float z[8]; unpack8(zz, z);
        float x[8] = {o0.x, o0.y, o0.z, o0.w, o1.x, o1.y, o1.z, o1.w}; float q2 = 0.f;
#pragma unroll
        for (int e = 0; e < 8; ++e) q2 += x[e] * x[e];
        const float rs = rsqrtf(allsum16(q2) * (1.f / 128.f) + 1e-6f);
#pragma unroll
        for (int e = 0; e < 8; ++e) o[e] = x[e] * rs * gnw[e] * z[e];
        *(v4u*)(YM + mm * D + 512 + lane * 8) = pack8(o);
    }
}

constexpr int XS = 1032;
__device__ __forceinline__ void phase_lru_prep(Ctx& C, int i) {
    PHASE_IDS
    LAS bf16* xc = (LAS bf16*)C.lds;
    const bf16* PO = (const bf16*)(C.ws + WS_PROJ);
    bf16* LP = (bf16*)(C.ws + WS_LP); bf16* LH = (bf16*)(C.ws + WS_LH); float* LT = (float*)(C.ws + WS_LTOT);
    const bf16* WA = (const bf16*)(C.ws + WS_WA) + wave * 16384; const bf16* WI = (const bf16*)(C.ws + WS_WI) + wave * 16384;
    const float* cw = C.in[30] + (size_t)i * 4 * D; const float* cb = C.in[31] + i * D;
    const float* ba = C.in[33] + i * D; const float* bi = C.in[35] + i * D; const float* Lp = C.in[36] + i * D;
    const int fr = lane & 15, fq = lane >> 4, h = wave;
    LAS float* CSTL = (LAS float*)(C.lds + 67584);
    for (int c = tid; c < D; c += NTHR) { CSTL[c] = ba[c]; CSTL[D + c] = bi[c]; CSTL[2 * D + c] = softplusf_(-Lp[c]); }
    for (int tile = C.bid; tile < M / 32; tile += C.G) {
        const int m0 = tile * 32; const bool prompt = m0 < MP;
        const bf16* P = PO + (size_t)m0 * 2048;
        bf16x8 Bc[4][2];
#pragma unroll
        for (int ks = 0; ks < 4; ++ks) { Bc[ks][0] = *(const bf16x8*)(WA + fr * 128 + ks * 32 + fq * 8); Bc[ks][1] = *(const bf16x8*)(WI + fr * 128 + ks * 32 + fq * 8); }
        {
            const int rg = tid >> 7;
            const bool seqstart = prompt ? (((m0 & (TP - 1)) == 0) && rg == 0) : true;
#pragma unroll 1
            for (int hh = 0; hh < 2; ++hh) {
                const int c0 = (tid & 127) * 8 + hh * 4;
                float xr[11][4];
#pragma unroll
                for (int r = 0; r < 11; ++r) { const int tr = rg * 8 - 3 + r;
                    if (r >= 3 || !seqstart) { const v2u w = *(const v2u*)(P + (ptrdiff_t)tr * 2048 + 1024 + c0); xr[r][0] = bflo(w.x); xr[r][1] = bfhi(w.x); xr[r][2] = bflo(w.y); xr[r][3] = bfhi(w.y); }
                    else if (prompt) { xr[r][0] = 0.f; xr[r][1] = 0.f; xr[r][2] = 0.f; xr[r][3] = 0.f; }
                    else { const f32x4 a = *(const f32x4*)(C.in[7] + ((size_t)i * SB + ((m0 - MP) >> 3) + rg) * 3 * D + r * D + c0); xr[r][0] = a.x; xr[r][1] = a.y; xr[r][2] = a.z; xr[r][3] = a.w; } }
                const f32x4 t0 = *(const f32x4*)(cw + c0), t1 = *(const f32x4*)(cw + D + c0), t2 = *(const f32x4*)(cw + 2 * D + c0), t3 = *(const f32x4*)(cw + 3 * D + c0), bs = *(const f32x4*)(cb + c0);
#pragma unroll
                for (int t8 = 0; t8 < 8; ++t8) { float y[4];
#pragma unroll
                    for (int e = 0; e < 4; ++e) y[e] = t0[e] * xr[t8][e] + t1[e] * xr[t8 + 1][e] + t2[e] * xr[t8 + 2][e] + t3[e] * xr[t8 + 3][e] + bs[e];
                    v2u o; o.x = pk2(y[0], y[1]); o.y = pk2(y[2], y[3]);
                    *(LAS v2u*)(xc + (rg * 8 + t8) * XS + c0) = o; }
            }
        }
        __syncthreads();
#pragma unroll
        for (int nt = 0; nt < 8; ++nt) {
            pg8::f32x4 aa[2] = {{0.f, 0.f, 0.f, 0.f}, {0.f, 0.f, 0.f, 0.f}}, ai[2] = {{0.f, 0.f, 0.f, 0.f}, {0.f, 0.f, 0.f, 0.f}};
            bf16x8 Bn[4][2];
            if (nt + 1 < 8) {
#pragma unroll
                for (int ks = 0; ks < 4; ++ks) { Bn[ks][0] = *(const bf16x8*)(WA + ((nt + 1) * 16 + fr) * 128 + ks * 32 + fq * 8); Bn[ks][1] = *(const bf16x8*)(WI + ((nt + 1) * 16 + fr) * 128 + ks * 32 + fq * 8); } }
#pragma unroll
            for (int ks = 0; ks < 4; ++ks) {
                const bf16x8 bfa = Bc[ks][0], bfi = Bc[ks][1];
#pragma unroll
                for (int mt = 0; mt < 2; ++mt) { const bf16x8 af = *(const LAS bf16x8*)(xc + (mt * 16 + fr) * XS + h * 128 + ks * 32 + fq * 8);
                    aa[mt] = __builtin_amdgcn_mfma_f32_16x16x32_bf16(af, bfa, aa[mt], 0, 0, 0); ai[mt] = __builtin_amdgcn_mfma_f32_16x16x32_bf16(af, bfi, ai[mt], 0, 0, 0); }
            }
            const int ch = h * 128 + nt * 16 + fr;
            const float bac = CSTL[ch], bic = CSTL[D + ch], spl = CSTL[2 * D + ch];
            float IA[2][4], IB[2][4], GA[2], GB[2], EA[2], EB[2];
#pragma unroll
            for (int mt = 0; mt < 2; ++mt) {
                float pa = 1.f, pb = 0.f;
#pragma unroll
                for (int j = 0; j < 4; ++j) {
                    const int tok = mt * 16 + fq * 4 + j; const float xv = bf2f(xc[tok * XS + ch]);
                    const float r = sigmoidf_(aa[mt][j] + bac), ig = sigmoidf_(ai[mt][j] + bic);
                    const float la = -8.0f * r * spl; const float A = __expf(la); const float x2 = 2.0f * la;
                    const float om_s = -x2 * (1.0f + x2 * (0.5f + x2 * (0.16666667f + x2 * (0.041666668f + x2 * 0.008333334f))));
                    const float om = (x2 > -0.25f) ? om_s : (1.0f - A * A); const float mult = __builtin_amdgcn_sqrtf(fmaxf(om, 0.f)); const float B = mult * ig * xv;
                    pb = A * pb + B; pa = pa * A; IA[mt][j] = pa; IB[mt][j] = pb;
                }
                float ga = pa, gb = pb;
                { const float qa = __shfl_up(ga, 16), qb = __shfl_up(gb, 16); const bool doit = prompt ? (fq >= 1) : ((fq & 1) != 0); if (doit) { gb = ga * qb + gb; ga = qa * ga; } }
                { const float qa = __shfl_up(ga, 32), qb = __shfl_up(gb, 32); if (prompt && fq >= 2) { gb = ga * qb + gb; ga = qa * ga; } }
                GA[mt] = ga; GB[mt] = gb;
                { const float qa = __shfl_up(ga, 16), qb = __shfl_up(gb, 16); const bool doit = prompt ? (fq >= 1) : ((fq & 1) != 0); EA[mt] = doit ? qa : 1.f; EB[mt] = doit ? qb : 0.f; }
            }
            { const float ta = __shfl(GA[0], fr + 48), tb = __shfl(GB[0], fr + 48); if (prompt) { EB[1] = EA[1] * tb + EB[1]; EA[1] = ta * EA[1]; } }
#pragma unroll
            for (int mt = 0; mt < 2; ++mt)
#pragma unroll
                for (int j = 0; j < 4; ++j) { const size_t m = (size_t)(m0 + mt * 16 + fq * 4 + j);
                    const float Pv = EA[mt] * IA[mt][j], Hv = IA[mt][j] * EB[mt] + IB[mt][j];
                    LP[m * D + ch] = (bf16)f2bf(Pv); LH[m * D + ch] = (bf16)f2bf(Hv);
                    if (mt == 1 && j == 3 && fq == 3) *(f32x2*)(LT + ((size_t)tile * D + ch) * 2) = (f32x2){Pv, Hv}; }
            if (nt + 1 < 8) {
#pragma unroll
                for (int ks = 0; ks < 4; ++ks) { Bc[ks][0] = Bn[ks][0]; Bc[ks][1] = Bn[ks][1]; } }
            asm volatile("" ::: "memory");
        }
        if (prompt) { if ((m0 & (TP - 1)) == TP - 32) { float* o = C.out + O_LC_P + ((size_t)i * NB + (m0 >> 11)) * 3 * D;
                for (int e = tid; e < 3 * D; e += NTHR) { const int j = e >> 10, cc = e & 1023; o[e] = bf2f(P[(29 + j) * 2048 + 1024 + cc]); } } }
        else { for (int e = tid; e < 4 * 3 * D; e += NTHR) { const int s = e / (3 * D), r = e - s * 3 * D, j = r >> 10, cc = r & 1023;
                C.out[O_LC_S + ((size_t)i * SB + ((m0 - MP) >> 3) + s) * 3 * D + r] = bf2f(P[(s * 8 + 5 + j) * 2048 + 1024 + cc]); } }
        __syncthreads();
    }
}

__device__ __forceinline__ float gelu_tanh(float x) { const float u = 0.7978845608028654f * (x + 0.044715f * x * x * x); return 0.5f * x * (1.0f + tanhf_(u)); }

__device__ __forceinline__ void phase_lru_fin(Ctx& C, int i) {
    PHASE_IDS
    LAS float* X = (LAS float*)C.lds;
    const bf16* PO = (const bf16*)(C.ws + WS_PROJ);
    const bf16* LP = (const bf16*)(C.ws + WS_LP); const bf16* LH = (const bf16*)(C.ws + WS_LH); const float* LT = (const float*)(C.ws + WS_LTOT);
    bf16* YM = (bf16*)(C.ws + WS_XN);
    const int rg = tid >> 7, cg = tid & 127, c0 = cg * 8;
    for (int unit = C.bid; unit < M / 16; unit += C.G) {
        const int m0 = unit * 16; const bool prompt = m0 < MP; const int tile = m0 >> 5;
        float carry[8];
        if (prompt) {
            const int tt0 = (m0 >> 11) * 64, n = tile - tt0, per = (n + 3) >> 2; const int lo = tt0 + rg * per; const int hi = (lo + per < tile) ? lo + per : tile;
            float A[8], B[8];
#pragma unroll
            for (int e = 0; e < 8; ++e) { A[e] = 1.f; B[e] = 0.f; }
#pragma unroll 4
            for (int tt = lo; tt < hi; ++tt) { const float* p = LT + ((size_t)tt * D + c0) * 2;
                const f32x4 v0 = *(const f32x4*)p, v1 = *(const f32x4*)(p + 4), v2 = *(const f32x4*)(p + 8), v3 = *(const f32x4*)(p + 12);
                const float P[8] = {v0.x, v0.z, v1.x, v1.z, v2.x, v2.z, v3.x, v3.z}, H[8] = {v0.y, v0.w, v1.y, v1.w, v2.y, v2.w, v3.y, v3.w};
#pragma unroll
                for (int e = 0; e < 8; ++e) { B[e] = P[e] * B[e] + H[e]; A[e] *= P[e]; } }
            LAS float* xp = X + (rg * 128 + cg) * 16;
            *(LAS f32x4*)xp = (f32x4){A[0], A[1], A[2], A[3]}; *(LAS f32x4*)(xp + 4) = (f32x4){A[4], A[5], A[6], A[7]};
            *(LAS f32x4*)(xp + 8) = (f32x4){B[0], B[1], B[2], B[3]}; *(LAS f32x4*)(xp + 12) = (f32x4){B[4], B[5], B[6], B[7]};
            __syncthreads();
#pragma unroll
            for (int e = 0; e < 8; ++e) carry[e] = 0.f;
#pragma unroll
            for (int q = 0; q < 4; ++q) { const LAS float* xq = X + (q * 128 + cg) * 16;
                const f32x4 a0 = *(const LAS f32x4*)xq, a1 = *(const LAS f32x4*)(xq + 4), b0 = *(const LAS f32x4*)(xq + 8), b1 = *(const LAS f32x4*)(xq + 12);
                carry[0] = a0.x * carry[0] + b0.x; carry[1] = a0.y * carry[1] + b0.y; carry[2] = a0.z * carry[2] + b0.z; carry[3] = a0.w * carry[3] + b0.w;
                carry[4] = a1.x * carry[4] + b1.x; carry[5] = a1.y * carry[5] + b1.y; carry[6] = a1.z * carry[6] + b1.z; carry[7] = a1.w * carry[7] + b1.w; }
        } else {
            const float* hp = C.in[6] + ((size_t)i * SB + ((m0 - MP) >> 3) + (rg >> 1)) * D + c0;
            const f32x4 h0 = *(const f32x4*)hp, h1 = *(const f32x4*)(hp + 4);
            carry[0] = h0.x; carry[1] = h0.y; carry[2] = h0.z; carry[3] = h0.w; carry[4] = h1.x; carry[5] = h1.y; carry[6] = h1.z; carry[7] = h1.w;
        }
#pragma unroll
        for (int t4 = 0; t4 < 4; ++t4) {
            const size_t m = (size_t)(m0 + rg * 4 + t4);
            float lh[8], lp[8], gt[8], y[8], hv[8];
            unpack8(*(const v4u*)(LH + m * D + c0), lh); unpack8(*(const v4u*)(LP + m * D + c0), lp); unpack8(*(const v4u*)(PO + m * 2048 + c0), gt);
#pragma unroll
            for (int e = 0; e < 8; ++e) { hv[e] = lh[e] + lp[e] * carry[e]; y[e] = hv[e] * gelu_tanh(gt[e]); }
            *(v4u*)(YM + m * D + c0) = pack8(y);
            const bool lastp = prompt && ((m & (TP - 1)) == TP - 1), lasts = !prompt && (((m - MP) & 7) == 7);
            if (lastp || lasts) { float* o = lastp ? C.out + O_LRU_P + ((size_t)i * NB + (m >> 11)) * D + c0 : C.out + O_LRU_S + ((size_t)i * SB + ((m - MP) >> 3)) * D + c0;
                *(f32x4*)o = (f32x4){hv[0], hv[1], hv[2], hv[3]}; *(f32x4*)(o + 4) = (f32x4){hv[4], hv[5], hv[6], hv[7]}; }
        }
        if (prompt) __syncthreads();
    }
}

__global__ void __launch_bounds__(NTHR, 2) hybrid_fwd(Args args) {
    extern __shared__ __attribute__((aligned(16))) unsigned char lds_raw[];
    cg::grid_group grid = cg::this_grid();
    Ctx C;
    C.lds = (LAS unsigned char*)lds_raw; C.in = args.in; C.out = args.out; C.ws = args.ws;
    C.bid = blockIdx.x; C.G = gridDim.x;
    const int lo = args.ph_lo, hi = args.ph_hi;
    volatile LAS unsigned* MISC = (volatile LAS unsigned*)(C.lds + MISC_OFF);
    if (threadIdx.x < 2) MISC[threadIdx.x] = 0u;
    __syncthreads();
    XcdBarrier xbar = xcd_barrier_post((unsigned*)(C.ws + WS_CTL), MISC);
    if (lo < 0) grid.sync();
#define GRID_BAR() xcd_barrier(xbar)
    int ph = 0;
    for (int es_ = 0; es_ < EXTRA_SYNCS; ++es_) GRID_BAR();
#define PH_BEGIN if (ph >= lo && ph < hi) { const int nrep_ = ((DUPMASK >> ph) & 1ull) ? 2 : 1; for (int rep_ = 0; rep_ < nrep_; ++rep_) { if (rep_) GRID_BAR();
#ifdef NOSYNC
#define PH_END } } ++ph;
#else
#define PH_END   } if (ph + 1 < hi) GRID_BAR(); } ++ph;
#endif
    bf16* XN = (bf16*)(C.ws + WS_XN); bf16* PROJ = (bf16*)(C.ws + WS_PROJ); bf16* HID = (bf16*)(C.ws + WS_HID);
    bf16* WIN = (bf16*)(C.ws + WS_WIN); bf16* WOUT = (bf16*)(C.ws + WS_WOUT); bf16* WUP = (bf16*)(C.ws + WS_WUP); bf16* WDN = (bf16*)(C.ws + WS_WDN);
#pragma unroll 1
    for (int l = 0; l < DEPTH; ++l) {
        const int i = l >> 1; const bool even = (l & 1) == 0;
        PH_BEGIN

#ifndef SKIP_CONV
phase_convert(C, l);
#endif

            __syncthreads();
            if (l == 0) phase_norm<true, true>(C, args.in[8] + l * D, args.in[11] + (size_t)i * D * EPROJ + 3840, EPROJ, 0);
            else if (even) phase_norm<false, true>(C, args.in[8] + l * D, args.in[11] + (size_t)i * D * EPROJ + 3840, EPROJ, 16);
            else phase_norm<false, false>(C, args.in[8] + l * D, nullptr, 0, 16);
            __syncthreads();
        PH_END
        if (even) {

#ifndef SKIP_G1
PH_BEGIN { pg8::Gemm g{XN, WIN, M, 3840, D}; ProjAOrder S; S.init(C.G, C.bid); EpiProjA E{PROJ}; pg8::gemm_phase<EpiProjA, ProjAOrder, true, true>(C.lds, g, S, E); } PH_END
#endif

            PH_BEGIN
#ifndef SKIP_RPREP
phase_rwkv_prep(C, i); __syncthreads();
#endif
 PH_END

#ifndef SKIP_G2
PH_BEGIN { pg8::EpiBf16<0> E{PROJ, GPR, nullptr, 0, 0, 1.f}; pg8::Gemm g{XN, WIN + (size_t)RPROJ * D, MP, GPR, D}; pg8::StaticOrder S; S.init(MP, GPR, C.G, C.bid, D);
              pg8::gemm_phase<pg8::EpiBf16<0>, pg8::StaticOrder, true, true>(C.lds, g, S, E); } PH_END
#endif

            PH_BEGIN
#ifndef SKIP_GPREP
phase_gdn_prep(C, i); __syncthreads();
#endif
 PH_END
            PH_BEGIN
#ifndef SKIP_SCAN
phase_scan(C, i);
#endif
 PH_END
            PH_BEGIN
#ifndef SKIP_POST
phase_post(C, i);
#endif
 PH_END
        } else {

#ifndef SKIP_G3
PH_BEGIN { pg8::EpiBf16<0> E{PROJ, 2048, nullptr, 0, 0, 1.f}; run_gemm(C, XN, WIN, 2048, D, E); } PH_END
#endif

            PH_BEGIN
#ifndef SKIP_LPREP
phase_lru_prep(C, i);
#endif
 PH_END
            PH_BEGIN
#ifndef SKIP_LFIN
phase_lru_fin(C, i);
#endif
 PH_END
        }

#ifndef SKIP_GOUT
PH_BEGIN run_gemm_res(C, XN, WOUT, D, 4, l == 0 ? args.in[0] : nullptr); PH_END
#endif

        PH_BEGIN phase_norm<false, false>(C, args.in[9] + l * D, nullptr, 0, 4); PH_END

#ifndef SKIP_GUP
PH_BEGIN { pg8::EpiBf16<2> E{HID, FF, nullptr, 0, 0, 1.f}; run_gemm(C, XN, WUP, FF, D, E); } PH_END
#endif


#ifndef SKIP_GDN
PH_BEGIN run_gemm_res(C, HID, WDN, FF, 16, nullptr); PH_END
#endif

    }
    PH_BEGIN phase_final(C); PH_END
#undef PH_BEGIN
#undef PH_END
}
constexpr int NPHASES = 2 * (11 + 8) + 1;

#ifndef N_LAUNCH_MODE
#define N_LAUNCH_MODE 1
#endif

extern "C" void kernel_launch(void* const* d_in, const int* in_sizes, int n_in, void* d_out, int out_size, void* d_ws, size_t ws_size, hipStream_t stream) {
    static int grid = 0;
    if (grid == 0) {
        if (n_in != 39 || out_size != (int)O_END || ws_size < WS_TOTAL) { fprintf(stderr, "kernel_launch: unexpected shapes: n_in %d out %d ws %zu (need %zu)\n", n_in, out_size, ws_size, (size_t)WS_TOTAL); grid = -1; return; }
        int dev = 0, cus = 0, per_cu = 0;
        hipGetDevice(&dev); hipDeviceGetAttribute(&cus, hipDeviceAttributeMultiprocessorCount, dev);
        hipFuncSetAttribute((const void*)hybrid_fwd, hipFuncAttributeMaxDynamicSharedMemorySize, LDS_BYTES);
        hipOccupancyMaxActiveBlocksPerMultiprocessor(&per_cu, (const void*)hybrid_fwd, NTHR, LDS_BYTES);
        if (per_cu < 1) { fprintf(stderr, "kernel_launch: occupancy query says %d blocks per CU\n", per_cu); per_cu = 1; }
        (void)hipGetLastError();
        grid = cus;
    }
    if (grid < 0) return;
    if (hipMemsetAsync((char*)d_ws + WS_CTL, 0, CTL_BYTES, stream) != hipSuccess) { fprintf(stderr, "kernel_launch: memset of the barrier words failed\n"); return; }
    Args a{};
    for (int k = 0; k < 39; ++k) a.in[k] = (const float*)d_in[k];
    a.out = (float*)d_out; a.ws = (unsigned char*)d_ws;
#if N_LAUNCH_MODE == 1
    a.ph_lo = 0; a.ph_hi = NPHASES;
    void* kargs[] = {&a};
    hipError_t e = hipLaunchCooperativeKernel((const void*)hybrid_fwd, dim3(grid), dim3(NTHR), kargs, LDS_BYTES, stream);
    if (e != hipSuccess) fprintf(stderr, "cooperative launch failed: %s (grid %d)\n", hipGetErrorString(e), grid);
#else
    for (int p = 0; p < NPHASES; ++p) { a.ph_lo = p; a.ph_hi = p + 1; hipLaunchKernelGGL(hybrid_fwd, dim3(grid), dim3(NTHR), LDS_BYTES, stream, a); }
#endif
}
```

```cpp
#include <hip/hip_runtime.h>
#include <hip/hip_cooperative_groups.h>
#include <cstdio>
#include <cstdint>
namespace cg = cooperative_groups;
#define DUPMASK 0ull
#define EXTRA_SYNCS 0
namespace pg8 {
#define PG8_LAS __attribute__((address_space(3)))
typedef unsigned short bf16_t;
typedef short bf16x8 __attribute__((ext_vector_type(8)));
typedef float f32x4 __attribute__((ext_vector_type(4)));
typedef unsigned u32x4 __attribute__((ext_vector_type(4)));
constexpr int BM = 256, BK = 64, HALF = 128, HTB = HALF * BK * 2  , STAGE_BYTES = 8 * HTB, NXCD = 8, WGM = 8;

__host__ __device__ __forceinline__ int lds_byte(int r, int c) { const int st = (r >> 4) * 2 + (c >> 5), rr = r & 15, cc = c & 31, ob = rr * 64 + cc * 2; return st * 1024 + (ob ^ (((ob >> 9) & 1) << 5)); }
__host__ __device__ __forceinline__ void stage_rc(int b, int& R, int& C) { const int st = b / 1024, sb = b % 1024, swz = sb ^ (((sb >> 9) & 1) << 5); R = (st >> 1) * 16 + swz / 64; C = (st & 1) * 32 + (swz % 64) / 2; }
__host__ __device__ __forceinline__ int perm32(int rho) { const int n = rho >> 4, i = rho & 15; return 8 * (i >> 2) + 4 * n + (i & 3); }

struct Unit { int pm, pn, kofs, nt, atomic; };
struct Gemm { const bf16_t* A; const bf16_t* Bt; int M, N, K; };

struct StaticOrder {
    int nM, nN, nwg, G, c, ntK;
    __host__ __device__ void init(int M, int N, int G_, int c_, int K_) { nM = M / BM; nN = N / BM; nwg = nM * nN; G = G_; c = c_; ntK = K_ / BK; }
    __host__ __device__ bool next(int i, Unit& u) const {
        const long L = (long)i * G + c; if (L >= nwg) return false;
        int wgid = (int)L; { const int q = nwg / NXCD, r = nwg % NXCD, xcd = wgid % NXCD, off = wgid / NXCD; wgid = (xcd < r ? xcd * (q + 1) : r * (q + 1) + (xcd - r) * q) + off; }
        const int nig = WGM * nN, gid = wgid / nig, fm = gid * WGM, gsz = (nM - fm) < WGM ? (nM - fm) : WGM;
        u.pm = fm + ((wgid % nig) % gsz); u.pn = (wgid % nig) / gsz; u.kofs = 0; u.nt = ntK; u.atomic = 0; return true;
    }
    __device__ __forceinline__ void a_ready(const Unit&) const {}
    __device__ __forceinline__ void done(const Unit&) const {}
};

__device__ __forceinline__ unsigned cvt_pk_bf16(float lo, float hi) { unsigned r; asm volatile("v_cvt_pk_bf16_f32 %0, %1, %2" : "=v"(r) : "v"(lo), "v"(hi)); return r; }
typedef float f32x2 __attribute__((ext_vector_type(2)));
__device__ __forceinline__ f32x2 gelu_pk(f32x2 v) {
    const f32x2 av = __builtin_elementwise_abs(v), d = av * 0.2316418882f + 1.0f;
    f32x2 t; t.x = __builtin_amdgcn_rcpf(d.x); t.y = __builtin_amdgcn_rcpf(d.y);
    f32x2 q = t * 0.5307027145f + (-0.7265760135f); q = q * t + 0.7107068705f; q = q * t + (-0.142248368f); q = q * t + 0.127414796f; q = q * t;
    const f32x2 s = (v * v) * (-0.72134752044f);
    f32x2 e; e.x = __builtin_amdgcn_exp2f(s.x); e.y = __builtin_amdgcn_exp2f(s.y);
    const f32x2 m = v * (q * e), r = v - m;
    f32x2 o; o.x = v.x < 0.f ? m.x : r.x; o.y = v.y < 0.f ? m.y : r.y; return o;
}

template <int ACT  > struct EpiBf16 {
    static constexpr bool PERM = true, AFTER_DRAIN = false, HAS_INIT = false; static_assert(ACT == 0 || ACT == 1 || ACT == 2, "EpiBf16: ACT is 0 (none), 1 (gelu_pk) or 2 (squared relu)");
    bf16_t* O; int ldc; const float* bias; int split_cols; size_t split_stride; float scale0;
    __device__ __forceinline__ void operator()(const f32x4 (&acc)[2][2][4][2], const Unit& u, int wr, int wc, int fr, int fq) const {
        const int row0 = u.pm * BM + wr * 64 + fr; int colt = u.pn * BM; bf16_t* base = O;
        float sc = 1.f; if (split_cols) { const int t = colt / split_cols; base += (size_t)t * split_stride; colt -= t * split_cols; if (t == 0) sc = scale0; }
        const int col0 = colt + wc * 32 + 8 * fq, bcol0 = u.pn * BM + wc * 32 + 8 * fq;
        f32x4 bv[2][2];
#pragma unroll
        for (int bj = 0; bj < 2; ++bj)
#pragma unroll
            for (int n = 0; n < 2; ++n) bv[bj][n] = bias ? *(const f32x4*)(bias + bcol0 + bj * HALF + 4 * n) : (f32x4){0.f, 0.f, 0.f, 0.f};
#pragma unroll
        for (int ai = 0; ai < 2; ++ai)
#pragma unroll
            for (int m = 0; m < 4; ++m) { bf16_t* rowp = base + (size_t)(row0 + ai * HALF + m * 16) * ldc + col0;
#pragma unroll
                for (int bj = 0; bj < 2; ++bj) { f32x4 v0 = acc[ai][bj][m][0] + bv[bj][0], v1 = acc[ai][bj][m][1] + bv[bj][1];
                    if (ACT == 1) { f32x2 a = gelu_pk((f32x2){v0[0], v0[1]}), b = gelu_pk((f32x2){v0[2], v0[3]}), c = gelu_pk((f32x2){v1[0], v1[1]}), d = gelu_pk((f32x2){v1[2], v1[3]});
                        v0 = (f32x4){a.x, a.y, b.x, b.y}; v1 = (f32x4){c.x, c.y, d.x, d.y}; }
                    if (ACT == 2) {
#pragma unroll
                        for (int e = 0; e < 4; ++e) { const float p0 = v0[e] > 0.f ? v0[e] : 0.f, p1 = v1[e] > 0.f ? v1[e] : 0.f; v0[e] = p0 * p0; v1[e] = p1 * p1; } }
                    v0 = v0 * sc; v1 = v1 * sc; u32x4 w; w.x = cvt_pk_bf16(v0[0], v0[1]); w.y = cvt_pk_bf16(v0[2], v0[3]); w.z = cvt_pk_bf16(v1[0], v1[1]); w.w = cvt_pk_bf16(v1[2], v1[3]);
                    *(u32x4*)(rowp + bj * HALF) = w; } }
    }
};
template <class Epi, class Sched, bool ALIGN_EPI = false, bool SP2 = false>
__device__ __forceinline__ void gemm_phase(PG8_LAS unsigned char* lds, const Gemm g, const Sched& S, const Epi& E) {
    int tid_ = threadIdx.x; asm volatile("" : "+v"(tid_));
    const int tid = tid_, wid = __builtin_amdgcn_readfirstlane(tid >> 6), lane = tid & 63, wr = wid >> 2, wc = wid & 3, fr = lane & 15, fq = lane >> 4;
    const int K = g.K;
    unsigned voffA[2], voffB[2];
#pragma unroll
    for (int i = 0; i < 2; ++i) { int R, C; stage_rc(tid * 16 + i * 8192, R, C); const int Rb = Epi::PERM ? ((R & ~31) + perm32(R & 31)) : R;
        voffA[i] = (unsigned)(R * K + C) * 2u; voffB[i] = (unsigned)(Rb * K + C) * 2u; }
    const size_t kstep = (size_t)(BK * 2);
    const size_t hstep = (size_t)HALF * K * 2;
    const size_t tstep = 2 * hstep;
    const unsigned ldsw = (unsigned)wid * 1024u;
    const int aoff = lds_byte(wr * 64 + fr, fq * 8), boff = lds_byte(wc * 32 + fr, fq * 8);
#define PG8_SA(b, h) (((b) * 2 + (h)) * HTB)
#define PG8_SB(b, h) ((4 + (b) * 2 + (h)) * HTB)
#define PG8_STAGE(bufoff, gbase, voff) do { _Pragma("unroll") for (int _i = 0; _i < 2; ++_i) \
        __builtin_amdgcn_global_load_lds((const unsigned*)((const char*)(gbase) + (voff)[_i]), (PG8_LAS unsigned*)(lds + (bufoff) + ldsw + _i * 8192), 16, 0, 0); } while (0)
#define PG8_LDA(dst, b, h) do { _Pragma("unroll") for (int m = 0; m < 4; ++m) _Pragma("unroll") for (int k = 0; k < 2; ++k) dst[m][k] = *(const PG8_LAS bf16x8*)(lds + PG8_SA(b, h) + aoff + m * 2048 + k * 1024); } while (0)
#define PG8_LDB(dst, b, h) do { _Pragma("unroll") for (int n = 0; n < 2; ++n) _Pragma("unroll") for (int k = 0; k < 2; ++k) dst[n][k] = *(const PG8_LAS bf16x8*)(lds + PG8_SB(b, h) + boff + n * 2048 + k * 1024); } while (0)
#define PG8_MMA(ai, bj, At, Bt) do { __builtin_amdgcn_s_setprio(1); _Pragma("unroll") for (int m = 0; m < 4; ++m) _Pragma("unroll") for (int n = 0; n < 2; ++n) _Pragma("unroll") for (int k = 0; k < 2; ++k) \
        acc[ai][bj][m][n] = __builtin_amdgcn_mfma_f32_16x16x32_bf16(Bt[n][k], At[m][k], acc[ai][bj][m][n], 0, 0, 0); __builtin_amdgcn_s_setprio(0); } while (0)
#define PG8_WAIT_V(n) asm volatile("s_waitcnt vmcnt(" #n ")" ::: "memory")
#define PG8_WAIT_L(n) asm volatile("s_waitcnt lgkmcnt(" #n ")" ::: "memory")
#define PG8_BAR __builtin_amdgcn_s_barrier()
#define PG8_SCHED __builtin_amdgcn_sched_barrier(0)
    Unit cur, nxt; int ui = 0;
    if (!S.next(0, cur)) return;
    f32x4 acc[2][2][4][2];
    if constexpr (Epi::HAS_INIT) E.init(acc, cur, wr, wc, fr, fq);
    else {
#pragma unroll
    for (int a = 0; a < 2; ++a)
#pragma unroll
        for (int b = 0; b < 2; ++b)
#pragma unroll
            for (int m = 0; m < 4; ++m)
#pragma unroll
                for (int n = 0; n < 2; ++n) acc[a][b][m][n] = (f32x4){0.f, 0.f, 0.f, 0.f};
    }
    bf16x8 At[4][2], B0[2][2], B1[2][2];
    const char* cA = (const char*)g.A + (size_t)cur.pm * tstep + (size_t)cur.kofs * 2; const char* cB = (const char*)g.Bt + (size_t)cur.pn * tstep + (size_t)cur.kofs * 2;
    S.a_ready(cur);
    if constexpr (SP2) {
        PG8_STAGE(PG8_SB(0, 0), cB, voffB); PG8_STAGE(PG8_SB(0, 1), cB + hstep, voffB); PG8_STAGE(PG8_SA(0, 0), cA, voffA); PG8_STAGE(PG8_SA(0, 1), cA + hstep, voffA);
        if (wr == 1) PG8_BAR;
        PG8_WAIT_V(2); PG8_BAR;
        PG8_STAGE(PG8_SB(1, 0), cB + kstep, voffB); PG8_STAGE(PG8_SA(1, 0), cA + kstep, voffA); PG8_STAGE(PG8_SB(1, 1), cB + hstep + kstep, voffB);
        PG8_WAIT_V(6); PG8_BAR;
    } else {
        PG8_STAGE(PG8_SB(0, 0), cB, voffB); PG8_STAGE(PG8_SA(0, 0), cA, voffA); PG8_STAGE(PG8_SB(0, 1), cB + hstep, voffB); PG8_STAGE(PG8_SA(0, 1), cA + hstep, voffA);
        if (wr == 1) PG8_BAR;
        PG8_WAIT_V(4); PG8_BAR;
        PG8_STAGE(PG8_SB(1, 0), cB + kstep, voffB); PG8_STAGE(PG8_SA(1, 0), cA + kstep, voffA); PG8_STAGE(PG8_SB(1, 1), cB + hstep + kstep, voffB);
        PG8_WAIT_V(6); PG8_BAR;
    }
    for (;;) {
        const bool has_next = S.next(ui + 1, nxt);
        const char* nA = has_next ? (const char*)g.A + (size_t)nxt.pm * tstep + (size_t)nxt.kofs * 2 : cA; const char* nB = has_next ? (const char*)g.Bt + (size_t)nxt.pn * tstep + (size_t)nxt.kofs * 2 : cB;
        const int nt = cur.nt;
        for (int t = 0; t < nt; t += 2) {
            const bool last = (t == nt - 2);
            const char* a1 = cA + (size_t)(t + 1) * kstep;
            const char* a2 = last ? nA : cA + (size_t)(t + 2) * kstep; const char* b2 = last ? nB : cB + (size_t)(t + 2) * kstep;
            const char* a3 = a2 + kstep; const char* b3 = b2 + kstep;
            if (last && has_next) S.a_ready(nxt);
            if constexpr (SP2) {
            PG8_LDB(B0, 0, 0); PG8_LDB(B1, 0, 1); PG8_SCHED; PG8_LDA(At, 0, 0); PG8_STAGE(PG8_SA(1, 1), a1 + hstep, voffA);
            PG8_WAIT_V(8); PG8_WAIT_L(0); PG8_BAR; PG8_MMA(0, 0, At, B0); PG8_MMA(0, 1, At, B1); PG8_BAR; PG8_SCHED;
            PG8_LDA(At, 0, 1); PG8_STAGE(PG8_SB(0, 0), b2, voffB); PG8_STAGE(PG8_SB(0, 1), b2 + hstep, voffB); PG8_STAGE(PG8_SA(0, 0), a2, voffA);
            PG8_WAIT_V(8); PG8_WAIT_L(0); PG8_BAR; PG8_MMA(1, 0, At, B0); PG8_MMA(1, 1, At, B1); PG8_BAR; PG8_SCHED;
            PG8_LDB(B0, 1, 0); PG8_LDB(B1, 1, 1); PG8_SCHED; PG8_LDA(At, 1, 0); PG8_STAGE(PG8_SA(0, 1), a2 + hstep, voffA);
            PG8_WAIT_V(8); PG8_WAIT_L(0); PG8_BAR; PG8_MMA(0, 0, At, B0); PG8_MMA(0, 1, At, B1); PG8_BAR; PG8_SCHED;
            PG8_LDA(At, 1, 1); PG8_STAGE(PG8_SB(1, 0), b3, voffB); PG8_STAGE(PG8_SB(1, 1), b3 + hstep, voffB); PG8_STAGE(PG8_SA(1, 0), a3, voffA);
            PG8_WAIT_V(8); PG8_WAIT_L(0); PG8_BAR; PG8_MMA(1, 0, At, B0); PG8_MMA(1, 1, At, B1); PG8_BAR; PG8_SCHED;
            } else {
            PG8_LDB(B0, 0, 0); PG8_SCHED; PG8_LDA(At, 0, 0); PG8_STAGE(PG8_SA(1, 1), a1 + hstep, voffA);
            PG8_WAIT_L(8); PG8_BAR; PG8_WAIT_L(0); PG8_MMA(0, 0, At, B0); PG8_BAR; PG8_SCHED;
            PG8_LDB(B1, 0, 1); PG8_STAGE(PG8_SB(0, 0), b2, voffB);
            PG8_BAR; PG8_WAIT_L(0); PG8_MMA(0, 1, At, B1); PG8_BAR;
            PG8_LDA(At, 0, 1); PG8_STAGE(PG8_SA(0, 0), a2, voffA);
            PG8_BAR; PG8_WAIT_L(0); PG8_MMA(1, 0, At, B0); PG8_BAR; PG8_SCHED;
            PG8_STAGE(PG8_SB(0, 1), b2 + hstep, voffB);
            PG8_WAIT_V(6); PG8_BAR; PG8_MMA(1, 1, At, B1); PG8_BAR;
            PG8_LDB(B0, 1, 0); PG8_SCHED; PG8_LDA(At, 1, 0); PG8_STAGE(PG8_SA(0, 1), a2 + hstep, voffA);
            PG8_WAIT_L(8); PG8_BAR; PG8_WAIT_L(0); PG8_MMA(0, 0, At, B0); PG8_BAR; PG8_SCHED;
            PG8_LDB(B1, 1, 1); PG8_STAGE(PG8_SB(1, 0), b3, voffB);
            PG8_BAR; PG8_WAIT_L(0); PG8_MMA(0, 1, At, B1); PG8_BAR;
            PG8_LDA(At, 1, 1); PG8_STAGE(PG8_SA(1, 0), a3, voffA);
            PG8_BAR; PG8_WAIT_L(0); PG8_MMA(1, 0, At, B0); PG8_BAR; PG8_SCHED;
            PG8_STAGE(PG8_SB(1, 1), b3 + hstep, voffB);
            PG8_WAIT_V(6); PG8_BAR; PG8_MMA(1, 1, At, B1); PG8_BAR;
            }
        }
        if constexpr (ALIGN_EPI) { if (wr == 0) PG8_BAR; }
        if constexpr (!Epi::AFTER_DRAIN) { E(acc, cur, wr, wc, fr, fq); S.done(cur); }
        if (!has_next) break;
        if constexpr (Epi::HAS_INIT) E.init(acc, nxt, wr, wc, fr, fq);
        else {
#pragma unroll
        for (int a = 0; a < 2; ++a)
#pragma unroll
            for (int b = 0; b < 2; ++b)
#pragma unroll
                for (int m = 0; m < 4; ++m)
#pragma unroll
                    for (int n = 0; n < 2; ++n) acc[a][b][m][n] = (f32x4){0.f, 0.f, 0.f, 0.f};
        }
        cur = nxt; cA = nA; cB = nB; ++ui;
        if constexpr (ALIGN_EPI) { if (wr == 1) PG8_BAR; }
    }
    PG8_WAIT_V(0);
    if constexpr (!ALIGN_EPI) { if (wr == 0) PG8_BAR; }
    PG8_BAR;
    if constexpr (Epi::AFTER_DRAIN) { E.fused(acc, cur, wr, wc, fr, fq, lds, wid, lane); S.done(cur); }
#undef PG8_SA
#undef PG8_SB
#undef PG8_STAGE
#undef PG8_LDA
#undef PG8_LDB
#undef PG8_MMA
#undef PG8_WAIT_V
#undef PG8_WAIT_L
#undef PG8_BAR
#undef PG8_SCHED
}
}

#define LAS __attribute__((address_space(3)))
typedef unsigned short bf16;
typedef unsigned v4u __attribute__((ext_vector_type(4)));
typedef unsigned v2u __attribute__((ext_vector_type(2)));
typedef float f32x4 __attribute__((ext_vector_type(4)));
typedef float f32x2 __attribute__((ext_vector_type(2)));
typedef short bf16x8 __attribute__((ext_vector_type(8)));

constexpr int NWAVES = 8, NTHR = 512;
constexpr int D = 1024, MP = 16384, MS = 1024, M = MP + MS, TP = 2048, NB = 8, SB = 128, TS = 8, DEPTH = 4;
constexpr int RH = 8, RHD = 64, RW = 512, RPROJ = 1792;
constexpr int GH = 4, GHD = 128, GW = 512, GQKV = 1536, GPR = 2048;
constexpr int EPROJ = 3848, FF = 4096;
constexpr int NSEQ = NB + SB;

constexpr size_t O_Y = 0;
constexpr size_t O_RWKV_P = (size_t)M * D;
constexpr size_t O_RWKV_S = O_RWKV_P + (size_t)2 * NB * RH * 4096;
constexpr size_t O_SH_P = O_RWKV_S + (size_t)2 * SB * RH * 4096;
constexpr size_t O_SH_S = O_SH_P + (size_t)2 * NB * RPROJ;
constexpr size_t O_GDN_P = O_SH_S + (size_t)2 * SB * RPROJ;
constexpr size_t O_GDN_S = O_GDN_P + (size_t)2 * NB * GH * 16384;
constexpr size_t O_GC_P = O_GDN_S + (size_t)2 * SB * GH * 16384;
constexpr size_t O_GC_S = O_GC_P + (size_t)2 * NB * 3 * GQKV;
constexpr size_t O_LRU_P = O_GC_S + (size_t)2 * SB * 3 * GQKV;
constexpr size_t O_LRU_S = O_LRU_P + (size_t)2 * NB * D;
constexpr size_t O_LC_P = O_LRU_S + (size_t)2 * SB * D;
constexpr size_t O_LC_S = O_LC_P + (size_t)2 * NB * 3 * D;
constexpr size_t O_END = O_LC_S + (size_t)2 * SB * 3 * D;
static_assert(O_END == 47419392, "output size");

constexpr size_t MiB = 1u << 20;
constexpr size_t WS_WIN = 0, WS_WOUT = 8 * MiB, WS_WUP = 10 * MiB, WS_WDN = 18 * MiB, WS_WA = 26 * MiB, WS_WI = 26 * MiB + 512 * 1024;
constexpr size_t WS_CTL = 27 * MiB, CTL_BYTES = 16384;
constexpr size_t WS_W2T = 26 * MiB, WS_A2T = 26 * MiB + 65536, WS_G2T = 26 * MiB + 131072;
constexpr size_t WS_XN = 28 * MiB;
constexpr size_t WS_PROJ = 62 * MiB;
constexpr size_t WS_YRAW = WS_PROJ, WS_ORAW = WS_PROJ + 34 * MiB;
constexpr size_t WS_SCN = 130 * MiB;
constexpr size_t A17 = 17 * MiB;
constexpr size_t WS_RU = WS_SCN, WS_RA = WS_SCN + A17, WS_RB = WS_SCN + 2 * A17, WS_RK = WS_SCN + 3 * A17, WS_RWR = WS_SCN + 4 * A17, WS_RV = WS_SCN + 5 * A17, WS_RG = WS_SCN + 6 * A17;
constexpr size_t WS_GQ = WS_SCN + 7 * A17, WS_GK = WS_SCN + 8 * A17, WS_GV = WS_SCN + 9 * A17, WS_GZ = WS_SCN + 10 * A17;
constexpr size_t WS_RSC = WS_SCN + 11 * A17;
constexpr size_t WS_GSC = WS_RSC + 3 * MiB;
constexpr size_t WS_P8 = WS_GSC + 2 * MiB;
constexpr size_t WS_END_EVEN = WS_P8 + 1 * MiB;
constexpr size_t WS_LP = WS_SCN, WS_LH = WS_SCN + 68 * MiB, WS_LTOT = WS_SCN + 136 * MiB;
constexpr size_t WS_HID = WS_PROJ;
constexpr size_t WS_PART = 200 * MiB;
constexpr size_t WS_H = WS_END_EVEN;
constexpr size_t WS_TOTAL = WS_H + 34 * MiB;
static_assert(WS_PART >= WS_HID + (size_t)M * FF * 2 && WS_PART + 64 * MiB <= WS_TOTAL, "PART placement");
static_assert(WS_HID + (size_t)M * FF * 2 <= WS_TOTAL && WS_LTOT + 544 * 1024 * 8 <= WS_TOTAL, "ws map");

constexpr int LDS_BYTES = 147456, MISC_OFF = 131072 + 256;

struct Args { const float* in[39]; float* out; unsigned char* ws; int ph_lo, ph_hi; };

__device__ __forceinline__ float bf2f(bf16 b) { return __builtin_bit_cast(float, (unsigned)b << 16); }
__device__ __forceinline__ float bflo(unsigned w) { return __builtin_bit_cast(float, w << 16); }
__device__ __forceinline__ float bfhi(unsigned w) { return __builtin_bit_cast(float, w & 0xffff0000u); }
__device__ __forceinline__ unsigned f2bf(float f) { unsigned u = __builtin_bit_cast(unsigned, f); return (u + 0x7fffu + ((u >> 16) & 1u)) >> 16; }
__device__ __forceinline__ unsigned pk2(float lo, float hi) { return f2bf(lo) | (f2bf(hi) << 16); }
__device__ __forceinline__ float wave_sum(float v) {
#pragma unroll
    for (int o = 1; o < 64; o <<= 1) v += __shfl_xor(v, o);
    return v;
}
template <int CTRL> __device__ __forceinline__ float dppf(float x) { return __builtin_bit_cast(float, __builtin_amdgcn_update_dpp(0, __builtin_bit_cast(int, x), CTRL, 0xf, 0xf, false)); }
__device__ __forceinline__ float allsum16(float x) { x += dppf<0x128>(x); x += dppf<0x124>(x); x += dppf<0x122>(x); x += dppf<0x121>(x); return x; }
__device__ __forceinline__ float sigmoidf_(float x) { return __builtin_amdgcn_rcpf(1.0f + __expf(-x)); }
__device__ __forceinline__ float softplusf_(float x) { return fmaxf(x, 0.f) + log1pf(__expf(-fabsf(x))); }
__device__ __forceinline__ float siluf_(float x) { return x * __builtin_amdgcn_rcpf(1.0f + __expf(-x)); }
__device__ __forceinline__ float tanhf_(float x) { return 1.0f - 2.0f * __builtin_amdgcn_rcpf(1.0f + __expf(2.0f * x)); }
#define LDS_WAIT() asm volatile("s_waitcnt lgkmcnt(0)" ::: "memory")

#define XB_TMO      128
#define XB_XCNT(j)  (256  + 64 * (j))
#define XB_XSUB(j)  (1280 + 64 * (j))
#define XB_XGEN(j)  (2304 + 64 * (j))
#define XB_TOP      3328
#define XB_TOPGEN   3392
#define XCD_BAR_WORDS 3456
#define XB_SPIN_CAP (1u << 18)

__device__ __forceinline__ unsigned xb_ld(unsigned* p)              { return __hip_atomic_load(p, __ATOMIC_RELAXED, __HIP_MEMORY_SCOPE_AGENT); }
__device__ __forceinline__ unsigned xb_add(unsigned* p, unsigned v) { return __hip_atomic_fetch_add(p, v, __ATOMIC_RELAXED, __HIP_MEMORY_SCOPE_AGENT); }
__device__ __forceinline__ unsigned xb_xcc_id() { return (unsigned)__builtin_amdgcn_s_getreg((3 << 11) | 20) & 0xFu; }
#define XB_SPIN(cond, bar) do { unsigned _sp = 0; while (cond) { __builtin_amdgcn_s_sleep(1); \
    if ((++_sp & 255u) == 0u) { if (xb_ld(&(bar)[XB_TMO])) break; if (_sp > XB_SPIN_CAP) { atomicAdd(&(bar)[XB_TMO], 1u); break; } } } } while (0)

struct XcdBarrier {
    unsigned* bar; unsigned x;
    volatile LAS unsigned* st;
};

__device__ __forceinline__ XcdBarrier xcd_barrier_post(unsigned* bar, volatile LAS unsigned* st) {
    XcdBarrier b; b.bar = bar; b.x = xb_xcc_id(); b.st = st;
    if (threadIdx.x == 0) (void)xb_add(&bar[XB_XCNT(b.x)], 1u);
    return b;
}
__device__ __forceinline__ void xcd_barrier_complete(unsigned* bar, unsigned x, unsigned& nloc, unsigned& nx) {
    const unsigned G = gridDim.x * gridDim.y * gridDim.z;
    unsigned sum, cnt, mine, sp = 0u;
    for (;;) {
        sum = 0u; cnt = 0u; mine = 0u;
#pragma unroll
        for (unsigned j = 0; j < 16; ++j) { const unsigned c = xb_ld(&bar[XB_XCNT(j)]); sum += c; cnt += (c > 0u) ? 1u : 0u; mine = (j == x) ? c : mine; }
        if (sum == G) break;
        __builtin_amdgcn_s_sleep(1);
        if ((++sp & 255u) == 0u) { if (xb_ld(&bar[XB_TMO])) break; if (sp > XB_SPIN_CAP) { atomicAdd(&bar[XB_TMO], 1u); break; } }
    }
    nloc = mine > 0u ? mine : 1u; nx = cnt > 0u ? cnt : 1u;
}

__device__ __forceinline__ void xcd_barrier(const XcdBarrier& b) {
    asm volatile("s_waitcnt vmcnt(0)" ::: "memory");
    __syncthreads();
    if (threadIdx.x == 0) {
        unsigned* bar = b.bar;
        __builtin_amdgcn_s_waitcnt(0);
        unsigned nloc = b.st[0], nx = b.st[1];
        if (nloc == 0u) { xcd_barrier_complete(bar, b.x, nloc, nx); b.st[0] = nloc; b.st[1] = nx; }
        const unsigned old = xb_add(&bar[XB_XSUB(b.x)], 1u);
        const unsigned gen = old / nloc;
        if (old + 1u == (gen + 1u) * nloc) {
            __builtin_amdgcn_fence(__ATOMIC_RELEASE, "agent");
            asm volatile("s_waitcnt vmcnt(0)" ::: "memory");
            const unsigned og = xb_add(&bar[XB_TOP], 1u);
            const unsigned tg = og / nx;
            if (og + 1u == (tg + 1u) * nx) xb_add(&bar[XB_TOPGEN], 1u);
            else XB_SPIN(xb_ld(&bar[XB_TOPGEN]) == tg, bar);
            __builtin_amdgcn_fence(__ATOMIC_ACQUIRE, "agent");
            xb_add(&bar[XB_XGEN(b.x)], 1u);
            asm volatile("s_waitcnt vmcnt(0)" ::: "memory");
        } else {
            XB_SPIN(xb_ld(&bar[XB_XGEN(b.x)]) == gen, bar);
            __builtin_amdgcn_fence(__ATOMIC_ACQUIRE, "agent");
            asm volatile("s_waitcnt vmcnt(0)" ::: "memory");
        }
    }
    __syncthreads();
}

struct Ctx {
    LAS unsigned char* lds;
    const float* const* in;
    float* out; unsigned char* ws;
    int bid, G;
};
#define PHASE_IDS int tid = threadIdx.x; asm volatile("" : "+v"(tid)); const int lane = tid & 63; const int wave = __builtin_amdgcn_readfirstlane(tid >> 6); (void)lane; (void)wave;

__device__ __forceinline__ void transpose_item(const float* W, int ldw, int K, int N, bf16* WT, LAS float* scr, int item, int lane) {
    const int nblk = N / 32, kb = item / nblk, nb = item % nblk, k0 = 64 * kb, n0 = 32 * nb;
#pragma unroll 8
    for (int i = 0; i < 32; ++i) { const int kk = 2 * i + (lane >> 5); scr[kk * 33 + (lane & 31)] = W[(size_t)(k0 + kk) * ldw + n0 + (lane & 31)]; }
    LDS_WAIT(); asm volatile("" ::: "memory");
    const int c = lane & 7;
#pragma unroll
    for (int j = 0; j < 4; ++j) { const int n = (lane >> 3) + 8 * j; const LAS float* s = scr + (8 * c) * 33 + n;
        v4u o; o.x = pk2(s[0 * 33], s[1 * 33]); o.y = pk2(s[2 * 33], s[3 * 33]); o.z = pk2(s[4 * 33], s[5 * 33]); o.w = pk2(s[6 * 33], s[7 * 33]);
        *(v4u*)(WT + (size_t)(n0 + n) * K + k0 + 8 * c) = o; }
    LDS_WAIT(); asm volatile("" ::: "memory");
}

__device__ __forceinline__ void phase_convert(Ctx& C, int l) {
    PHASE_IDS
    const int i = l >> 1; const bool even = (l & 1) == 0;
    LAS float* scr = (LAS float*)(C.lds + wave * 8448);
    const int gw = C.bid * NWAVES + wave, NGW = C.G * NWAVES;
    bf16* WIN = (bf16*)(C.ws + WS_WIN); bf16* WOUT = (bf16*)(C.ws + WS_WOUT); bf16* WUP = (bf16*)(C.ws + WS_WUP); bf16* WDN = (bf16*)(C.ws + WS_WDN);
    const float* up = C.in[37] + (size_t)l * D * FF; const float* dn = C.in[38] + (size_t)l * FF * D;
    const int NIN = even ? 3840 : 2048, LDIN = even ? EPROJ : 2048;
    const float* win = even ? C.in[11] + (size_t)i * D * EPROJ : C.in[28] + (size_t)i * D * 2048;
    const float* wout = even ? C.in[12] + (size_t)i * D * D : C.in[29] + (size_t)i * D * D;
    const int I_IN = (D / 64) * (NIN / 32), I_OUT = (D / 64) * (D / 32), I_UP = (D / 64) * (FF / 32), I_DN = (FF / 64) * (D / 32), I_G = even ? 0 : 8 * 8, I_L = even ? 16 : 0;
    const int NITEMS = I_IN + I_OUT + I_UP + I_DN + 2 * I_G + 4 * I_L;
    for (int it = gw; it < NITEMS; it += NGW) {
        int r = it;
        if (r < I_IN) { transpose_item(win, LDIN, D, NIN, WIN, scr, r, lane); continue; } r -= I_IN;
        if (r < I_OUT) { transpose_item(wout, D, D, D, WOUT, scr, r, lane); continue; } r -= I_OUT;
        if (r < I_UP) { transpose_item(up, FF, D, FF, WUP, scr, r, lane); continue; } r -= I_UP;
        if (r < I_DN) { transpose_item(dn, D, FF, D, WDN, scr, r, lane); continue; } r -= I_DN;
        if (even) {
            if (r < I_L) { transpose_item(C.in[15] + (size_t)i * 64 * RW, RW, 64, RW, (bf16*)(C.ws + WS_W2T), scr, r, lane); continue; } r -= I_L;
            if (r < I_L) { transpose_item(C.in[17] + (size_t)i * 64 * RW, RW, 64, RW, (bf16*)(C.ws + WS_A2T), scr, r, lane); continue; } r -= I_L;
            transpose_item(C.in[18] + (size_t)i * 128 * RW, RW, 128, RW, (bf16*)(C.ws + WS_G2T), scr, r, lane); continue;
        }
        if (r < I_G) { const int h = r >> 3; transpose_item(C.in[32] + (size_t)(i * 8 + h) * 16384, 128, 128, 128, (bf16*)(C.ws + WS_WA) + h * 16384, scr, r & 7, lane); continue; } r -= I_G;
        { const int h = r >> 3; transpose_item(C.in[34] + (size_t)(i * 8 + h) * 16384, 128, 128, 128, (bf16*)(C.ws + WS_WI) + h * 16384, scr, r & 7, lane); }
    }
}

template <bool FIRST, bool P8>
__device__ __forceinline__ void phase_norm(Ctx& C, const float* nw, const float* w8src  , int ld8, int npart) {
    PHASE_IDS
    LAS float* w8 = (LAS float*)(C.lds + 96 * 1024);
    if (P8) {
        for (int idx = tid; idx < 8192; idx += NTHR) w8[idx] = w8src[(size_t)(idx >> 3) * ld8 + (idx & 7)];
        __syncthreads();
    }
    const int gw = C.bid * NWAVES + wave, NGW = C.G * NWAVES;
    bf16* XN = (bf16*)(C.ws + WS_XN); float* P8o = (float*)(C.ws + WS_P8);
    f32x4 wv[4];
#pragma unroll
    for (int j = 0; j < 4; ++j) wv[j] = *(const f32x4*)(nw + 4 * lane + 256 * j);
    for (int m = gw; m < M; m += NGW) {
        bf16* hrow = (bf16*)(C.ws + WS_H) + (size_t)m * D + 4 * lane;
        f32x4 v[4]; float ss = 0.f;
        if (FIRST) { const float* src = (m < MP ? C.in[0] + (size_t)m * D : C.in[1] + (size_t)(m - MP) * D);
#pragma unroll
            for (int j = 0; j < 4; ++j) v[j] = *(const f32x4*)(src + 4 * lane + 256 * j); }
        else {
#pragma unroll
            for (int j = 0; j < 4; ++j) { const v2u hw = *(const v2u*)(hrow + 256 * j); v[j] = (f32x4){bflo(hw.x), bfhi(hw.x), bflo(hw.y), bfhi(hw.y)}; } }
        if (!FIRST && m >= MP && npart > 0) {
            const bf16* pp = (const bf16*)(C.ws + WS_PART) + (size_t)(m - MP) * D + 4 * lane;
            for (int ks = 0; ks < npart; ++ks) {
#pragma unroll
                for (int j = 0; j < 4; ++j) { const v2u pw = *(const v2u*)(pp + (size_t)ks * MS * D + 256 * j); v[j] += (f32x4){bflo(pw.x), bfhi(pw.x), bflo(pw.y), bfhi(pw.y)}; } }
#pragma unroll
            for (int j = 0; j < 4; ++j) { v2u hw; hw.x = pk2(v[j].x, v[j].y); hw.y = pk2(v[j].z, v[j].w); *(v2u*)(hrow + 256 * j) = hw; }
        }
#pragma unroll
        for (int j = 0; j < 4; ++j) ss += (v[j].x * v[j].x + v[j].y * v[j].y) + (v[j].z * v[j].z + v[j].w * v[j].w);
        if (FIRST && m >= MP) {
#pragma unroll
            for (int j = 0; j < 4; ++j) { v2u hw; hw.x = pk2(v[j].x, v[j].y); hw.y = pk2(v[j].z, v[j].w); *(v2u*)(hrow + 256 * j) = hw; }
        }
        const float rs = rsqrtf(wave_sum(ss) * (1.f / D) + 1e-6f);
        float d8[8];
#pragma unroll
        for (int q = 0; q < 8; ++q) d8[q] = 0.f;
#pragma unroll
        for (int j = 0; j < 4; ++j) {
            v[j] = v[j] * rs * wv[j];
            v2u o; o.x = pk2(v[j].x, v[j].y); o.y = pk2(v[j].z, v[j].w);
            *(v2u*)(XN + (size_t)m * D + 4 * lane + 256 * j) = o;
            if (P8) {
#pragma unroll
                for (int e = 0; e < 4; ++e) { const int k = 4 * lane + 256 * j + e; const f32x4 a = *(const LAS f32x4*)(w8 + k * 8), b = *(const LAS f32x4*)(w8 + k * 8 + 4); const float x = v[j][e];
                    d8[0] += x * a.x; d8[1] += x * a.y; d8[2] += x * a.z; d8[3] += x * a.w; d8[4] += x * b.x; d8[5] += x * b.y; d8[6] += x * b.z; d8[7] += x * b.w; }
            }
        }
        if (P8) {
#pragma unroll
            for (int q = 0; q < 8; ++q) d8[q] = wave_sum(d8[q]);
            if (lane == 0) { *(f32x4*)(P8o + (size_t)m * 8) = (f32x4){d8[0], d8[1], d8[2], d8[3]}; *(f32x4*)(P8o + (size_t)m * 8 + 4) = (f32x4){d8[4], d8[5], d8[6], d8[7]}; }
        }
    }
}

__device__ __forceinline__ void phase_final(Ctx& C) {
    PHASE_IDS
    const int gw = C.bid * NWAVES + wave, NGW = C.G * NWAVES; const float* nw = C.in[10];
    f32x4 wv[4];
#pragma unroll
    for (int j = 0; j < 4; ++j) wv[j] = *(const f32x4*)(nw + 4 * lane + 256 * j);
    for (int m = gw; m < M; m += NGW) {
        float* row = C.out + (size_t)m * D; f32x4 v[4]; float ss = 0.f; const bf16* hrow = (const bf16*)(C.ws + WS_H) + (size_t)m * D + 4 * lane;
#pragma unroll
        for (int j = 0; j < 4; ++j) { const v2u hw = *(const v2u*)(hrow + 256 * j); v[j] = (f32x4){bflo(hw.x), bfhi(hw.x), bflo(hw.y), bfhi(hw.y)}; }
        if (m >= MP) { const bf16* pp = (const bf16*)(C.ws + WS_PART) + (size_t)(m - MP) * D + 4 * lane;
            for (int ks = 0; ks < 16; ++ks) {
#pragma unroll
                for (int j = 0; j < 4; ++j) { const v2u pw = *(const v2u*)(pp + (size_t)ks * MS * D + 256 * j); v[j] += (f32x4){bflo(pw.x), bfhi(pw.x), bflo(pw.y), bfhi(pw.y)}; } } }
#pragma unroll
        for (int j = 0; j < 4; ++j) ss += (v[j].x * v[j].x + v[j].y * v[j].y) + (v[j].z * v[j].z + v[j].w * v[j].w);
        const float rs = rsqrtf(wave_sum(ss) * (1.f / D) + 1e-6f);
#pragma unroll
        for (int j = 0; j < 4; ++j) *(f32x4*)(row + 4 * lane + 256 * j) = v[j] * rs * wv[j];
    }
}

struct EpiRes {
    static constexpr bool PERM = false, AFTER_DRAIN = false, HAS_INIT = true;
    bf16* H; bf16* PART; const float* Hin;
    __device__ __forceinline__ void init(pg8::f32x4 (&acc)[2][2][4][2], const pg8::Unit& u, int wr, int wc, int fr, int fq) const {
        const size_t uo = (size_t)(u.pm * 256 + wr * 64) * D + u.pn * 256 + wc * 32;
        const float* ub = Hin + uo; const bf16* ubh = H + uo;
        const int loff = fr * D + 4 * fq;
#pragma unroll
        for (int ai = 0; ai < 2; ++ai)
#pragma unroll
            for (int m = 0; m < 4; ++m) { const float* rowp = ub + (size_t)(ai * 128 + m * 16) * D; const bf16* rowh = ubh + (size_t)(ai * 128 + m * 16) * D;
#pragma unroll
                for (int bj = 0; bj < 2; ++bj)
#pragma unroll
                    for (int n = 0; n < 2; ++n) { if (u.atomic) acc[ai][bj][m][n] = (pg8::f32x4){0.f, 0.f, 0.f, 0.f}; else if (Hin) { const f32x4 o = *(const f32x4*)(rowp + loff + bj * 128 + n * 16); acc[ai][bj][m][n] = (pg8::f32x4){o.x, o.y, o.z, o.w}; }
                        else { const v2u hw = *(const v2u*)(rowh + loff + bj * 128 + n * 16); acc[ai][bj][m][n] = (pg8::f32x4){bflo(hw.x), bfhi(hw.x), bflo(hw.y), bfhi(hw.y)}; } } }
    }
    __device__ __forceinline__ void operator()(const pg8::f32x4 (&acc)[2][2][4][2], const pg8::Unit& u, int wr, int wc, int fr, int fq) const {
        const int row0 = u.pm * 256 + wr * 64 + fr, col0 = u.pn * 256 + wc * 32 + 4 * fq;
#pragma unroll
        for (int ai = 0; ai < 2; ++ai)
#pragma unroll
            for (int m = 0; m < 4; ++m) { const size_t ro = (size_t)(row0 + ai * 128 + m * 16) * D + col0;
#pragma unroll
                for (int bj = 0; bj < 2; ++bj)
#pragma unroll
                    for (int n = 0; n < 2; ++n) { const size_t eo = ro + bj * 128 + n * 16; const pg8::f32x4 a = acc[ai][bj][m][n]; v2u pw; pw.x = pk2(a[0], a[1]); pw.y = pk2(a[2], a[3]);
                        if (u.atomic) { *(v2u*)(PART + ((size_t)(u.atomic - 1) * MS * D) + eo - (size_t)MP * D) = pw; }
                        else { *(v2u*)(H + eo) = pw; } } }
    }
};

struct SplitOrder {
    pg8::StaticOrder base; int nsplit, K, c;
    __device__ void init(int N, int G_, int c_, int K_, int nsplit_) { base.init(MP, N, G_, c_, K_); nsplit = nsplit_; K = K_; c = c_; }
    __device__ bool next(int i, pg8::Unit& u) const {
        if (i == 0) return base.next(0, u);
        if (i == 1 && c < 16 * nsplit) { const int tile = c / nsplit, ks = c - tile * nsplit; u.pm = 64 + (tile >> 2); u.pn = tile & 3; u.kofs = ks * (K / nsplit); u.nt = K / nsplit / 64; u.atomic = ks + 1; return true; }
        return false;
    }
    __device__ __forceinline__ void a_ready(const pg8::Unit&) const {}
    __device__ __forceinline__ void done(const pg8::Unit&) const {}
};
__device__ __forceinline__ void run_gemm_res(Ctx& C, const bf16* A, const bf16* Bt, int K, int nsplit, const float* hin) {
    pg8::Gemm g{A, Bt, M, D, K}; SplitOrder S; S.init(D, C.G, C.bid, K, nsplit); EpiRes E{(bf16*)(C.ws + WS_H), (bf16*)(C.ws + WS_PART), hin};
    pg8::gemm_phase<EpiRes, SplitOrder, true, true>(C.lds, g, S, E);
}
struct ProjAOrder {
    pg8::StaticOrder base; int G, c;
    __device__ void init(int G_, int c_) { base.init(M, RPROJ, G_, c_, D); G = G_; c = c_; }
    __device__ bool next(int i, pg8::Unit& u) const {
        if (base.next(i, u)) return true;
        const int L = i * G + c;
        if (L < 476 + 32) { const int idx = L - 476; u.pm = 64 + (idx >> 3); u.pn = 7 + (idx & 7); u.kofs = 0; u.nt = D / 64; u.atomic = 0; return true; }
        return false;
    }
    __device__ __forceinline__ void a_ready(const pg8::Unit&) const {}
    __device__ __forceinline__ void done(const pg8::Unit&) const {}
};
struct EpiProjA {
    static constexpr bool PERM = true, AFTER_DRAIN = false, HAS_INIT = false;
    pg8::bf16_t* O;
    __device__ __forceinline__ void operator()(const pg8::f32x4 (&acc)[2][2][4][2], const pg8::Unit& u, int wr, int wc, int fr, int fq) const {
        const int gt = __builtin_amdgcn_readfirstlane(u.pn >= 7 ? 1 : 0); const int ldc = RPROJ + gt * 256; const int colt = (u.pn - 7 * gt) * 256;
        const int row0 = u.pm * 256 + wr * 64 + fr, col0 = colt + wc * 32 + 8 * fq;
#pragma unroll
        for (int ai = 0; ai < 2; ++ai)
#pragma unroll
            for (int m = 0; m < 4; ++m) { pg8::bf16_t* rowp = O + (size_t)(row0 + ai * 128 + m * 16) * ldc + col0;
#pragma unroll
                for (int bj = 0; bj < 2; ++bj) { const pg8::f32x4 v0 = acc[ai][bj][m][0], v1 = acc[ai][bj][m][1];
                    pg8::u32x4 w; w.x = pg8::cvt_pk_bf16(v0[0], v0[1]); w.y = pg8::cvt_pk_bf16(v0[2], v0[3]); w.z = pg8::cvt_pk_bf16(v1[0], v1[1]); w.w = pg8::cvt_pk_bf16(v1[2], v1[3]);
                    *(pg8::u32x4*)(rowp + bj * 128) = w; } }
    }
};
template <class Epi>
__device__ __forceinline__ void run_gemm(Ctx& C, const bf16* A, const bf16* Bt, int N, int K, const Epi& E) {
    pg8::Gemm g{A, Bt, M, N, K}; pg8::StaticOrder S; S.init(M, N, C.G, C.bid, K);
    pg8::gemm_phase<Epi, pg8::StaticOrder, true, true>(C.lds, g, S, E);
}

constexpr int RP_TILE = 0, RP_SH = 61440, RP_LIN = 76800, RP_LINS = 264, RP_CST = 86016;
__device__ __forceinline__ void phase_rwkv_prep(Ctx& C, int i) {
    PHASE_IDS
    LAS bf16* TILE = (LAS bf16*)(C.lds + RP_TILE); LAS float* SH = (LAS float*)(C.lds + RP_SH); LAS bf16* LIN = (LAS bf16*)(C.lds + RP_LIN);
    const bf16* PR = (const bf16*)(C.ws + WS_PROJ);
    bf16* RU = (bf16*)(C.ws + WS_RU); bf16* RA = (bf16*)(C.ws + WS_RA); bf16* RB = (bf16*)(C.ws + WS_RB); bf16* RK = (bf16*)(C.ws + WS_RK);
    bf16* RWR = (bf16*)(C.ws + WS_RWR); bf16* RV = (bf16*)(C.ws + WS_RV); bf16* RG = (bf16*)(C.ws + WS_RG); float* RSC = (float*)(C.ws + WS_RSC);
    const bf16* W2T = (const bf16*)(C.ws + WS_W2T); const bf16* A2T = (const bf16*)(C.ws + WS_A2T); const bf16* G2T = (const bf16*)(C.ws + WS_G2T);
    const float* mu = C.in[13] + (size_t)i * RPROJ; const float* w0 = C.in[14] + i * RW; const float* a0 = C.in[16] + i * RW;
    const float* k_k = C.in[19] + i * RW; const float* k_a = C.in[20] + i * RW; const float* r_k = C.in[21] + i * RW;
    const int fr = lane & 15, fq = lane >> 4, h = wave;
    LAS float* CST = (LAS float*)(C.lds + RP_CST);
    { const int c = tid; CST[c] = mu[c]; CST[512 + c] = mu[512 + c]; CST[1024 + c] = mu[1024 + c]; CST[1536 + c] = w0[c]; CST[2048 + c] = a0[c]; CST[2560 + c] = k_k[c]; CST[3072 + c] = k_a[c]; CST[3584 + c] = r_k[c]; }
    const int lcol = tid & 255, ltg = tid >> 8; const float mul_ = mu[1536 + lcol];
    for (int tile = C.bid; tile < M / 16; tile += C.G) {
        const int m0 = tile * 16; const bool prompt = m0 < MP; const int sb = (m0 - MP) >> 3;
        const bool pfirst = prompt && ((m0 & (TP - 1)) == 0);
#pragma unroll
        for (int q = 0; q < 8; ++q) { const int id = tid + 512 * q;
            if (id < 17 * 224) { const int r = id / 224, ch = id - r * 224; v4u v = {0u, 0u, 0u, 0u};
                if (r > 0 || (prompt && !pfirst)) v = *(const v4u*)(PR + (size_t)(m0 - 1 + r) * RPROJ + ch * 8);
                *(LAS v4u*)(TILE + r * RPROJ + ch * 8) = v; } }
        if (!prompt) { const float* sh = C.in[3] + ((size_t)i * SB + sb) * RPROJ;
#pragma unroll
            for (int q = 0; q < 7; ++q) SH[tid + 512 * q] = sh[tid + 512 * q]; }
        __syncthreads();
        bf16x8 Bw[4][2], Ba[4][2];
#pragma unroll
        for (int nt = 0; nt < 4; ++nt) { const int n = h * 64 + fr * 4 + nt;
#pragma unroll
            for (int ks = 0; ks < 2; ++ks) { Bw[nt][ks] = *(const bf16x8*)(W2T + n * 64 + ks * 32 + fq * 8); Ba[nt][ks] = *(const bf16x8*)(A2T + n * 64 + ks * 32 + fq * 8); } }
#pragma unroll
        for (int t8 = 0; t8 < 8; ++t8) { const int t = ltg * 8 + t8;
            const float p = bf2f(TILE[(t + 1) * RPROJ + 1536 + lcol]);
            const float pv = (!prompt && t8 == 0) ? SH[ltg * RPROJ + 1536 + lcol] : bf2f(TILE[t * RPROJ + 1536 + lcol]);
            const float xs = p + mul_ * (pv - p);
            LIN[t * RP_LINS + lcol] = (bf16)f2bf((lcol < 64) ? tanhf_(xs) : ((lcol < 128) ? xs : sigmoidf_(xs))); }
        __syncthreads();
        pg8::f32x4 aw[4], aa[4], ag[4];
        {
            bf16x8 ax[4];
#pragma unroll
            for (int ks = 0; ks < 4; ++ks) ax[ks] = *(const LAS bf16x8*)(LIN + fr * RP_LINS + ks * 32 + fq * 8);
#pragma unroll
            for (int nt = 0; nt < 4; ++nt) {
                pg8::f32x4 z = {0.f, 0.f, 0.f, 0.f};
                aw[nt] = __builtin_amdgcn_mfma_f32_16x16x32_bf16(ax[0], Bw[nt][0], z, 0, 0, 0); aw[nt] = __builtin_amdgcn_mfma_f32_16x16x32_bf16(ax[1], Bw[nt][1], aw[nt], 0, 0, 0);
                aa[nt] = __builtin_amdgcn_mfma_f32_16x16x32_bf16(ax[2], Ba[nt][0], z, 0, 0, 0); aa[nt] = __builtin_amdgcn_mfma_f32_16x16x32_bf16(ax[3], Ba[nt][1], aa[nt], 0, 0, 0);
            }
        }
        asm volatile("" ::: "memory");
        {
            bf16x8 ax[4];
#pragma unroll
            for (int ks = 0; ks < 4; ++ks) ax[ks] = *(const LAS bf16x8*)(LIN + fr * RP_LINS + 128 + ks * 32 + fq * 8);
#pragma unroll
            for (int nt = 0; nt < 4; ++nt) { const int n = h * 64 + fr * 4 + nt;
                bf16x8 Bg[4];
#pragma unroll
                for (int ks = 0; ks < 4; ++ks) Bg[ks] = *(const bf16x8*)(G2T + n * 128 + ks * 32 + fq * 8);
                pg8::f32x4 z = {0.f, 0.f, 0.f, 0.f};
                ag[nt] = __builtin_amdgcn_mfma_f32_16x16x32_bf16(ax[0], Bg[0], z, 0, 0, 0);
#pragma unroll
                for (int ks = 1; ks < 4; ++ks) ag[nt] = __builtin_amdgcn_mfma_f32_16x16x32_bf16(ax[ks], Bg[ks], ag[nt], 0, 0, 0);
            }
        }
        asm volatile("" ::: "memory");
        const int c0 = h * 64 + fr * 4;
#define LD4(dst, p) do { const v2u w_ = *(const LAS v2u*)(p); dst[0] = bflo(w_.x); dst[1] = bfhi(w_.x); dst[2] = bflo(w_.y); dst[3] = bfhi(w_.y); } while (0)
#define LDF4(dst, p) do { const f32x4 w_ = *(const LAS f32x4*)(p); dst[0] = w_.x; dst[1] = w_.y; dst[2] = w_.z; dst[3] = w_.w; } while (0)
#pragma unroll
        for (int j = 0; j < 4; ++j) {
            const int tk = fq * 4 + j; const size_t m = (size_t)(m0 + tk);
            const bool sfirst = !prompt && ((tk & 7) == 0);
            float r4[4], k4[4], v4[4], pr[4], pk[4], pv[4], cm[4];
            LD4(r4, TILE + (tk + 1) * RPROJ + c0); LD4(k4, TILE + (tk + 1) * RPROJ + 512 + c0); LD4(v4, TILE + (tk + 1) * RPROJ + 1024 + c0);
            if (sfirst) { LDF4(pr, SH + (tk >> 3) * RPROJ + c0); LDF4(pk, SH + (tk >> 3) * RPROJ + 512 + c0); LDF4(pv, SH + (tk >> 3) * RPROJ + 1024 + c0); }
            else { LD4(pr, TILE + tk * RPROJ + c0); LD4(pk, TILE + tk * RPROJ + 512 + c0); LD4(pv, TILE + tk * RPROJ + 1024 + c0); }
            float xr[4], xk[4], xv[4], av[4], k2[4], krw[4]; float ssq = 0.f;
            LDF4(cm, CST + c0);
#pragma unroll
            for (int nt = 0; nt < 4; ++nt) xr[nt] = r4[nt] + cm[nt] * (pr[nt] - r4[nt]);
            LDF4(cm, CST + 512 + c0);
#pragma unroll
            for (int nt = 0; nt < 4; ++nt) xk[nt] = k4[nt] + cm[nt] * (pk[nt] - k4[nt]);
            LDF4(cm, CST + 1024 + c0);
#pragma unroll
            for (int nt = 0; nt < 4; ++nt) xv[nt] = v4[nt] + cm[nt] * (pv[nt] - v4[nt]);
            LDF4(cm, CST + 2560 + c0);
#pragma unroll
            for (int nt = 0; nt < 4; ++nt) { krw[nt] = xk[nt] * cm[nt]; ssq += krw[nt] * krw[nt]; }
            LDF4(cm, CST + 2048 + c0);
#pragma unroll
            for (int nt = 0; nt < 4; ++nt) av[nt] = sigmoidf_(cm[nt] + aa[nt][j]);
            LDF4(cm, CST + 3072 + c0);
#pragma unroll
            for (int nt = 0; nt < 4; ++nt) k2[nt] = xk[nt] * (1.0f + (av[nt] - 1.0f) * cm[nt]);
            ssq = allsum16(ssq);
            const float rn = rsqrtf(ssq + 1e-6f);
            float br = 0.f, kr = 0.f, rk = 0.f, w0v[4], rkv[4];
            LDF4(w0v, CST + 1536 + c0); LDF4(rkv, CST + 3584 + c0);
            float ou[4], oa[4], ob[4], ok[4], ow[4], og[4];
#pragma unroll
            for (int nt = 0; nt < 4; ++nt) {
                const float kk = krw[nt] * rn, bb = kk * av[nt], r = xr[nt];
                const float ew = 0.6065306597126334f * sigmoidf_(w0v[nt] + aw[nt][j]); const float dec = __expf(-ew);
                ob[nt] = bf2f((bf16)f2bf(bb)); ok[nt] = bf2f((bf16)f2bf(k2[nt]));
                br += ob[nt] * r; kr += ok[nt] * r; rk += r * k2[nt] * rkv[nt];
                ou[nt] = 1.0f - dec; oa[nt] = -kk; ow[nt] = dec * r; og[nt] = ag[nt][j]; }
            const size_t o = m * RW + c0;
#define ST4(ARR, f) do { v2u w_; w_.x = pk2(f[0], f[1]); w_.y = pk2(f[2], f[3]); *(v2u*)(ARR + o) = w_; } while (0)
            ST4(RU, ou); ST4(RA, oa); ST4(RB, ob); ST4(RK, ok); ST4(RWR, ow); ST4(RV, xv); ST4(RG, og);
#undef ST4
            br = allsum16(br); kr = allsum16(kr); rk = allsum16(rk);
            if (fr == 0) *(f32x4*)(RSC + (m * 8 + h) * 4) = (f32x4){br, kr, rk, 0.f};
        }
#undef LD4
#undef LDF4
        if (prompt) { if ((m0 & (TP - 1)) == TP - 16) { float* o = C.out + O_SH_P + ((size_t)i * NB + (m0 >> 11)) * RPROJ; for (int cc = tid; cc < RPROJ; cc += NTHR) o[cc] = bf2f(TILE[16 * RPROJ + cc]); } }
        else { float* o = C.out + O_SH_S + ((size_t)i * SB + sb) * RPROJ; for (int cc = tid; cc < 2 * RPROJ; cc += NTHR) { const int s = cc >= RPROJ ? 1 : 0; o[cc] = bf2f(TILE[(8 + 8 * s) * RPROJ + (cc - s * RPROJ)]); } }
        __syncthreads();
    }
}

__device__ __forceinline__ void unpack8(v4u c, float (&f)[8]) { f[0] = bflo(c.x); f[1] = bfhi(c.x); f[2] = bflo(c.y); f[3] = bfhi(c.y); f[4] = bflo(c.z); f[5] = bfhi(c.z); f[6] = bflo(c.w); f[7] = bfhi(c.w); }
__device__ __forceinline__ v4u pack8(const float (&f)[8]) { v4u o; o.x = pk2(f[0], f[1]); o.y = pk2(f[2], f[3]); o.z = pk2(f[4], f[5]); o.w = pk2(f[6], f[7]); return o; }
__device__ __forceinline__ void phase_gdn_prep(Ctx& C, int i) {
    PHASE_IDS
    LAS float* cwl = (LAS float*)C.lds;
    const bf16* PG = (const bf16*)(C.ws + WS_PROJ);
    bf16* GQ = (bf16*)(C.ws + WS_GQ); bf16* GK = (bf16*)(C.ws + WS_GK); bf16* GV = (bf16*)(C.ws + WS_GV); bf16* GZ = (bf16*)(C.ws + WS_GZ);
    float* GSC = (float*)(C.ws + WS_GSC); const float* P8 = (const float*)(C.ws + WS_P8);
    const float* cw = C.in[24] + (size_t)i * 4 * GQKV; const float* A_log = C.in[25] + i * GH; const float* dtb = C.in[26] + i * GH;
    for (int e = tid; e < 4 * GQKV; e += NTHR) cwl[e] = cw[e];
    __syncthreads();
    for (int tile = C.bid; tile < M / 8; tile += C.G) {
        const int m = tile * 8 + wave; const bool prompt = m < MP;
        const int t = prompt ? (m & (TP - 1)) : ((m - MP) & 7); const int b = prompt ? (m >> 11) : ((m - MP) >> 3);
        const bool last = prompt ? (t == TP - 1) : (t == 7);
        const bf16* P = PG + (size_t)m * GPR;
        const float* cs = C.in[5] + ((size_t)i * SB + (prompt ? 0 : b)) * 3 * GQKV;
        float* go = prompt ? C.out + O_GC_P + ((size_t)i * NB + b) * 3 * GQKV : C.out + O_GC_S + ((size_t)i * SB + b) * 3 * GQKV;
        float val[3][8];
#pragma unroll
        for (int blk = 0; blk < 3; ++blk) {
            const int col0 = blk * 512 + lane * 8;
            float xr[4][8];
            unpack8(*(const v4u*)(P + col0), xr[0]);
#pragma unroll
            for (int j = 1; j < 4; ++j) {
                if (t - j >= 0) unpack8(*(const v4u*)(P - (size_t)j * GPR + col0), xr[j]);
                else if (prompt) {
#pragma unroll
                    for (int e = 0; e < 8; ++e) xr[j][e] = 0.f; }
                else { const f32x4 a = *(const f32x4*)(cs + (3 + t - j) * GQKV + col0), c4 = *(const f32x4*)(cs + (3 + t - j) * GQKV + col0 + 4);
                    xr[j][0] = a.x; xr[j][1] = a.y; xr[j][2] = a.z; xr[j][3] = a.w; xr[j][4] = c4.x; xr[j][5] = c4.y; xr[j][6] = c4.z; xr[j][7] = c4.w; }
            }
#pragma unroll
            for (int h4 = 0; h4 < 2; ++h4) {
                const f32x4 w0 = *(const LAS f32x4*)(cwl + col0 + h4 * 4), w1 = *(const LAS f32x4*)(cwl + GQKV + col0 + h4 * 4), w2 = *(const LAS f32x4*)(cwl + 2 * GQKV + col0 + h4 * 4), w3 = *(const LAS f32x4*)(cwl + 3 * GQKV + col0 + h4 * 4);
#pragma unroll
                for (int e = 0; e < 4; ++e) { const int ee = h4 * 4 + e; val[blk][ee] = siluf_(w0[e] * xr[3][ee] + w1[e] * xr[2][ee] + w2[e] * xr[1][ee] + w3[e] * xr[0][ee]); }
            }
            if (last) {
#pragma unroll
                for (int j = 0; j < 3; ++j) { *(f32x4*)(go + j * GQKV + col0) = (f32x4){xr[2 - j][0], xr[2 - j][1], xr[2 - j][2], xr[2 - j][3]}; *(f32x4*)(go + j * GQKV + col0 + 4) = (f32x4){xr[2 - j][4], xr[2 - j][5], xr[2 - j][6], xr[2 - j][7]}; }
            }
        }
        float sq = 0.f, sk = 0.f;
#pragma unroll
        for (int e = 0; e < 8; ++e) { sq += val[0][e] * val[0][e]; sk += val[1][e] * val[1][e]; }
        sq = allsum16(sq); sk = allsum16(sk);
        const float nq = rsqrtf(sq + 1e-6f) * 0.08838834764831845f, nk = rsqrtf(sk + 1e-6f);
        float qh[8], kh[8];
#pragma unroll
        for (int e = 0; e < 8; ++e) { qh[e] = val[0][e] * nq; kh[e] = val[1][e] * nk; }
        const v4u qp = pack8(qh), kp = pack8(kh);
        const size_t o = (size_t)m * GW + lane * 8;
        *(v4u*)(GQ + o) = qp; *(v4u*)(GK + o) = kp; *(v4u*)(GV + o) = pack8(val[2]);
        float qr[8], kr[8]; unpack8(qp, qr); unpack8(kp, kr);
        float qk = 0.f;
#pragma unroll
        for (int e = 0; e < 8; ++e) qk += qr[e] * kr[e];
        qk = allsum16(qk);
        float z[8]; unpack8(*(const v4u*)(P + GQKV + lane * 8), z);
#pragma unroll
        for (int e = 0; e < 8; ++e) z[e] = siluf_(z[e]);
        *(v4u*)(GZ + o) = pack8(z);
        if ((lane & 15) == 0) { const int hh = lane >> 4;
            const float braw = P8[(size_t)m * 8 + hh], araw = P8[(size_t)m * 8 + 4 + hh];
            const float g = -__expf(A_log[hh]) * softplusf_(araw + dtb[hh]);
            *(f32x4*)(GSC + ((size_t)m * 4 + hh) * 4) = (f32x4){__expf(g), sigmoidf_(braw), qk, 0.f}; }
    }
}

__device__ __forceinline__ void bf8_to_lds(LAS float* dst, v4u c) {
    *(LAS f32x4*)dst = (f32x4){bflo(c.x), bfhi(c.x), bflo(c.y), bfhi(c.y)};
    *(LAS f32x4*)(dst + 4) = (f32x4){bflo(c.z), bfhi(c.z), bflo(c.w), bfhi(c.w)};
}

__device__ __forceinline__ f32x2 fma2(f32x2 a, f32x2 b, f32x2 c) { return __builtin_elementwise_fma(a, b, c); }
constexpr int SCAN_UNR = 4;
struct ROps { f32x4 u, a, b, k, w; float v; f32x2 sc; };
__device__ __forceinline__ ROps r_ld(const LAS float* B, int t, int kq, int vidx) {
    ROps o; const LAS float* V = B + t * 320 + kq * 4;
    o.u = *(const LAS f32x4*)V; o.a = *(const LAS f32x4*)(V + 64); o.b = *(const LAS f32x4*)(V + 128); o.k = *(const LAS f32x4*)(V + 192); o.w = *(const LAS f32x4*)(V + 256);
    o.v = B[5120 + t * 16 + vidx]; o.sc = *(const LAS f32x2*)(B + 5376 + t * 2); return o;
}
template <int TB> __device__ __forceinline__ void rwkv_block(f32x4& S, const LAS float* B, int kq, int vidx, float* yo) {
    f32x2 S0 = {S.x, S.y}, S1 = {S.z, S.w}; float ykeep = 0.f;
    ROps c = r_ld(B, 0, kq, vidx);
#pragma unroll 1
    for (int t0 = 0; t0 < TB; t0 += SCAN_UNR)
#pragma unroll
    for (int tt = 0; tt < SCAN_UNR; ++tt) {
        const int t = t0 + tt;
        ROps n = r_ld(B, (t + 1) & 15, kq, vidx);
        const f32x2 a0 = {c.a.x, c.a.y}, a1 = {c.a.z, c.a.w}, w0 = {c.w.x, c.w.y}, w1 = {c.w.z, c.w.w};
        const f32x2 ps = fma2(S1, a1, S0 * a0), py = fma2(S1, w1, S0 * w0);
        const float sa = allsum16(ps.x + ps.y), yp = allsum16(py.x + py.y);
        const f32x2 u0 = {c.u.x, c.u.y}, u1 = {c.u.z, c.u.w}, b0 = {c.b.x, c.b.y}, b1 = {c.b.z, c.b.w}, k0 = {c.k.x, c.k.y}, k1 = {c.k.z, c.k.w};
        const f32x2 sa2 = {sa, sa}, v2 = {c.v, c.v};
        S0 = fma2(-u0, S0, S0); S1 = fma2(-u1, S1, S1);
        S0 = fma2(sa2, b0, S0); S1 = fma2(sa2, b1, S1);
        S0 = fma2(v2, k0, S0); S1 = fma2(v2, k1, S1);
        const float y = yp + sa * c.sc.x + c.v * c.sc.y;
        ykeep = (kq == t) ? y : ykeep;
        c = n;
    }
    if (TB == 16 || kq < TB) yo[(size_t)kq * RW] = ykeep;
    S = (f32x4){S0.x, S0.y, S1.x, S1.y};
}
struct GOps { f32x4 q0, q1, k0, k1; float v; f32x4 sc; };
__device__ __forceinline__ GOps g_ld(const LAS float* B, int t, int kq, int vidx) {
    GOps o; const LAS float* V = B + t * 256 + kq * 8;
    o.q0 = *(const LAS f32x4*)V; o.q1 = *(const LAS f32x4*)(V + 4); o.k0 = *(const LAS f32x4*)(V + 128); o.k1 = *(const LAS f32x4*)(V + 132);
    o.v = B[4096 + t * 16 + vidx]; o.sc = *(const LAS f32x4*)(B + 4352 + t * 4); return o;
}
template <int TB> __device__ __forceinline__ void gdn_block(f32x2 (&S)[4], const LAS float* B, int kq, int vidx, float* oo) {
    float okeep = 0.f;
    GOps c = g_ld(B, 0, kq, vidx);
#pragma unroll 1
    for (int t0 = 0; t0 < TB; t0 += SCAN_UNR)
#pragma unroll
    for (int tt = 0; tt < SCAN_UNR; ++tt) {
        const int t = t0 + tt;
        GOps n = g_ld(B, (t + 1) & 15, kq, vidx);
        const f32x2 k[4] = {{c.k0.x, c.k0.y}, {c.k0.z, c.k0.w}, {c.k1.x, c.k1.y}, {c.k1.z, c.k1.w}}, q[4] = {{c.q0.x, c.q0.y}, {c.q0.z, c.q0.w}, {c.q1.x, c.q1.y}, {c.q1.z, c.q1.w}};
        const f32x2 pk = fma2(S[3], k[3], fma2(S[2], k[2], fma2(S[1], k[1], S[0] * k[0]))), pq = fma2(S[3], q[3], fma2(S[2], q[2], fma2(S[1], q[1], S[0] * q[0])));
        const float kts = allsum16(pk.x + pk.y), qts = allsum16(pq.x + pq.y);
        const float alpha = c.sc.x, beta = c.sc.y, qk = c.sc.z;
        const float coef = beta * (c.v - alpha * kts);
        const f32x2 al2 = {alpha, alpha}, cf2 = {coef, coef};
#pragma unroll
        for (int e = 0; e < 4; ++e) S[e] = fma2(al2, S[e], k[e] * cf2);
        const float o = alpha * qts + qk * coef;
        okeep = (kq == t) ? o : okeep;
        c = n;
    }
    if (TB == 16 || kq < TB) oo[(size_t)kq * GW] = okeep;
}
__device__ __forceinline__ float sum8(float x) { x += dppf<0x141>(x); x += dppf<0x4E>(x); x += dppf<0xB1>(x); return x; }
struct ROps8 { f32x4 u[2], a[2], b[2], k[2], w[2]; float v; f32x2 sc; };
__device__ __forceinline__ ROps8 r_ld8(const LAS float* B, int t, int kq, int vidx) {
    ROps8 o; const LAS float* V = B + t * 320 + kq * 8;
#pragma unroll
    for (int h = 0; h < 2; ++h) { o.u[h] = *(const LAS f32x4*)(V + 4 * h); o.a[h] = *(const LAS f32x4*)(V + 64 + 4 * h); o.b[h] = *(const LAS f32x4*)(V + 128 + 4 * h); o.k[h] = *(const LAS f32x4*)(V + 192 + 4 * h); o.w[h] = *(const LAS f32x4*)(V + 256 + 4 * h); }
    o.v = B[5120 + t * 16 + vidx]; o.sc = *(const LAS f32x2*)(B + 5376 + t * 2); return o;
}
#define PAIRS(V_) {{V_[0].x, V_[0].y}, {V_[0].z, V_[0].w}, {V_[1].x, V_[1].y}, {V_[1].z, V_[1].w}}
template <int TB> __device__ __forceinline__ void rwkv_block8(f32x2 (&S)[4], const LAS float* B, int kq, int vidx, float* yo) {
    float ykA = 0.f, ykB = 0.f;
    ROps8 c = r_ld8(B, 0, kq, vidx);
#pragma unroll 1
    for (int t0 = 0; t0 < TB; t0 += SCAN_UNR)
#pragma unroll
    for (int tt = 0; tt < SCAN_UNR; ++tt) {
        const int t = t0 + tt;
        const ROps8 n = r_ld8(B, (t + 1) & 15, kq, vidx);
        const f32x2 a[4] = PAIRS(c.a), w[4] = PAIRS(c.w), u[4] = PAIRS(c.u), b[4] = PAIRS(c.b), k[4] = PAIRS(c.k);
        const f32x2 ps = fma2(S[3], a[3], fma2(S[2], a[2], fma2(S[1], a[1], S[0] * a[0]))), py = fma2(S[3], w[3], fma2(S[2], w[2], fma2(S[1], w[1], S[0] * w[0])));
        const float sa = sum8(ps.x + ps.y), yp = sum8(py.x + py.y);
        const f32x2 sa2 = {sa, sa}, v2 = {c.v, c.v};
#pragma unroll
        for (int e = 0; e < 4; ++e) { S[e] = fma2(-u[e], S[e], S[e]); S[e] = fma2(sa2, b[e], S[e]); S[e] = fma2(v2, k[e], S[e]); }
        const float y = yp + sa * c.sc.x + c.v * c.sc.y;
        ykA = (kq == t) ? y : ykA; ykB = (kq + 8 == t) ? y : ykB;
        c = n;
    }
    yo[(size_t)kq * RW] = ykA;
    if (TB == 16) yo[(size_t)(kq + 8) * RW] = ykB;
}
struct GOps8 { f32x4 q[4], k[4]; float v; f32x4 sc; };
__device__ __forceinline__ GOps8 g_ld8(const LAS float* B, int t, int kq, int vidx) {
    GOps8 o; const LAS float* V = B + t * 256 + kq * 16;
#pragma unroll
    for (int h = 0; h < 4; ++h) { o.q[h] = *(const LAS f32x4*)(V + 4 * h); o.k[h] = *(const LAS f32x4*)(V + 128 + 4 * h); }
    o.v = B[4096 + t * 16 + vidx]; o.sc = *(const LAS f32x4*)(B + 4352 + t * 4); return o;
}
#define PAIRS8(V_) {{V_[0].x, V_[0].y}, {V_[0].z, V_[0].w}, {V_[1].x, V_[1].y}, {V_[1].z, V_[1].w}, {V_[2].x, V_[2].y}, {V_[2].z, V_[2].w}, {V_[3].x, V_[3].y}, {V_[3].z, V_[3].w}}
template <int TB> __device__ __forceinline__ void gdn_block8(f32x2 (&S)[8], const LAS float* B, int kq, int vidx, float* oo) {
    float okA = 0.f, okB = 0.f;
    GOps8 c = g_ld8(B, 0, kq, vidx);
#pragma unroll 1
    for (int t0 = 0; t0 < TB; t0 += SCAN_UNR)
#pragma unroll
    for (int tt = 0; tt < SCAN_UNR; ++tt) {
        const int t = t0 + tt;
        const GOps8 n = g_ld8(B, (t + 1) & 15, kq, vidx);
        const f32x2 k[8] = PAIRS8(c.k), q[8] = PAIRS8(c.q);
        f32x2 pk = S[0] * k[0], pq = S[0] * q[0];
#pragma unroll
        for (int e = 1; e < 8; ++e) { pk = fma2(S[e], k[e], pk); pq = fma2(S[e], q[e], pq); }
        const float kts = sum8(pk.x + pk.y), qts = sum8(pq.x + pq.y);
        const float alpha = c.sc.x, beta = c.sc.y, qk = c.sc.z;
        const float coef = beta * (c.v - alpha * kts);
        const f32x2 al2 = {alpha, alpha}, cf2 = {coef, coef};
#pragma unroll
        for (int e = 0; e < 8; ++e) S[e] = fma2(al2, S[e], k[e] * cf2);
        const float o = alpha * qts + qk * coef;
        okA = (kq == t) ? o : okA; okB = (kq + 8 == t) ? o : okB;
        c = n;
    }
    oo[(size_t)kq * GW] = okA;
    if (TB == 16) oo[(size_t)(kq + 8) * GW] = okB;
}
constexpr int SC_NBLK = 128 + 16;
constexpr int RBUF = 16 * 5 * 64 + 16 * 16 + 16 * 2;
constexpr int GBUF = 16 * 2 * 128 + 16 * 16 + 16 * 4;
__device__ __forceinline__ void phase_scan(Ctx& C, int i) {
    PHASE_IDS
    const int w = wave & 1; const bool cw = (wave < 2) || (wave >= 6);
    int sub = lane >> 3, kq = lane & 7, ht = tid & 255;
#define RELAUNDER do { int tl_ = tid; asm volatile("" : "+v"(tl_)); ht = tl_ & 255; sub = (tl_ & 63) >> 3; kq = tl_ & 7; } while (0)
    LAS float* const ldsf = (LAS float*)C.lds;
    if (wave < 4) {
        LAS float* const buf0 = ldsf;
        const unsigned char* SCN = C.ws + WS_SCN; const bf16* RV = (const bf16*)(C.ws + WS_RV); const float* RSC = (const float*)(C.ws + WS_RSC);
        float* YRAW = (float*)(C.ws + WS_YRAW);
        v4u st[5]; v4u stv; f32x2 sts; f32x4 Snext = {0.f, 0.f, 0.f, 0.f}, Snext1 = {0.f, 0.f, 0.f, 0.f};
#define R_DESC(blk, m0, tb, head, quarter, b, isprompt) \
        size_t m0; int tb, head, quarter, b; bool isprompt; \
        if ((blk) < 128) { isprompt = true; const int seq = C.bid >> 5; b = seq; head = (C.bid >> 2) & 7; quarter = C.bid & 3; m0 = (size_t)seq * TP + (size_t)(blk) * 16; tb = 16; } \
        else { isprompt = false; const int su = C.bid * 16 + ((blk) - 128); b = su >> 5; head = (su >> 2) & 7; quarter = su & 3; m0 = (size_t)MP + (size_t)b * TS; tb = 8; }
#define R_STAGE_LOAD(blk) do { R_DESC(blk, m0_, tb_, head_, quarter_, b_, ip_) \
        if (!cw) { const int hx = ht & 127; \
        _Pragma("unroll") for (int q = 0; q < 5; ++q) { const int id = hx + 128 * q; const int tok = id / 40, rem = id - tok * 40, vec = rem >> 3, part = rem & 7; \
            if (tok < tb_) st[q] = *(const v4u*)(SCN + (size_t)vec * A17 + ((m0_ + tok) * RW + head_ * 64 + part * 8) * 2); } \
        if (hx < 32) { const int tok = hx >> 1; if (tok < tb_) stv = *(const v4u*)(RV + (m0_ + tok) * RW + head_ * 64 + quarter_ * 16 + (hx & 1) * 8); } \
        else if (hx < 48) { const int tok = hx - 32; if (tok < tb_) sts = *(const f32x2*)(RSC + ((m0_ + tok) * 8 + head_) * 4); } } \
        if (!ip_ && cw) { const float* s0_ = C.in[2] + ((size_t)(i * SB + b_) * RH + head_) * 4096 + (quarter_ * 16 + w * 8 + sub) * 64 + kq * 8; Snext = *(const f32x4*)s0_; Snext1 = *(const f32x4*)(s0_ + 4); } else { Snext = (f32x4){0.f, 0.f, 0.f, 0.f}; Snext1 = Snext; } } while (0)
#define R_STAGE_WRITE(blk) do { LAS float* B = buf0 + ((blk) & 1) * RBUF; \
        if (!cw) { const int hx = ht & 127; \
        _Pragma("unroll") for (int q = 0; q < 5; ++q) { const int id = hx + 128 * q; const int tok = id / 40, rem = id - tok * 40, vec = rem >> 3, part = rem & 7; \
            bf8_to_lds(B + (tok * 5 + vec) * 64 + part * 8, st[q]); } \
        if (hx < 32) bf8_to_lds(B + 5120 + (hx >> 1) * 16 + (hx & 1) * 8, stv); \
        else if (hx < 48) *(LAS f32x2*)(B + 5376 + (hx - 32) * 2) = sts; } } while (0)
        R_STAGE_LOAD(0);
        f32x2 S[4] = {{Snext.x, Snext.y}, {Snext.z, Snext.w}, {Snext1.x, Snext1.y}, {Snext1.z, Snext1.w}};
        R_STAGE_WRITE(0);
        __syncthreads();
#pragma unroll 1
        for (int blk = 0; blk < SC_NBLK; ++blk) {
            RELAUNDER;
            R_DESC(blk, m0, tb, head, quarter, b, isprompt)
            const bool last = isprompt ? (blk == 127) : true;
            if (blk + 1 < SC_NBLK) R_STAGE_LOAD(blk + 1);
            const LAS float* B = buf0 + (blk & 1) * RBUF;
            const int row = quarter * 16 + w * 8 + sub;
            float* yo = YRAW + m0 * RW + head * 64 + row;
            if (cw) {
            if (tb == 16) rwkv_block8<16>(S, B, kq, w * 8 + sub, yo); else rwkv_block8<8>(S, B, kq, w * 8 + sub, yo);
            if (last) {
                float* So = (isprompt ? C.out + O_RWKV_P + ((size_t)(i * NB + b) * RH + head) * 4096 : C.out + O_RWKV_S + ((size_t)(i * SB + b) * RH + head) * 4096);
                *(f32x4*)(So + row * 64 + kq * 8) = (f32x4){S[0].x, S[0].y, S[1].x, S[1].y}; *(f32x4*)(So + row * 64 + kq * 8 + 4) = (f32x4){S[2].x, S[2].y, S[3].x, S[3].y};
                S[0] = (f32x2){Snext.x, Snext.y}; S[1] = (f32x2){Snext.z, Snext.w}; S[2] = (f32x2){Snext1.x, Snext1.y}; S[3] = (f32x2){Snext1.z, Snext1.w};
            }
            }
            if (blk + 1 < SC_NBLK) R_STAGE_WRITE(blk + 1);
            __syncthreads();
        }
#undef R_DESC
#undef R_STAGE_LOAD
#undef R_STAGE_WRITE
    } else {
        LAS float* const buf0 = ldsf + 2 * RBUF;
        const bf16* GQ = (const bf16*)(C.ws + WS_GQ); const bf16* GV = (const bf16*)(C.ws + WS_GV); const float* GSC = (const float*)(C.ws + WS_GSC);
        float* ORAW = (float*)(C.ws + WS_ORAW);
        v4u st[4]; v4u stv; f32x4 sts; float Snext[16];
#pragma unroll
        for (int e = 0; e < 16; ++e) Snext[e] = 0.f;
#define G_DESC(blk, m0, tb, head, cgp, b, isprompt) \
        size_t m0; int tb, head, cgp, b; bool isprompt; \
        if ((blk) < 128) { isprompt = true; const int seq = C.bid >> 5; b = seq; head = (C.bid >> 3) & 3; cgp = C.bid & 7; m0 = (size_t)seq * TP + (size_t)(blk) * 16; tb = 16; } \
        else { isprompt = false; const int su = C.bid * 16 + ((blk) - 128); b = su >> 5; head = (su >> 3) & 3; cgp = su & 7; m0 = (size_t)MP + (size_t)b * TS; tb = 8; }
#define G_STAGE_LOAD(blk) do { G_DESC(blk, m0_, tb_, head_, cgp_, b_, ip_) \
        if (!cw) { const int hx = ht & 127; \
        _Pragma("unroll") for (int q = 0; q < 4; ++q) { const int id = hx + 128 * q; const int tok = id >> 5, vec = (id >> 4) & 1, part = id & 15; \
            if (tok < tb_) st[q] = *(const v4u*)(GQ + (size_t)vec * (A17 / 2) + (m0_ + tok) * GW + head_ * 128 + part * 8); } \
        if (hx < 32) { const int tok = hx >> 1; if (tok < tb_) stv = *(const v4u*)(GV + (m0_ + tok) * GW + head_ * 128 + cgp_ * 16 + (hx & 1) * 8); } \
        else if (hx < 48) { const int tok = hx - 32; if (tok < tb_) sts = *(const f32x4*)(GSC + ((m0_ + tok) * 4 + head_) * 4); } } \
        if (!ip_ && cw) { const float* S0 = C.in[4] + ((size_t)(i * SB + b_) * GH + head_) * 16384 + cgp_ * 16 + w * 8 + sub; \
            _Pragma("unroll") for (int e = 0; e < 16; ++e) Snext[e] = S0[(size_t)(kq * 16 + e) * 128]; } \
        else { _Pragma("unroll") for (int e = 0; e < 16; ++e) Snext[e] = 0.f; } } while (0)
#define G_STAGE_WRITE(blk) do { LAS float* B = buf0 + ((blk) & 1) * GBUF; \
        if (!cw) { const int hx = ht & 127; \
        _Pragma("unroll") for (int q = 0; q < 4; ++q) { const int id = hx + 128 * q; const int tok = id >> 5, vec = (id >> 4) & 1, part = id & 15; \
            bf8_to_lds(B + (tok * 2 + vec) * 128 + part * 8, st[q]); } \
        if (hx < 32) bf8_to_lds(B + 4096 + (hx >> 1) * 16 + (hx & 1) * 8, stv); \
        else if (hx < 48) *(LAS f32x4*)(B + 4352 + (hx - 32) * 4) = sts; } } while (0)
        G_STAGE_LOAD(0);
        f32x2 S[8];
#pragma unroll
        for (int e = 0; e < 8; ++e) S[e] = (f32x2){Snext[2 * e], Snext[2 * e + 1]};
        G_STAGE_WRITE(0);
        __syncthreads();
#pragma unroll 1
        for (int blk = 0; blk < SC_NBLK; ++blk) {
            RELAUNDER;
            G_DESC(blk, m0, tb, head, cgp, b, isprompt)
            const bool last = isprompt ? (blk == 127) : true;
            if (blk + 1 < SC_NBLK) G_STAGE_LOAD(blk + 1);
            const LAS float* B = buf0 + (blk & 1) * GBUF;
            const int col = cgp * 16 + w * 8 + sub;
            float* oo = ORAW + m0 * GW + head * 128 + col;
            if (cw) {
            if (tb == 16) gdn_block8<16>(S, B, kq, w * 8 + sub, oo); else gdn_block8<8>(S, B, kq, w * 8 + sub, oo);
            if (last) {
                float* So = (isprompt ? C.out + O_GDN_P + ((size_t)(i * NB + b) * GH + head) * 16384 : C.out + O_GDN_S + ((size_t)(i * SB + b) * GH + head) * 16384) + col;
#pragma unroll
                for (int e = 0; e < 8; ++e) { So[(size_t)(kq * 16 + 2 * e) * 128] = S[e].x; So[(size_t)(kq * 16 + 2 * e + 1) * 128] = S[e].y; S[e] = (f32x2){Snext[2 * e], Snext[2 * e + 1]}; }
            }
            }
            if (blk + 1 < SC_NBLK) G_STAGE_WRITE(blk + 1);
            __syncthreads();
        }
#undef G_DESC
#undef G_STAGE_LOAD
#undef G_STAGE_WRITE
    }
}

__device__ __forceinline__ void phase_post(Ctx& C, int i) {
    PHASE_IDS
    const int gw = C.bid * NWAVES + wave, NGW = C.G * NWAVES;
    const float* YRAW = (const float*)(C.ws + WS_YRAW); const float* ORAW = (const float*)(C.ws + WS_ORAW);
    const bf16* RV = (const bf16*)(C.ws + WS_RV); const bf16* RG = (const bf16*)(C.ws + WS_RG); const float* RSC = (const float*)(C.ws + WS_RSC); const bf16* GZ = (const bf16*)(C.ws + WS_GZ);
    bf16* YM = (bf16*)(C.ws + WS_XN);
    const float* lnwp = C.in[22] + i * RW + lane * 8; const float* lnbp = C.in[23] + i * RW + lane * 8; const float* gnwp = C.in[27] + i * GHD + (lane & 15) * 8;
    float lnw[8], lnb[8], gnw[8];
#pragma unroll
    for (int e = 0; e < 8; ++e) { lnw[e] = lnwp[e]; lnb[e] = lnbp[e]; gnw[e] = gnwp[e]; }
    for (int m = gw; m < M; m += NGW) {
        const size_t mm = (size_t)m;
        const f32x4 y0 = *(const f32x4*)(YRAW + mm * RW + lane * 8), y1 = *(const f32x4*)(YRAW + mm * RW + lane * 8 + 4);
        const f32x4 o0 = *(const f32x4*)(ORAW + mm * GW + lane * 8), o1 = *(const f32x4*)(ORAW + mm * GW + lane * 8 + 4);
        const v4u vv = *(const v4u*)(RV + mm * RW + lane * 8), gg = *(const v4u*)(RG + mm * RW + lane * 8), zz = *(const v4u*)(GZ + mm * GW + lane * 8);
        const float rk = RSC[(mm * 8 + (lane >> 3)) * 4 + 2];
        float y[8] = {y0.x, y0.y, y0.z, y0.w, y1.x, y1.y, y1.z, y1.w}, v[8], g[8], o[8];
        unpack8(vv, v); unpack8(gg, g);
        float s = ((y[0] + y[1]) + (y[2] + y[3])) + ((y[4] + y[5]) + (y[6] + y[7]));
        const float mean = sum8(s) * (1.f / 64.f); float q = 0.f;
#pragma unroll
        for (int e = 0; e < 8; ++e) { y[e] -= mean; q += y[e] * y[e]; }
        const float rstd = rsqrtf(sum8(q) * (1.f / 64.f) + 64e-5f);
#pragma unroll
        for (int e = 0; e < 8; ++e) o[e] = (y[e] * rstd * lnw[e] + lnb[e] + rk * v[e]) * g[e];
        *(v4u*)(YM + mm * D + lane * 8) = pack8(o);
        float z[8]; unpack8(zz, z);
        float x[8] = {o0.x, o0.y, o0.z, o0.w, o1.x, o1.y, o1.z, o1.w}; float q2 = 0.f;
#pragma unroll
        for (int e = 0; e < 8; ++e) q2 += x[e] * x[e];
        const float rs = rsqrtf(allsum16(q2) * (1.f / 128.f) + 1e-6f);
#pragma unroll
        for (int e = 0; e < 8; ++e) o[e] = x[e] * rs * gnw[e] * z[e];
        *(v4u*)(YM + mm * D + 512 + lane * 8) = pack8(o);
    }
}

constexpr int XS = 1032;
__device__ __forceinline__ void phase_lru_prep(Ctx& C, int i) {
    PHASE_IDS
    LAS bf16* xc = (LAS bf16*)C.lds;
    const bf16* PO = (const bf16*)(C.ws + WS_PROJ);
    bf16* LP = (bf16*)(C.ws + WS_LP); bf16* LH = (bf16*)(C.ws + WS_LH); float* LT = (float*)(C.ws + WS_LTOT);
    const bf16* WA = (const bf16*)(C.ws + WS_WA) + wave * 16384; const bf16* WI = (const bf16*)(C.ws + WS_WI) + wave * 16384;
    const float* cw = C.in[30] + (size_t)i * 4 * D; const float* cb = C.in[31] + i * D;
    const float* ba = C.in[33] + i * D; const float* bi = C.in[35] + i * D; const float* Lp = C.in[36] + i * D;
    const int fr = lane & 15, fq = lane >> 4, h = wave;
    LAS float* CSTL = (LAS float*)(C.lds + 67584);
    for (int c = tid; c < D; c += NTHR) { CSTL[c] = ba[c]; CSTL[D + c] = bi[c]; CSTL[2 * D + c] = softplusf_(-Lp[c]); }
    for (int tile = C.bid; tile < M / 32; tile += C.G) {
        const int m0 = tile * 32; const bool prompt = m0 < MP;
        const bf16* P = PO + (size_t)m0 * 2048;
        bf16x8 Bc[4][2];
#pragma unroll
        for (int ks = 0; ks < 4; ++ks) { Bc[ks][0] = *(const bf16x8*)(WA + fr * 128 + ks * 32 + fq * 8); Bc[ks][1] = *(const bf16x8*)(WI + fr * 128 + ks * 32 + fq * 8); }
        {
            const int rg = tid >> 7;
            const bool seqstart = prompt ? (((m0 & (TP - 1)) == 0) && rg == 0) : true;
#pragma unroll 1
            for (int hh = 0; hh < 2; ++hh) {
                const int c0 = (tid & 127) * 8 + hh * 4;
                float xr[11][4];
#pragma unroll
                for (int r = 0; r < 11; ++r) { const int tr = rg * 8 - 3 + r;
                    if (r >= 3 || !seqstart) { const v2u w = *(const v2u*)(P + (ptrdiff_t)tr * 2048 + 1024 + c0); xr[r][0] = bflo(w.x); xr[r][1] = bfhi(w.x); xr[r][2] = bflo(w.y); xr[r][3] = bfhi(w.y); }
                    else if (prompt) { xr[r][0] = 0.f; xr[r][1] = 0.f; xr[r][2] = 0.f; xr[r][3] = 0.f; }
                    else { const f32x4 a = *(const f32x4*)(C.in[7] + ((size_t)i * SB + ((m0 - MP) >> 3) + rg) * 3 * D + r * D + c0); xr[r][0] = a.x; xr[r][1] = a.y; xr[r][2] = a.z; xr[r][3] = a.w; } }
                const f32x4 t0 = *(const f32x4*)(cw + c0), t1 = *(const f32x4*)(cw + D + c0), t2 = *(const f32x4*)(cw + 2 * D + c0), t3 = *(const f32x4*)(cw + 3 * D + c0), bs = *(const f32x4*)(cb + c0);
#pragma unroll
                for (int t8 = 0; t8 < 8; ++t8) { float y[4];
#pragma unroll
                    for (int e = 0; e < 4; ++e) y[e] = t0[e] * xr[t8][e] + t1[e] * xr[t8 + 1][e] + t2[e] * xr[t8 + 2][e] + t3[e] * xr[t8 + 3][e] + bs[e];
                    v2u o; o.x = pk2(y[0], y[1]); o.y = pk2(y[2], y[3]);
                    *(LAS v2u*)(xc + (rg * 8 + t8) * XS + c0) = o; }
            }
        }
        __syncthreads();
#pragma unroll
        for (int nt = 0; nt < 8; ++nt) {
            pg8::f32x4 aa[2] = {{0.f, 0.f, 0.f, 0.f}, {0.f, 0.f, 0.f, 0.f}}, ai[2] = {{0.f, 0.f, 0.f, 0.f}, {0.f, 0.f, 0.f, 0.f}};
            bf16x8 Bn[4][2];
            if (nt + 1 < 8) {
#pragma unroll
                for (int ks = 0; ks < 4; ++ks) { Bn[ks][0] = *(const bf16x8*)(WA + ((nt + 1) * 16 + fr) * 128 + ks * 32 + fq * 8); Bn[ks][1] = *(const bf16x8*)(WI + ((nt + 1) * 16 + fr) * 128 + ks * 32 + fq * 8); } }
#pragma unroll
            for (int ks = 0; ks < 4; ++ks) {
                const bf16x8 bfa = Bc[ks][0], bfi = Bc[ks][1];
#pragma unroll
                for (int mt = 0; mt < 2; ++mt) { const bf16x8 af = *(const LAS bf16x8*)(xc + (mt * 16 + fr) * XS + h * 128 + ks * 32 + fq * 8);
                    aa[mt] = __builtin_amdgcn_mfma_f32_16x16x32_bf16(af, bfa, aa[mt], 0, 0, 0); ai[mt] = __builtin_amdgcn_mfma_f32_16x16x32_bf16(af, bfi, ai[mt], 0, 0, 0); }
            }
            const int ch = h * 128 + nt * 16 + fr;
            const float bac = CSTL[ch], bic = CSTL[D + ch], spl = CSTL[2 * D + ch];
            float IA[2][4], IB[2][4], GA[2], GB[2], EA[2], EB[2];
#pragma unroll
            for (int mt = 0; mt < 2; ++mt) {
                float pa = 1.f, pb = 0.f;
#pragma unroll
                for (int j = 0; j < 4; ++j) {
                    const int tok = mt * 16 + fq * 4 + j; const float xv = bf2f(xc[tok * XS + ch]);
                    const float r = sigmoidf_(aa[mt][j] + bac), ig = sigmoidf_(ai[mt][j] + bic);
                    const float la = -8.0f * r * spl; const float A = __expf(la); const float x2 = 2.0f * la;
                    const float om_s = -x2 * (1.0f + x2 * (0.5f + x2 * (0.16666667f + x2 * (0.041666668f + x2 * 0.008333334f))));
                    const float om = (x2 > -0.25f) ? om_s : (1.0f - A * A); const float mult = __builtin_amdgcn_sqrtf(fmaxf(om, 0.f)); const float B = mult * ig * xv;
                    pb = A * pb + B; pa = pa * A; IA[mt][j] = pa; IB[mt][j] = pb;
                }
                float ga = pa, gb = pb;
                { const float qa = __shfl_up(ga, 16), qb = __shfl_up(gb, 16); const bool doit = prompt ? (fq >= 1) : ((fq & 1) != 0); if (doit) { gb = ga * qb + gb; ga = qa * ga; } }
                { const float qa = __shfl_up(ga, 32), qb = __shfl_up(gb, 32); if (prompt && fq >= 2) { gb = ga * qb + gb; ga = qa * ga; } }
                GA[mt] = ga; GB[mt] = gb;
                { const float qa = __shfl_up(ga, 16), qb = __shfl_up(gb, 16); const bool doit = prompt ? (fq >= 1) : ((fq & 1) != 0); EA[mt] = doit ? qa : 1.f; EB[mt] = doit ? qb : 0.f; }
            }
            { const float ta = __shfl(GA[0], fr + 48), tb = __shfl(GB[0], fr + 48); if (prompt) { EB[1] = EA[1] * tb + EB[1]; EA[1] = ta * EA[1]; } }
#pragma unroll
            for (int mt = 0; mt < 2; ++mt)
#pragma unroll
                for (int j = 0; j < 4; ++j) { const size_t m = (size_t)(m0 + mt * 16 + fq * 4 + j);
                    const float Pv = EA[mt] * IA[mt][j], Hv = IA[mt][j] * EB[mt] + IB[mt][j];
                    LP[m * D + ch] = (bf16)f2bf(Pv); LH[m * D + ch] = (bf16)f2bf(Hv);
                    if (mt == 1 && j == 3 && fq == 3) *(f32x2*)(LT + ((size_t)tile * D + ch) * 2) = (f32x2){Pv, Hv}; }
            if (nt + 1 < 8) {
#pragma unroll
                for (int ks = 0; ks < 4; ++ks) { Bc[ks][0] = Bn[ks][0]; Bc[ks][1] = Bn[ks][1]; } }
            asm volatile("" ::: "memory");
        }
        if (prompt) { if ((m0 & (TP - 1)) == TP - 32) { float* o = C.out + O_LC_P + ((size_t)i * NB + (m0 >> 11)) * 3 * D;
                for (int e = tid; e < 3 * D; e += NTHR) { const int j = e >> 10, cc = e & 1023; o[e] = bf2f(P[(29 + j) * 2048 + 1024 + cc]); } } }
        else { for (int e = tid; e < 4 * 3 * D; e += NTHR) { const int s = e / (3 * D), r = e - s * 3 * D, j = r >> 10, cc = r & 1023;
                C.out[O_LC_S + ((size_t)i * SB + ((m0 - MP) >> 3) + s) * 3 * D + r] = bf2f(P[(s * 8 + 5 + j) * 2048 + 1024 + cc]); } }
        __syncthreads();
    }
}

__device__ __forceinline__ float gelu_tanh(float x) { const float u = 0.7978845608028654f * (x + 0.044715f * x * x * x); return 0.5f * x * (1.0f + tanhf_(u)); }

__device__ __forceinline__ void phase_lru_fin(Ctx& C, int i) {
    PHASE_IDS
    LAS float* X = (LAS float*)C.lds;
    const bf16* PO = (const bf16*)(C.ws + WS_PROJ);
    const bf16* LP = (const bf16*)(C.ws + WS_LP); const bf16* LH = (const bf16*)(C.ws + WS_LH); const float* LT = (const float*)(C.ws + WS_LTOT);
    bf16* YM = (bf16*)(C.ws + WS_XN);
    const int rg = tid >> 7, cg = tid & 127, c0 = cg * 8;
    for (int unit = C.bid; unit < M / 16; unit += C.G) {
        const int m0 = unit * 16; const bool prompt = m0 < MP; const int tile = m0 >> 5;
        float carry[8];
        if (prompt) {
            const int tt0 = (m0 >> 11) * 64, n = tile - tt0, per = (n + 3) >> 2; const int lo = tt0 + rg * per; const int hi = (lo + per < tile) ? lo + per : tile;
            float A[8], B[8];
#pragma unroll
            for (int e = 0; e < 8; ++e) { A[e] = 1.f; B[e] = 0.f; }
#pragma unroll 4
            for (int tt = lo; tt < hi; ++tt) { const float* p = LT + ((size_t)tt * D + c0) * 2;
                const f32x4 v0 = *(const f32x4*)p, v1 = *(const f32x4*)(p + 4), v2 = *(const f32x4*)(p + 8), v3 = *(const f32x4*)(p + 12);
                const float P[8] = {v0.x, v0.z, v1.x, v1.z, v2.x, v2.z, v3.x, v3.z}, H[8] = {v0.y, v0.w, v1.y, v1.w, v2.y, v2.w, v3.y, v3.w};
#pragma unroll
                for (int e = 0; e < 8; ++e) { B[e] = P[e] * B[e] + H[e]; A[e] *= P[e]; } }
            LAS float* xp = X + (rg * 128 + cg) * 16;
            *(LAS f32x4*)xp = (f32x4){A[0], A[1], A[2], A[3]}; *(LAS f32x4*)(xp + 4) = (f32x4){A[4], A[5], A[6], A[7]};
            *(LAS f32x4*)(xp + 8) = (f32x4){B[0], B[1], B[2], B[3]}; *(LAS f32x4*)(xp + 12) = (f32x4){B[4], B[5], B[6], B[7]};
            __syncthreads();
#pragma unroll
            for (int e = 0; e < 8; ++e) carry[e] = 0.f;
#pragma unroll
            for (int q = 0; q < 4; ++q) { const LAS float* xq = X + (q * 128 + cg) * 16;
                const f32x4 a0 = *(const LAS f32x4*)xq, a1 = *(const LAS f32x4*)(xq + 4), b0 = *(const LAS f32x4*)(xq + 8), b1 = *(const LAS f32x4*)(xq + 12);
                carry[0] = a0.x * carry[0] + b0.x; carry[1] = a0.y * carry[1] + b0.y; carry[2] = a0.z * carry[2] + b0.z; carry[3] = a0.w * carry[3] + b0.w;
                carry[4] = a1.x * carry[4] + b1.x; carry[5] = a1.y * carry[5] + b1.y; carry[6] = a1.z * carry[6] + b1.z; carry[7] = a1.w * carry[7] + b1.w; }
        } else {
            const float* hp = C.in[6] + ((size_t)i * SB + ((m0 - MP) >> 3) + (rg >> 1)) * D + c0;
            const f32x4 h0 = *(const f32x4*)hp, h1 = *(const f32x4*)(hp + 4);
            carry[0] = h0.x; carry[1] = h0.y; carry[2] = h0.z; carry[3] = h0.w; carry[4] = h1.x; carry[5] = h1.y; carry[6] = h1.z; carry[7] = h1.w;
        }
#pragma unroll
        for (int t4 = 0; t4 < 4; ++t4) {
            const size_t m = (size_t)(m0 + rg * 4 + t4);
            float lh[8], lp[8], gt[8], y[8], hv[8];
            unpack8(*(const v4u*)(LH + m * D + c0), lh); unpack8(*(const v4u*)(LP + m * D + c0), lp); unpack8(*(const v4u*)(PO + m * 2048 + c0), gt);
#pragma unroll
            for (int e = 0; e < 8; ++e) { hv[e] = lh[e] + lp[e] * carry[e]; y[e] = hv[e] * gelu_tanh(gt[e]); }
            *(v4u*)(YM + m * D + c0) = pack8(y);
            const bool lastp = prompt && ((m & (TP - 1)) == TP - 1), lasts = !prompt && (((m - MP) & 7) == 7);
            if (lastp || lasts) { float* o = lastp ? C.out + O_LRU_P + ((size_t)i * NB + (m >> 11)) * D + c0 : C.out + O_LRU_S + ((size_t)i * SB + ((m - MP) >> 3)) * D + c0;
                *(f32x4*)o = (f32x4){hv[0], hv[1], hv[2], hv[3]}; *(f32x4*)(o + 4) = (f32x4){hv[4], hv[5], hv[6], hv[7]}; }
        }
        if (prompt) __syncthreads();
    }
}

__global__ void __launch_bounds__(NTHR, 2) hybrid_fwd(Args args) {
    extern __shared__ __attribute__((aligned(16))) unsigned char lds_raw[];
    cg::grid_group grid = cg::this_grid();
    Ctx C;
    C.lds = (LAS unsigned char*)lds_raw; C.in = args.in; C.out = args.out; C.ws = args.ws;
    C.bid = blockIdx.x; C.G = gridDim.x;
    const int lo = args.ph_lo, hi = args.ph_hi;
    volatile LAS unsigned* MISC = (volatile LAS unsigned*)(C.lds + MISC_OFF);
    if (threadIdx.x < 2) MISC[threadIdx.x] = 0u;
    __syncthreads();
    XcdBarrier xbar = xcd_barrier_post((unsigned*)(C.ws + WS_CTL), MISC);
    if (lo < 0) grid.sync();
#define GRID_BAR() xcd_barrier(xbar)
    int ph = 0;
    for (int es_ = 0; es_ < EXTRA_SYNCS; ++es_) GRID_BAR();
#define PH_BEGIN if (ph >= lo && ph < hi) { const int nrep_ = ((DUPMASK >> ph) & 1ull) ? 2 : 1; for (int rep_ = 0; rep_ < nrep_; ++rep_) { if (rep_) GRID_BAR();
#ifdef NOSYNC
#define PH_END } } ++ph;
#else
#define PH_END   } if (ph + 1 < hi) GRID_BAR(); } ++ph;
#endif
    bf16* XN = (bf16*)(C.ws + WS_XN); bf16* PROJ = (bf16*)(C.ws + WS_PROJ); bf16* HID = (bf16*)(C.ws + WS_HID);
    bf16* WIN = (bf16*)(C.ws + WS_WIN); bf16* WOUT = (bf16*)(C.ws + WS_WOUT); bf16* WUP = (bf16*)(C.ws + WS_WUP); bf16* WDN = (bf16*)(C.ws + WS_WDN);
#pragma unroll 1
    for (int l = 0; l < DEPTH; ++l) {
        const int i = l >> 1; const bool even = (l & 1) == 0;
        PH_BEGIN

#ifndef SKIP_CONV
phase_convert(C, l);
#endif

            __syncthreads();
            if (l == 0) phase_norm<true, true>(C, args.in[8] + l * D, args.in[11] + (size_t)i * D * EPROJ + 3840, EPROJ, 0);
            else if (even) phase_norm<false, true>(C, args.in[8] + l * D, args.in[11] + (size_t)i * D * EPROJ + 3840, EPROJ, 16);
            else phase_norm<false, false>(C, args.in[8] + l * D, nullptr, 0, 16);
            __syncthreads();
        PH_END
        if (even) {

#ifndef SKIP_G1
PH_BEGIN { pg8::Gemm g{XN, WIN, M, 3840, D}; ProjAOrder S; S.init(C.G, C.bid); EpiProjA E{PROJ}; pg8::gemm_phase<EpiProjA, ProjAOrder, true, true>(C.lds, g, S, E); } PH_END
#endif

            PH_BEGIN
#ifndef SKIP_RPREP
phase_rwkv_prep(C, i); __syncthreads();
#endif
 PH_END

#ifndef SKIP_G2
PH_BEGIN { pg8::EpiBf16<0> E{PROJ, GPR, nullptr, 0, 0, 1.f}; pg8::Gemm g{XN, WIN + (size_t)RPROJ * D, MP, GPR, D}; pg8::StaticOrder S; S.init(MP, GPR, C.G, C.bid, D);
              pg8::gemm_phase<pg8::EpiBf16<0>, pg8::StaticOrder, true, true>(C.lds, g, S, E); } PH_END
#endif

            PH_BEGIN
#ifndef SKIP_GPREP
phase_gdn_prep(C, i); __syncthreads();
#endif
 PH_END
            PH_BEGIN
#ifndef SKIP_SCAN
phase_scan(C, i);
#endif
 PH_END
            PH_BEGIN
#ifndef SKIP_POST
phase_post(C, i);
#endif
 PH_END
        } else {

#ifndef SKIP_G3
PH_BEGIN { pg8::EpiBf16<0> E{PROJ, 2048, nullptr, 0, 0, 1.f}; run_gemm(C, XN, WIN, 2048, D, E); } PH_END
#endif

            PH_BEGIN
#ifndef SKIP_LPREP
phase_lru_prep(C, i);
#endif
 PH_END
            PH_BEGIN
#ifndef SKIP_LFIN
phase_lru_fin(C, i);
#endif
 PH_END
        }

#ifndef SKIP_GOUT
PH_BEGIN run_gemm_res(C, XN, WOUT, D, 4, l == 0 ? args.in[0] : nullptr); PH_END
#endif

        PH_BEGIN phase_norm<false, false>(C, args.in[9] + l * D, nullptr, 0, 4); PH_END

#ifndef SKIP_GUP
PH_BEGIN { pg8::EpiBf16<2> E{HID, FF, nullptr, 0, 0, 1.f}; run_gemm(C, XN, WUP, FF, D, E); } PH_END
#endif


#ifndef SKIP_GDN
PH_BEGIN run_gemm_res(C, HID, WDN, FF, 16, nullptr); PH_END
#endif

    }
    PH_BEGIN phase_final(C); PH_END
#undef PH_BEGIN
#undef PH_END
}
constexpr int NPHASES = 2 * (11 + 8) + 1;

#ifndef N_LAUNCH_MODE
#define N_LAUNCH_MODE 1
#endif

extern "C" void kernel_launch(void* const* d_in, const int* in_sizes, int n_in, void* d_out, int out_size, void* d_ws, size_t ws_size, hipStream_t stream) {
    static int grid = 0;
    if (grid == 0) {
        if (n_in != 39 || out_size != (int)O_END || ws_size < WS_TOTAL) { fprintf(stderr, "kernel_launch: unexpected shapes: n_in %d out %d ws %zu (need %zu)\n", n_in, out_size, ws_size, (size_t)WS_TOTAL); grid = -1; return; }
        int dev = 0, cus = 0, per_cu = 0;
        hipGetDevice(&dev); hipDeviceGetAttribute(&cus, hipDeviceAttributeMultiprocessorCount, dev);
        hipFuncSetAttribute((const void*)hybrid_fwd, hipFuncAttributeMaxDynamicSharedMemorySize, LDS_BYTES);
        hipOccupancyMaxActiveBlocksPerMultiprocessor(&per_cu, (const void*)hybrid_fwd, NTHR, LDS_BYTES);
        if (per_cu < 1) { fprintf(stderr, "kernel_launch: occupancy query says %d blocks per CU\n", per_cu); per_cu = 1; }
        (void)hipGetLastError();
        grid = cus;
    }
    if (grid < 0) return;
    if (hipMemsetAsync((char*)d_ws + WS_CTL, 0, CTL_BYTES, stream) != hipSuccess) { fprintf(stderr, "kernel_launch: memset of the barrier words failed\n"); return; }
    Args a{};
    for (int k = 0; k < 39; ++k) a.in[k] = (const float*)d_in[k];
    a.out = (float*)d_out; a.ws = (unsigned char*)d_ws;
#if N_LAUNCH_MODE == 1
    a.ph_lo = 0; a.ph_hi = NPHASES;
    void* kargs[] = {&a};
    hipError_t e = hipLaunchCooperativeKernel((const void*)hybrid_fwd, dim3(grid), dim3(NTHR), kargs, LDS_BYTES, stream);
    if (e != hipSuccess) fprintf(stderr, "cooperative launch failed: %s (grid %d)\n", hipGetErrorString(e), grid);
#else
    for (int p = 0; p < NPHASES; ++p) { a.ph_lo = p; a.ph_hi = p + 1; hipLaunchKernelGGL(hybrid_fwd, dim3(grid), dim3(NTHR), LDS_BYTES, stream, a); }
#endif
}
```

```cpp
#include <hip/hip_runtime.h>
#include <hip/hip_cooperative_groups.h>
#include <cstdio>
#include <cstdint>
namespace cg = cooperative_groups;
#define DUPMASK 0ull
#define EXTRA_SYNCS 0
namespace pg8 {
#define PG8_LAS __attribute__((address_space(3)))
typedef unsigned short bf16_t;
typedef short bf16x8 __attribute__((ext_vector_type(8)));
typedef float f32x4 __attribute__((ext_vector_type(4)));
typedef unsigned u32x4 __attribute__((ext_vector_type(4)));
constexpr int BM = 256, BK = 64, HALF = 128, HTB = HALF * BK * 2  , STAGE_BYTES = 8 * HTB, NXCD = 8, WGM = 8;

__host__ __device__ __forceinline__ int lds_byte(int r, int c) { const int st = (r >> 4) * 2 + (c >> 5), rr = r & 15, cc = c & 31, ob = rr * 64 + cc * 2; return st * 1024 + (ob ^ (((ob >> 9) & 1) << 5)); }
__host__ __device__ __forceinline__ void stage_rc(int b, int& R, int& C) { const int st = b / 1024, sb = b % 1024, swz = sb ^ (((sb >> 9) & 1) << 5); R = (st >> 1) * 16 + swz / 64; C = (st & 1) * 32 + (swz % 64) / 2; }
__host__ __device__ __forceinline__ int perm32(int rho) { const int n = rho >> 4, i = rho & 15; return 8 * (i >> 2) + 4 * n + (i & 3); }

struct Unit { int pm, pn, kofs, nt, atomic; };
struct Gemm { const bf16_t* A; const bf16_t* Bt; int M, N, K; };

struct StaticOrder {
    int nM, nN, nwg, G, c, ntK;
    __host__ __device__ void init(int M, int N, int G_, int c_, int K_) { nM = M / BM; nN = N / BM; nwg = nM * nN; G = G_; c = c_; ntK = K_ / BK; }
    __host__ __device__ bool next(int i, Unit& u) const {
        const long L = (long)i * G + c; if (L >= nwg) return false;
        int wgid = (int)L; { const int q = nwg / NXCD, r = nwg % NXCD, xcd = wgid % NXCD, off = wgid / NXCD; wgid = (xcd < r ? xcd * (q + 1) : r * (q + 1) + (xcd - r) * q) + off; }
        const int nig = WGM * nN, gid = wgid / nig, fm = gid * WGM, gsz = (nM - fm) < WGM ? (nM - fm) : WGM;
        u.pm = fm + ((wgid % nig) % gsz); u.pn = (wgid % nig) / gsz; u.kofs = 0; u.nt = ntK; u.atomic = 0; return true;
    }
    __device__ __forceinline__ void a_ready(const Unit&) const {}
    __device__ __forceinline__ void done(const Unit&) const {}
};

__device__ __forceinline__ unsigned cvt_pk_bf16(float lo, float hi) { unsigned r; asm volatile("v_cvt_pk_bf16_f32 %0, %1, %2" : "=v"(r) : "v"(lo), "v"(hi)); return r; }
typedef float f32x2 __attribute__((ext_vector_type(2)));
__device__ __forceinline__ f32x2 gelu_pk(f32x2 v) {
    const f32x2 av = __builtin_elementwise_abs(v), d = av * 0.2316418882f + 1.0f;
    f32x2 t; t.x = __builtin_amdgcn_rcpf(d.x); t.y = __builtin_amdgcn_rcpf(d.y);
    f32x2 q = t * 0.5307027145f + (-0.7265760135f); q = q * t + 0.7107068705f; q = q * t + (-0.142248368f); q = q * t + 0.127414796f; q = q * t;
    const f32x2 s = (v * v) * (-0.72134752044f);
    f32x2 e; e.x = __builtin_amdgcn_exp2f(s.x); e.y = __builtin_amdgcn_exp2f(s.y);
    const f32x2 m = v * (q * e), r = v - m;
    f32x2 o; o.x = v.x < 0.f ? m.x : r.x; o.y = v.y < 0.f ? m.y : r.y; return o;
}

template <int ACT  > struct EpiBf16 {
    static constexpr bool PERM = true, AFTER_DRAIN = false, HAS_INIT = false; static_assert(ACT == 0 || ACT == 1 || ACT == 2, "EpiBf16: ACT is 0 (none), 1 (gelu_pk) or 2 (squared relu)");
    bf16_t* O; int ldc; const float* bias; int split_cols; size_t split_stride; float scale0;
    __device__ __forceinline__ void operator()(const f32x4 (&acc)[2][2][4][2], const Unit& u, int wr, int wc, int fr, int fq) const {
        const int row0 = u.pm * BM + wr * 64 + fr; int colt = u.pn * BM; bf16_t* base = O;
        float sc = 1.f; if (split_cols) { const int t = colt / split_cols; base += (size_t)t * split_stride; colt -= t * split_cols; if (t == 0) sc = scale0; }
        const int col0 = colt + wc * 32 + 8 * fq, bcol0 = u.pn * BM + wc * 32 + 8 * fq;
        f32x4 bv[2][2];
#pragma unroll
        for (int bj = 0; bj < 2; ++bj)
#pragma unroll
            for (int n = 0; n < 2; ++n) bv[bj][n] = bias ? *(const f32x4*)(bias + bcol0 + bj * HALF + 4 * n) : (f32x4){0.f, 0.f, 0.f, 0.f};
#pragma unroll
        for (int ai = 0; ai < 2; ++ai)
#pragma unroll
            for (int m = 0; m < 4; ++m) { bf16_t* rowp = base + (size_t)(row0 + ai * HALF + m * 16) * ldc + col0;
#pragma unroll
                for (int bj = 0; bj < 2; ++bj) { f32x4 v0 = acc[ai][bj][m][0] + bv[bj][0], v1 = acc[ai][bj][m][1] + bv[bj][1];
                    if (ACT == 1) { f32x2 a = gelu_pk((f32x2){v0[0], v0[1]}), b = gelu_pk((f32x2){v0[2], v0[3]}), c = gelu_pk((f32x2){v1[0], v1[1]}), d = gelu_pk((f32x2){v1[2], v1[3]});
                        v0 = (f32x4){a.x, a.y, b.x, b.y}; v1 = (f32x4){c.x, c.y, d.x, d.y}; }
                    if (ACT == 2) {
#pragma unroll
                        for (int e = 0; e < 4; ++e) { const float p0 = v0[e] > 0.f ? v0[e] : 0.f, p1 = v1[e] > 0.f ? v1[e] : 0.f; v0[e] = p0 * p0; v1[e] = p1 * p1; } }
                    v0 = v0 * sc; v1 = v1 * sc; u32x4 w; w.x = cvt_pk_bf16(v0[0], v0[1]); w.y = cvt_pk_bf16(v0[2], v0[3]); w.z = cvt_pk_bf16(v1[0], v1[1]); w.w = cvt_pk_bf16(v1[2], v1[3]);
                    *(u32x4*)(rowp + bj * HALF) = w; } }
    }
};
template <class Epi, class Sched, bool ALIGN_EPI = false, bool SP2 = false>
__device__ __forceinline__ void gemm_phase(PG8_LAS unsigned char* lds, const Gemm g, const Sched& S, const Epi& E) {
    int tid_ = threadIdx.x; asm volatile("" : "+v"(tid_));
    const int tid = tid_, wid = __builtin_amdgcn_readfirstlane(tid >> 6), lane = tid & 63, wr = wid >> 2, wc = wid & 3, fr = lane & 15, fq = lane >> 4;
    const int K = g.K;
    unsigned voffA[2], voffB[2];
#pragma unroll
    for (int i = 0; i < 2; ++i) { int R, C; stage_rc(tid * 16 + i * 8192, R, C); const int Rb = Epi::PERM ? ((R & ~31) + perm32(R & 31)) : R;
        voffA[i] = (unsigned)(R * K + C) * 2u; voffB[i] = (unsigned)(Rb * K + C) * 2u; }
    const size_t kstep = (size_t)(BK * 2);
    const size_t hstep = (size_t)HALF * K * 2;
    const size_t tstep = 2 * hstep;
    const unsigned ldsw = (unsigned)wid * 1024u;
    const int aoff = lds_byte(wr * 64 + fr, fq * 8), boff = lds_byte(wc * 32 + fr, fq * 8);
#define PG8_SA(b, h) (((b) * 2 + (h)) * HTB)
#define PG8_SB(b, h) ((4 + (b) * 2 + (h)) * HTB)
#define PG8_STAGE(bufoff, gbase, voff) do { _Pragma("unroll") for (int _i = 0; _i < 2; ++_i) \
        __builtin_amdgcn_global_load_lds((const unsigned*)((const char*)(gbase) + (voff)[_i]), (PG8_LAS unsigned*)(lds + (bufoff) + ldsw + _i * 8192), 16, 0, 0); } while (0)
#define PG8_LDA(dst, b, h) do { _Pragma("unroll") for (int m = 0; m < 4; ++m) _Pragma("unroll") for (int k = 0; k < 2; ++k) dst[m][k] = *(const PG8_LAS bf16x8*)(lds + PG8_SA(b, h) + aoff + m * 2048 + k * 1024); } while (0)
#define PG8_LDB(dst, b, h) do { _Pragma("unroll") for (int n = 0; n < 2; ++n) _Pragma("unroll") for (int k = 0; k < 2; ++k) dst[n][k] = *(const PG8_LAS bf16x8*)(lds + PG8_SB(b, h) + boff + n * 2048 + k * 1024); } while (0)
#define PG8_MMA(ai, bj, At, Bt) do { __builtin_amdgcn_s_setprio(1); _Pragma("unroll") for (int m = 0; m < 4; ++m) _Pragma("unroll") for (int n = 0; n < 2; ++n) _Pragma("unroll") for (int k = 0; k < 2; ++k) \
        acc[ai][bj][m][n] = __builtin_amdgcn_mfma_f32_16x16x32_bf16(Bt[n][k], At[m][k], acc[ai][bj][m][n], 0, 0, 0); __builtin_amdgcn_s_setprio(0); } while (0)
#define PG8_WAIT_V(n) asm volatile("s_waitcnt vmcnt(" #n ")" ::: "memory")
#define PG8_WAIT_L(n) asm volatile("s_waitcnt lgkmcnt(" #n ")" ::: "memory")
#define PG8_BAR __builtin_amdgcn_s_barrier()
#define PG8_SCHED __builtin_amdgcn_sched_barrier(0)
    Unit cur, nxt; int ui = 0;
    if (!S.next(0, cur)) return;
    f32x4 acc[2][2][4][2];
    if constexpr (Epi::HAS_INIT) E.init(acc, cur, wr, wc, fr, fq);
    else {
#pragma unroll
    for (int a = 0; a < 2; ++a)
#pragma unroll
        for (int b = 0; b < 2; ++b)
#pragma unroll
            for (int m = 0; m < 4; ++m)
#pragma unroll
                for (int n = 0; n < 2; ++n) acc[a][b][m][n] = (f32x4){0.f, 0.f, 0.f, 0.f};
    }
    bf16x8 At[4][2], B0[2][2], B1[2][2];
    const char* cA = (const char*)g.A + (size_t)cur.pm * tstep + (size_t)cur.kofs * 2; const char* cB = (const char*)g.Bt + (size_t)cur.pn * tstep + (size_t)cur.kofs * 2;
    S.a_ready(cur);
    if constexpr (SP2) {
        PG8_STAGE(PG8_SB(0, 0), cB, voffB); PG8_STAGE(PG8_SB(0, 1), cB + hstep, voffB); PG8_STAGE(PG8_SA(0, 0), cA, voffA); PG8_STAGE(PG8_SA(0, 1), cA + hstep, voffA);
        if (wr == 1) PG8_BAR;
        PG8_WAIT_V(2); PG8_BAR;
        PG8_STAGE(PG8_SB(1, 0), cB + kstep, voffB); PG8_STAGE(PG8_SA(1, 0), cA + kstep, voffA); PG8_STAGE(PG8_SB(1, 1), cB + hstep + kstep, voffB);
        PG8_WAIT_V(6); PG8_BAR;
    } else {
        PG8_STAGE(PG8_SB(0, 0), cB, voffB); PG8_STAGE(PG8_SA(0, 0), cA, voffA); PG8_STAGE(PG8_SB(0, 1), cB + hstep, voffB); PG8_STAGE(PG8_SA(0, 1), cA + hstep, voffA);
        if (wr == 1) PG8_BAR;
        PG8_WAIT_V(4); PG8_BAR;
        PG8_STAGE(PG8_SB(1, 0), cB + kstep, voffB); PG8_STAGE(PG8_SA(1, 0), cA + kstep, voffA); PG8_STAGE(PG8_SB(1, 1), cB + hstep + kstep, voffB);
        PG8_WAIT_V(6); PG8_BAR;
    }
    for (;;) {
        const bool has_next = S.next(ui + 1, nxt);
        const char* nA = has_next ? (const char*)g.A + (size_t)nxt.pm * tstep + (size_t)nxt.kofs * 2 : cA; const char* nB = has_next ? (const char*)g.Bt + (size_t)nxt.pn * tstep + (size_t)nxt.kofs * 2 : cB;
        const int nt = cur.nt;
        for (int t = 0; t < nt; t += 2) {
            const bool last = (t == nt - 2);
            const char* a1 = cA + (size_t)(t + 1) * kstep;
            const char* a2 = last ? nA : cA + (size_t)(t + 2) * kstep; const char* b2 = last ? nB : cB + (size_t)(t + 2) * kstep;
            const char* a3 = a2 + kstep; const char* b3 = b2 + kstep;
            if (last && has_next) S.a_ready(nxt);
            if constexpr (SP2) {
            PG8_LDB(B0, 0, 0); PG8_LDB(B1, 0, 1); PG8_SCHED; PG8_LDA(At, 0, 0); PG8_STAGE(PG8_SA(1, 1), a1 + hstep, voffA);
            PG8_WAIT_V(8); PG8_WAIT_L(0); PG8_BAR; PG8_MMA(0, 0, At, B0); PG8_MMA(0, 1, At, B1); PG8_BAR; PG8_SCHED;
            PG8_LDA(At, 0, 1); PG8_STAGE(PG8_SB(0, 0), b2, voffB); PG8_STAGE(PG8_SB(0, 1), b2 + hstep, voffB); PG8_STAGE(PG8_SA(0, 0), a2, voffA);
            PG8_WAIT_V(8); PG8_WAIT_L(0); PG8_BAR; PG8_MMA(1, 0, At, B0); PG8_MMA(1, 1, At, B1); PG8_BAR; PG8_SCHED;
            PG8_LDB(B0, 1, 0); PG8_LDB(B1, 1, 1); PG8_SCHED; PG8_LDA(At, 1, 0); PG8_STAGE(PG8_SA(0, 1), a2 + hstep, voffA);
            PG8_WAIT_V(8); PG8_WAIT_L(0); PG8_BAR; PG8_MMA(0, 0, At, B0); PG8_MMA(0, 1, At, B1); PG8_BAR; PG8_SCHED;
            PG8_LDA(At, 1, 1); PG8_STAGE(PG8_SB(1, 0), b3, voffB); PG8_STAGE(PG8_SB(1, 1), b3 + hstep, voffB); PG8_STAGE(PG8_SA(1, 0), a3, voffA);
            PG8_WAIT_V(8); PG8_WAIT_L(0); PG8_BAR; PG8_MMA(1, 0, At, B0); PG8_MMA(1, 1, At, B1); PG8_BAR; PG8_SCHED;
            } else {
            PG8_LDB(B0, 0, 0); PG8_SCHED; PG8_LDA(At, 0, 0); PG8_STAGE(PG8_SA(1, 1), a1 + hstep, voffA);
            PG8_WAIT_L(8); PG8_BAR; PG8_WAIT_L(0); PG8_MMA(0, 0, At, B0); PG8_BAR; PG8_SCHED;
            PG8_LDB(B1, 0, 1); PG8_STAGE(PG8_SB(0, 0), b2, voffB);
            PG8_BAR; PG8_WAIT_L(0); PG8_MMA(0, 1, At, B1); PG8_BAR;
            PG8_LDA(At, 0, 1); PG8_STAGE(PG8_SA(0, 0), a2, voffA);
            PG8_BAR; PG8_WAIT_L(0); PG8_MMA(1, 0, At, B0); PG8_BAR; PG8_SCHED;
            PG8_STAGE(PG8_SB(0, 1), b2 + hstep, voffB);
            PG8_WAIT_V(6); PG8_BAR; PG8_MMA(1, 1, At, B1); PG8_BAR;
            PG8_LDB(B0, 1, 0); PG8_SCHED; PG8_LDA(At, 1, 0); PG8_STAGE(PG8_SA(0, 1), a2 + hstep, voffA);
            PG8_WAIT_L(8); PG8_BAR; PG8_WAIT_L(0); PG8_MMA(0, 0, At, B0); PG8_BAR; PG8_SCHED;
            PG8_LDB(B1, 1, 1); PG8_STAGE(PG8_SB(1, 0), b3, voffB);
            PG8_BAR; PG8_WAIT_L(0); PG8_MMA(0, 1, At, B1); PG8_BAR;
            PG8_LDA(At, 1, 1); PG8_STAGE(PG8_SA(1, 0), a3, voffA);
            PG8_BAR; PG8_WAIT_L(0); PG8_MMA(1, 0, At, B0); PG8_BAR; PG8_SCHED;
            PG8_STAGE(PG8_SB(1, 1), b3 + hstep, voffB);
            PG8_WAIT_V(6); PG8_BAR; PG8_MMA(1, 1, At, B1); PG8_BAR;
            }
        }
        if constexpr (ALIGN_EPI) { if (wr == 0) PG8_BAR; }
        if constexpr (!Epi::AFTER_DRAIN) { E(acc, cur, wr, wc, fr, fq); S.done(cur); }
        if (!has_next) break;
        if constexpr (Epi::HAS_INIT) E.init(acc, nxt, wr, wc, fr, fq);
        else {
#pragma unroll
        for (int a = 0; a < 2; ++a)
#pragma unroll
            for (int b = 0; b < 2; ++b)
#pragma unroll
                for (int m = 0; m < 4; ++m)
#pragma unroll
                    for (int n = 0; n < 2; ++n) acc[a][b][m][n] = (f32x4){0.f, 0.f, 0.f, 0.f};
        }
        cur = nxt; cA = nA; cB = nB; ++ui;
        if constexpr (ALIGN_EPI) { if (wr == 1) PG8_BAR; }
    }
    PG8_WAIT_V(0);
    if constexpr (!ALIGN_EPI) { if (wr == 0) PG8_BAR; }
    PG8_BAR;
    if constexpr (Epi::AFTER_DRAIN) { E.fused(acc, cur, wr, wc, fr, fq, lds, wid, lane); S.done(cur); }
#undef PG8_SA
#undef PG8_SB
#undef PG8_STAGE
#undef PG8_LDA
#undef PG8_LDB
#undef PG8_MMA
#undef PG8_WAIT_V
#undef PG8_WAIT_L
#undef PG8_BAR
#undef PG8_SCHED
}
}

#define LAS __attribute__((address_space(3)))
typedef unsigned short bf16;
typedef unsigned v4u __attribute__((ext_vector_type(4)));
typedef unsigned v2u __attribute__((ext_vector_type(2)));
typedef float f32x4 __attribute__((ext_vector_type(4)));
typedef float f32x2 __attribute__((ext_vector_type(2)));
typedef short bf16x8 __attribute__((ext_vector_type(8)));

constexpr int NWAVES = 8, NTHR = 512;
constexpr int D = 1024, MP = 16384, MS = 1024, M = MP + MS, TP = 2048, NB = 8, SB = 128, TS = 8, DEPTH = 4;
constexpr int RH = 8, RHD = 64, RW = 512, RPROJ = 1792;
constexpr int GH = 4, GHD = 128, GW = 512, GQKV = 1536, GPR = 2048;
constexpr int EPROJ = 3848, FF = 4096;
constexpr int NSEQ = NB + SB;

constexpr size_t O_Y = 0;
constexpr size_t O_RWKV_P = (size_t)M * D;
constexpr size_t O_RWKV_S = O_RWKV_P + (size_t)2 * NB * RH * 4096;
constexpr size_t O_SH_P = O_RWKV_S + (size_t)2 * SB * RH * 4096;
constexpr size_t O_SH_S = O_SH_P + (size_t)2 * NB * RPROJ;
constexpr size_t O_GDN_P = O_SH_S + (size_t)2 * SB * RPROJ;
constexpr size_t O_GDN_S = O_GDN_P + (size_t)2 * NB * GH * 16384;
constexpr size_t O_GC_P = O_GDN_S + (size_t)2 * SB * GH * 16384;
constexpr size_t O_GC_S = O_GC_P + (size_t)2 * NB * 3 * GQKV;
constexpr size_t O_LRU_P = O_GC_S + (size_t)2 * SB * 3 * GQKV;
constexpr size_t O_LRU_S = O_LRU_P + (size_t)2 * NB * D;
constexpr size_t O_LC_P = O_LRU_S + (size_t)2 * SB * D;
constexpr size_t O_LC_S = O_LC_P + (size_t)2 * NB * 3 * D;
constexpr size_t O_END = O_LC_S + (size_t)2 * SB * 3 * D;
static_assert(O_END == 47419392, "output size");

constexpr size_t MiB = 1u << 20;
constexpr size_t WS_WIN = 0, WS_WOUT = 8 * MiB, WS_WUP = 10 * MiB, WS_WDN = 18 * MiB, WS_WA = 26 * MiB, WS_WI = 26 * MiB + 512 * 1024;
constexpr size_t WS_CTL = 27 * MiB, CTL_BYTES = 16384;
constexpr size_t WS_W2T = 26 * MiB, WS_A2T = 26 * MiB + 65536, WS_G2T = 26 * MiB + 131072;
constexpr size_t WS_XN = 28 * MiB;
constexpr size_t WS_PROJ = 62 * MiB;
constexpr size_t WS_YRAW = WS_PROJ, WS_ORAW = WS_PROJ + 34 * MiB;
constexpr size_t WS_SCN = 130 * MiB;
constexpr size_t A17 = 17 * MiB;
constexpr size_t WS_RU = WS_SCN, WS_RA = WS_SCN + A17, WS_RB = WS_SCN + 2 * A17, WS_RK = WS_SCN + 3 * A17, WS_RWR = WS_SCN + 4 * A17, WS_RV = WS_SCN + 5 * A17, WS_RG = WS_SCN + 6 * A17;
constexpr size_t WS_GQ = WS_SCN + 7 * A17, WS_GK = WS_SCN + 8 * A17, WS_GV = WS_SCN + 9 * A17, WS_GZ = WS_SCN + 10 * A17;
constexpr size_t WS_RSC = WS_SCN + 11 * A17;
constexpr size_t WS_GSC = WS_RSC + 3 * MiB;
constexpr size_t WS_P8 = WS_GSC + 2 * MiB;
constexpr size_t WS_END_EVEN = WS_P8 + 1 * MiB;
constexpr size_t WS_LP = WS_SCN, WS_LH = WS_SCN + 68 * MiB, WS_LTOT = WS_SCN + 136 * MiB;
constexpr size_t WS_HID = WS_PROJ;
constexpr size_t WS_PART = 200 * MiB;
constexpr size_t WS_H = WS_END_EVEN;
constexpr size_t WS_TOTAL = WS_H + 34 * MiB;
static_assert(WS_PART >= WS_HID + (size_t)M * FF * 2 && WS_PART + 64 * MiB <= WS_TOTAL, "PART placement");
static_assert(WS_HID + (size_t)M * FF * 2 <= WS_TOTAL && WS_LTOT + 544 * 1024 * 8 <= WS_TOTAL, "ws map");

constexpr int LDS_BYTES = 147456, MISC_OFF = 131072 + 256;

struct Args { const float* in[39]; float* out; unsigned char* ws; int ph_lo, ph_hi; };

__device__ __forceinline__ float bf2f(bf16 b) { return __builtin_bit_cast(float, (unsigned)b << 16); }
__device__ __forceinline__ float bflo(unsigned w) { return __builtin_bit_cast(float, w << 16); }
__device__ __forceinline__ float bfhi(unsigned w) { return __builtin_bit_cast(float, w & 0xffff0000u); }
__device__ __forceinline__ unsigned f2bf(float f) { unsigned u = __builtin_bit_cast(unsigned, f); return (u + 0x7fffu + ((u >> 16) & 1u)) >> 16; }
__device__ __forceinline__ unsigned pk2(float lo, float hi) { return f2bf(lo) | (f2bf(hi) << 16); }
__device__ __forceinline__ float wave_sum(float v) {
#pragma unroll
    for (int o = 1; o < 64; o <<= 1) v += __shfl_xor(v, o);
    return v;
}
template <int CTRL> __device__ __forceinline__ float dppf(float x) { return __builtin_bit_cast(float, __builtin_amdgcn_update_dpp(0, __builtin_bit_cast(int, x), CTRL, 0xf, 0xf, false)); }
__device__ __forceinline__ float allsum16(float x) { x += dppf<0x128>(x); x += dppf<0x124>(x); x += dppf<0x122>(x); x += dppf<0x121>(x); return x; }
__device__ __forceinline__ float sigmoidf_(float x) { return __builtin_amdgcn_rcpf(1.0f + __expf(-x)); }
__device__ __forceinline__ float softplusf_(float x) { return fmaxf(x, 0.f) + log1pf(__expf(-fabsf(x))); }
__device__ __forceinline__ float siluf_(float x) { return x * __builtin_amdgcn_rcpf(1.0f + __expf(-x)); }
__device__ __forceinline__ float tanhf_(float x) { return 1.0f - 2.0f * __builtin_amdgcn_rcpf(1.0f + __expf(2.0f * x)); }
#define LDS_WAIT() asm volatile("s_waitcnt lgkmcnt(0)" ::: "memory")

#define XB_TMO      128
#define XB_XCNT(j)  (256  + 64 * (j))
#define XB_XSUB(j)  (1280 + 64 * (j))
#define XB_XGEN(j)  (2304 + 64 * (j))
#define XB_TOP      3328
#define XB_TOPGEN   3392
#define XCD_BAR_WORDS 3456
#define XB_SPIN_CAP (1u << 18)

__device__ __forceinline__ unsigned xb_ld(unsigned* p)              { return __hip_atomic_load(p, __ATOMIC_RELAXED, __HIP_MEMORY_SCOPE_AGENT); }
__device__ __forceinline__ unsigned xb_add(unsigned* p, unsigned v) { return __hip_atomic_fetch_add(p, v, __ATOMIC_RELAXED, __HIP_MEMORY_SCOPE_AGENT); }
__device__ __forceinline__ unsigned xb_xcc_id() { return (unsigned)__builtin_amdgcn_s_getreg((3 << 11) | 20) & 0xFu; }
#define XB_SPIN(cond, bar) do { unsigned _sp = 0; while (cond) { __builtin_amdgcn_s_sleep(1); \
    if ((++_sp & 255u) == 0u) { if (xb_ld(&(bar)[XB_TMO])) break; if (_sp > XB_SPIN_CAP) { atomicAdd(&(bar)[XB_TMO], 1u); break; } } } } while (0)

struct XcdBarrier {
    unsigned* bar; unsigned x;
    volatile LAS unsigned* st;
};

__device__ __forceinline__ XcdBarrier xcd_barrier_post(unsigned* bar, volatile LAS unsigned* st) {
    XcdBarrier b; b.bar = bar; b.x = xb_xcc_id(); b.st = st;
    if (threadIdx.x == 0) (void)xb_add(&bar[XB_XCNT(b.x)], 1u);
    return b;
}
__device__ __forceinline__ void xcd_barrier_complete(unsigned* bar, unsigned x, unsigned& nloc, unsigned& nx) {
    const unsigned G = gridDim.x * gridDim.y * gridDim.z;
    unsigned sum, cnt, mine, sp = 0u;
    for (;;) {
        sum = 0u; cnt = 0u; mine = 0u;
#pragma unroll
        for (unsigned j = 0; j < 16; ++j) { const unsigned c = xb_ld(&bar[XB_XCNT(j)]); sum += c; cnt += (c > 0u) ? 1u : 0u; mine = (j == x) ? c : mine; }
        if (sum == G) break;
        __builtin_amdgcn_s_sleep(1);
        if ((++sp & 255u) == 0u) { if (xb_ld(&bar[XB_TMO])) break; if (sp > XB_SPIN_CAP) { atomicAdd(&bar[XB_TMO], 1u); break; } }
    }
    nloc = mine > 0u ? mine : 1u; nx = cnt > 0u ? cnt : 1u;
}

__device__ __forceinline__ void xcd_barrier(const XcdBarrier& b) {
    asm volatile("s_waitcnt vmcnt(0)" ::: "memory");
    __syncthreads();
    if (threadIdx.x == 0) {
        unsigned* bar = b.bar;
        __builtin_amdgcn_s_waitcnt(0);
        unsigned nloc = b.st[0], nx = b.st[1];
        if (nloc == 0u) { xcd_barrier_complete(bar, b.x, nloc, nx); b.st[0] = nloc; b.st[1] = nx; }
        const unsigned old = xb_add(&bar[XB_XSUB(b.x)], 1u);
        const unsigned gen = old / nloc;
        if (old + 1u == (gen + 1u) * nloc) {
            __builtin_amdgcn_fence(__ATOMIC_RELEASE, "agent");
            asm volatile("s_waitcnt vmcnt(0)" ::: "memory");
            const unsigned og = xb_add(&bar[XB_TOP], 1u);
            const unsigned tg = og / nx;
            if (og + 1u == (tg + 1u) * nx) xb_add(&bar[XB_TOPGEN], 1u);
            else XB_SPIN(xb_ld(&bar[XB_TOPGEN]) == tg, bar);
            __builtin_amdgcn_fence(__ATOMIC_ACQUIRE, "agent");
            xb_add(&bar[XB_XGEN(b.x)], 1u);
            asm volatile("s_waitcnt vmcnt(0)" ::: "memory");
        } else {
            XB_SPIN(xb_ld(&bar[XB_XGEN(b.x)]) == gen, bar);
            __builtin_amdgcn_fence(__ATOMIC_ACQUIRE, "agent");
            asm volatile("s_waitcnt vmcnt(0)" ::: "memory");
        }
    }
    __syncthreads();
}

struct Ctx {
    LAS unsigned char* lds;
    const float* const* in;
    float* out; unsigned char* ws;
    int bid, G;
};
#define PHASE_IDS int tid = threadIdx.x; asm volatile("" : "+v"(tid)); const int lane = tid & 63; const int wave = __builtin_amdgcn_readfirstlane(tid >> 6); (void)lane; (void)wave;

__device__ __forceinline__ void transpose_item(const float* W, int ldw, int K, int N, bf16* WT, LAS float* scr, int item, int lane) {
    const int nblk = N / 32, kb = item / nblk, nb = item % nblk, k0 = 64 * kb, n0 = 32 * nb;
#pragma unroll 8
    for (int i = 0; i < 32; ++i) { const int kk = 2 * i + (lane >> 5); scr[kk * 33 + (lane & 31)] = W[(size_t)(k0 + kk) * ldw + n0 + (lane & 31)]; }
    LDS_WAIT(); asm volatile("" ::: "memory");
    const int c = lane & 7;
#pragma unroll
    for (int j = 0; j < 4; ++j) { const int n = (lane >> 3) + 8 * j; const LAS float* s = scr + (8 * c) * 33 + n;
        v4u o; o.x = pk2(s[0 * 33], s[1 * 33]); o.y = pk2(s[2 * 33], s[3 * 33]); o.z = pk2(s[4 * 33], s[5 * 33]); o.w = pk2(s[6 * 33], s[7 * 33]);
        *(v4u*)(WT + (size_t)(n0 + n) * K + k0 + 8 * c) = o; }
    LDS_WAIT(); asm volatile("" ::: "memory");
}

__device__ __forceinline__ void phase_convert(Ctx& C, int l) {
    PHASE_IDS
    const int i = l >> 1; const bool even = (l & 1) == 0;
    LAS float* scr = (LAS float*)(C.lds + wave * 8448);
    const int gw = C.bid * NWAVES + wave, NGW = C.G * NWAVES;
    bf16* WIN = (bf16*)(C.ws + WS_WIN); bf16* WOUT = (bf16*)(C.ws + WS_WOUT); bf16* WUP = (bf16*)(C.ws + WS_WUP); bf16* WDN = (bf16*)(C.ws + WS_WDN);
    const float* up = C.in[37] + (size_t)l * D * FF; const float* dn = C.in[38] + (size_t)l * FF * D;
    const int NIN = even ? 3840 : 2048, LDIN = even ? EPROJ : 2048;
    const float* win = even ? C.in[11] + (size_t)i * D * EPROJ : C.in[28] + (size_t)i * D * 2048;
    const float* wout = even ? C.in[12] + (size_t)i * D * D : C.in[29] + (size_t)i * D * D;
    const int I_IN = (D / 64) * (NIN / 32), I_OUT = (D / 64) * (D / 32), I_UP = (D / 64) * (FF / 32), I_DN = (FF / 64) * (D / 32), I_G = even ? 0 : 8 * 8, I_L = even ? 16 : 0;
    const int NITEMS = I_IN + I_OUT + I_UP + I_DN + 2 * I_G + 4 * I_L;
    for (int it = gw; it < NITEMS; it += NGW) {
        int r = it;
        if (r < I_IN) { transpose_item(win, LDIN, D, NIN, WIN, scr, r, lane); continue; } r -= I_IN;
        if (r < I_OUT) { transpose_item(wout, D, D, D, WOUT, scr, r, lane); continue; } r -= I_OUT;
        if (r < I_UP) { transpose_item(up, FF, D, FF, WUP, scr, r, lane); continue; } r -= I_UP;
        if (r < I_DN) { transpose_item(dn, D, FF, D, WDN, scr, r, lane); continue; } r -= I_DN;
        if (even) {
            if (r < I_L) { transpose_item(C.in[15] + (size_t)i * 64 * RW, RW, 64, RW, (bf16*)(C.ws + WS_W2T), scr, r, lane); continue; } r -= I_L;
            if (r < I_L) { transpose_item(C.in[17] + (size_t)i * 64 * RW, RW, 64, RW, (bf16*)(C.ws + WS_A2T), scr, r, lane); continue; } r -= I_L;
            transpose_item(C.in[18] + (size_t)i * 128 * RW, RW, 128, RW, (bf16*)(C.ws + WS_G2T), scr, r, lane); continue;
        }
        if (r < I_G) { const int h = r >> 3; transpose_item(C.in[32] + (size_t)(i * 8 + h) * 16384, 128, 128, 128, (bf16*)(C.ws + WS_WA) + h * 16384, scr, r & 7, lane); continue; } r -= I_G;
        { const int h = r >> 3; transpose_item(C.in[34] + (size_t)(i * 8 + h) * 16384, 128, 128, 128, (bf16*)(C.ws + WS_WI) + h * 16384, scr, r & 7, lane); }
    }
}

template <bool FIRST, bool P8>
__device__ __forceinline__ void phase_norm(Ctx& C, const float* nw, const float* w8src  , int ld8, int npart) {
    PHASE_IDS
    LAS float* w8 = (LAS float*)(C.lds + 96 * 1024);
    if (P8) {
        for (int idx = tid; idx < 8192; idx += NTHR) w8[idx] = w8src[(size_t)(idx >> 3) * ld8 + (idx & 7)];
        __syncthreads();
    }
    const int gw = C.bid * NWAVES + wave, NGW = C.G * NWAVES;
    bf16* XN = (bf16*)(C.ws + WS_XN); float* P8o = (float*)(C.ws + WS_P8);
    f32x4 wv[4];
#pragma unroll
    for (int j = 0; j < 4; ++j) wv[j] = *(const f32x4*)(nw + 4 * lane + 256 * j);
    for (int m = gw; m < M; m += NGW) {
        bf16* hrow = (bf16*)(C.ws + WS_H) + (size_t)m * D + 4 * lane;
        f32x4 v[4]; float ss = 0.f;
        if (FIRST) { const float* src = (m < MP ? C.in[0] + (size_t)m * D : C.in[1] + (size_t)(m - MP) * D);
#pragma unroll
            for (int j = 0; j < 4; ++j) v[j] = *(const f32x4*)(src + 4 * lane + 256 * j); }
        else {
#pragma unroll
            for (int j = 0; j < 4; ++j) { const v2u hw = *(const v2u*)(hrow + 256 * j); v[j] = (f32x4){bflo(hw.x), bfhi(hw.x), bflo(hw.y), bfhi(hw.y)}; } }
        if (!FIRST && m >= MP && npart > 0) {
            const bf16* pp = (const bf16*)(C.ws + WS_PART) + (size_t)(m - MP) * D + 4 * lane;
            for (int ks = 0; ks < npart; ++ks) {
#pragma unroll
                for (int j = 0; j < 4; ++j) { const v2u pw = *(const v2u*)(pp + (size_t)ks * MS * D + 256 * j); v[j] += (f32x4){bflo(pw.x), bfhi(pw.x), bflo(pw.y), bfhi(pw.y)}; } }
#pragma unroll
            for (int j = 0; j < 4; ++j) { v2u hw; hw.x = pk2(v[j].x, v[j].y); hw.y = pk2(v[j].z, v[j].w); *(v2u*)(hrow + 256 * j) = hw; }
        }
#pragma unroll
        for (int j = 0; j < 4; ++j) ss += (v[j].x * v[j].x + v[j].y * v[j].y) + (v[j].z * v[j].z + v[j].w * v[j].w);
        if (FIRST && m >= MP) {
#pragma unroll
            for (int j = 0; j < 4; ++j) { v2u hw; hw.x = pk2(v[j].x, v[j].y); hw.y = pk2(v[j].z, v[j].w); *(v2u*)(hrow + 256 * j) = hw; }
        }
        const float rs = rsqrtf(wave_sum(ss) * (1.f / D) + 1e-6f);
        float d8[8];
#pragma unroll
        for (int q = 0; q < 8; ++q) d8[q] = 0.f;
#pragma unroll
        for (int j = 0; j < 4; ++j) {
            v[j] = v[j] * rs * wv[j];
            v2u o; o.x = pk2(v[j].x, v[j].y); o.y = pk2(v[j].z, v[j].w);
            *(v2u*)(XN + (size_t)m * D + 4 * lane + 256 * j) = o;
            if (P8) {
#pragma unroll
                for (int e = 0; e < 4; ++e) { const int k = 4 * lane + 256 * j + e; const f32x4 a = *(const LAS f32x4*)(w8 + k * 8), b = *(const LAS f32x4*)(w8 + k * 8 + 4); const float x = v[j][e];
                    d8[0] += x * a.x; d8[1] += x * a.y; d8[2] += x * a.z; d8[3] += x * a.w; d8[4] += x * b.x; d8[5] += x * b.y; d8[6] += x * b.z; d8[7] += x * b.w; }
            }
        }
        if (P8) {
#pragma unroll
            for (int q = 0; q < 8; ++q) d8[q] = wave_sum(d8[q]);
            if (lane == 0) { *(f32x4*)(P8o + (size_t)m * 8) = (f32x4){d8[0], d8[1], d8[2], d8[3]}; *(f32x4*)(P8o + (size_t)m * 8 + 4) = (f32x4){d8[4], d8[5], d8[6], d8[7]}; }
        }
    }
}

__device__ __forceinline__ void phase_final(Ctx& C) {
    PHASE_IDS
    const int gw = C.bid * NWAVES + wave, NGW = C.G * NWAVES; const float* nw = C.in[10];
    f32x4 wv[4];
#pragma unroll
    for (int j = 0; j < 4; ++j) wv[j] = *(const f32x4*)(nw + 4 * lane + 256 * j);
    for (int m = gw; m < M; m += NGW) {
        float* row = C.out + (size_t)m * D; f32x4 v[4]; float ss = 0.f; const bf16* hrow = (const bf16*)(C.ws + WS_H) + (size_t)m * D + 4 * lane;
#pragma unroll
        for (int j = 0; j < 4; ++j) { const v2u hw = *(const v2u*)(hrow + 256 * j); v[j] = (f32x4){bflo(hw.x), bfhi(hw.x), bflo(hw.y), bfhi(hw.y)}; }
        if (m >= MP) { const bf16* pp = (const bf16*)(C.ws + WS_PART) + (size_t)(m - MP) * D + 4 * lane;
            for (int ks = 0; ks < 16; ++ks) {
#pragma unroll
                for (int j = 0; j < 4; ++j) { const v2u pw = *(const v2u*)(pp + (size_t)ks * MS * D + 256 * j); v[j] += (f32x4){bflo(pw.x), bfhi(pw.x), bflo(pw.y), bfhi(pw.y)}; } } }
#pragma unroll
        for (int j = 0; j < 4; ++j) ss += (v[j].x * v[j].x + v[j].y * v[j].y) + (v[j].z * v[j].z + v[j].w * v[j].w);
        const float rs = rsqrtf(wave_sum(ss) * (1.f / D) + 1e-6f);
#pragma unroll
        for (int j = 0; j < 4; ++j) *(f32x4*)(row + 4 * lane + 256 * j) = v[j] * rs * wv[j];
    }
}

struct EpiRes {
    static constexpr bool PERM = false, AFTER_DRAIN = false, HAS_INIT = true;
    bf16* H; bf16* PART; const float* Hin;
    __device__ __forceinline__ void init(pg8::f32x4 (&acc)[2][2][4][2], const pg8::Unit& u, int wr, int wc, int fr, int fq) const {
        const size_t uo = (size_t)(u.pm * 256 + wr * 64) * D + u.pn * 256 + wc * 32;
        const float* ub = Hin + uo; const bf16* ubh = H + uo;
        const int loff = fr * D + 4 * fq;
#pragma unroll
        for (int ai = 0; ai < 2; ++ai)
#pragma unroll
            for (int m = 0; m < 4; ++m) { const float* rowp = ub + (size_t)(ai * 128 + m * 16) * D; const bf16* rowh = ubh + (size_t)(ai * 128 + m * 16) * D;
#pragma unroll
                for (int bj = 0; bj < 2; ++bj)
#pragma unroll
                    for (int n = 0; n < 2; ++n) { if (u.atomic) acc[ai][bj][m][n] = (pg8::f32x4){0.f, 0.f, 0.f, 0.f}; else if (Hin) { const f32x4 o = *(const f32x4*)(rowp + loff + bj * 128 + n * 16); acc[ai][bj][m][n] = (pg8::f32x4){o.x, o.y, o.z, o.w}; }
                        else { const v2u hw = *(const v2u*)(rowh + loff + bj * 128 + n * 16); acc[ai][bj][m][n] = (pg8::f32x4){bflo(hw.x), bfhi(hw.x), bflo(hw.y), bfhi(hw.y)}; } } }
    }
    __device__ __forceinline__ void operator()(const pg8::f32x4 (&acc)[2][2][4][2], const pg8::Unit& u, int wr, int wc, int fr, int fq) const {
        const int row0 = u.pm * 256 + wr * 64 + fr, col0 = u.pn * 256 + wc * 32 + 4 * fq;
#pragma unroll
        for (int ai = 0; ai < 2; ++ai)
#pragma unroll
            for (int m = 0; m < 4; ++m) { const size_t ro = (size_t)(row0 + ai * 128 + m * 16) * D + col0;
#pragma unroll
                for (int bj = 0; bj < 2; ++bj)
#pragma unroll
                    for (int n = 0; n < 2; ++n) { const size_t eo = ro + bj * 128 + n * 16; const pg8::f32x4 a = acc[ai][bj][m][n]; v2u pw; pw.x = pk2(a[0], a[1]); pw.y = pk2(a[2], a[3]);
                        if (u.atomic) { *(v2u*)(PART + ((size_t)(u.atomic - 1) * MS * D) + eo - (size_t)MP * D) = pw; }
                        else { *(v2u*)(H + eo) = pw; } } }
    }
};

struct SplitOrder {
    pg8::StaticOrder base; int nsplit, K, c;
    __device__ void init(int N, int G_, int c_, int K_, int nsplit_) { base.init(MP, N, G_, c_, K_); nsplit = nsplit_; K = K_; c = c_; }
    __device__ bool next(int i, pg8::Unit& u) const {
        if (i == 0) return base.next(0, u);
        if (i == 1 && c < 16 * nsplit) { const int tile = c / nsplit, ks = c - tile * nsplit; u.pm = 64 + (tile >> 2); u.pn = tile & 3; u.kofs = ks * (K / nsplit); u.nt = K / nsplit / 64; u.atomic = ks + 1; return true; }
        return false;
    }
    __device__ __forceinline__ void a_ready(const pg8::Unit&) const {}
    __device__ __forceinline__ void done(const pg8::Unit&) const {}
};
__device__ __forceinline__ void run_gemm_res(Ctx& C, const bf16* A, const bf16* Bt, int K, int nsplit, const float* hin) {
    pg8::Gemm g{A, Bt, M, D, K}; SplitOrder S; S.init(D, C.G, C.bid, K, nsplit); EpiRes E{(bf16*)(C.ws + WS_H), (bf16*)(C.ws + WS_PART), hin};
    pg8::gemm_phase<EpiRes, SplitOrder, true, true>(C.lds, g, S, E);
}
struct ProjAOrder {
    pg8::StaticOrder base; int G, c;
    __device__ void init(int G_, int c_) { base.init(M, RPROJ, G_, c_, D); G = G_; c = c_; }
    __device__ bool next(int i, pg8::Unit& u) const {
        if (base.next(i, u)) return true;
        const int L = i * G + c;
        if (L < 476 + 32) { const int idx = L - 476; u.pm = 64 + (idx >> 3); u.pn = 7 + (idx & 7); u.kofs = 0; u.nt = D / 64; u.atomic = 0; return true; }
        return false;
    }
    __device__ __forceinline__ void a_ready(const pg8::Unit&) const {}
    __device__ __forceinline__ void done(const pg8::Unit&) const {}
};
struct EpiProjA {
    static constexpr bool PERM = true, AFTER_DRAIN = false, HAS_INIT = false;
    pg8::bf16_t* O;
    __device__ __forceinline__ void operator()(const pg8::f32x4 (&acc)[2][2][4][2], const pg8::Unit& u, int wr, int wc, int fr, int fq) const {
        const int gt = __builtin_amdgcn_readfirstlane(u.pn >= 7 ? 1 : 0); const int ldc = RPROJ + gt * 256; const int colt = (u.pn - 7 * gt) * 256;
        const int row0 = u.pm * 256 + wr * 64 + fr, col0 = colt + wc * 32 + 8 * fq;
#pragma unroll
        for (int ai = 0; ai < 2; ++ai)
#pragma unroll
            for (int m = 0; m < 4; ++m) { pg8::bf16_t* rowp = O + (size_t)(row0 + ai * 128 + m * 16) * ldc + col0;
#pragma unroll
                for (int bj = 0; bj < 2; ++bj) { const pg8::f32x4 v0 = acc[ai][bj][m][0], v1 = acc[ai][bj][m][1];
                    pg8::u32x4 w; w.x = pg8::cvt_pk_bf16(v0[0], v0[1]); w.y = pg8::cvt_pk_bf16(v0[2], v0[3]); w.z = pg8::cvt_pk_bf16(v1[0], v1[1]); w.w = pg8::cvt_pk_bf16(v1[2], v1[3]);
                    *(pg8::u32x4*)(rowp + bj * 128) = w; } }
    }
};
template <class Epi>
__device__ __forceinline__ void run_gemm(Ctx& C, const bf16* A, const bf16* Bt, int N, int K, const Epi& E) {
    pg8::Gemm g{A, Bt, M, N, K}; pg8::StaticOrder S; S.init(M, N, C.G, C.bid, K);
    pg8::gemm_phase<Epi, pg8::StaticOrder, true, true>(C.lds, g, S, E);
}

constexpr int RP_TILE = 0, RP_SH = 61440, RP_LIN = 76800, RP_LINS = 264, RP_CST = 86016;
__device__ __forceinline__ void phase_rwkv_prep(Ctx& C, int i) {
    PHASE_IDS
    LAS bf16* TILE = (LAS bf16*)(C.lds + RP_TILE); LAS float* SH = (LAS float*)(C.lds + RP_SH); LAS bf16* LIN = (LAS bf16*)(C.lds + RP_LIN);
    const bf16* PR = (const bf16*)(C.ws + WS_PROJ);
    bf16* RU = (bf16*)(C.ws + WS_RU); bf16* RA = (bf16*)(C.ws + WS_RA); bf16* RB = (bf16*)(C.ws + WS_RB); bf16* RK = (bf16*)(C.ws + WS_RK);
    bf16* RWR = (bf16*)(C.ws + WS_RWR); bf16* RV = (bf16*)(C.ws + WS_RV); bf16* RG = (bf16*)(C.ws + WS_RG); float* RSC = (float*)(C.ws + WS_RSC);
    const bf16* W2T = (const bf16*)(C.ws + WS_W2T); const bf16* A2T = (const bf16*)(C.ws + WS_A2T); const bf16* G2T = (const bf16*)(C.ws + WS_G2T);
    const float* mu = C.in[13] + (size_t)i * RPROJ; const float* w0 = C.in[14] + i * RW; const float* a0 = C.in[16] + i * RW;
    const float* k_k = C.in[19] + i * RW; const float* k_a = C.in[20] + i * RW; const float* r_k = C.in[21] + i * RW;
    const int fr = lane & 15, fq = lane >> 4, h = wave;
    LAS float* CST = (LAS float*)(C.lds + RP_CST);
    { const int c = tid; CST[c] = mu[c]; CST[512 + c] = mu[512 + c]; CST[1024 + c] = mu[1024 + c]; CST[1536 + c] = w0[c]; CST[2048 + c] = a0[c]; CST[2560 + c] = k_k[c]; CST[3072 + c] = k_a[c]; CST[3584 + c] = r_k[c]; }
    const int lcol = tid & 255, ltg = tid >> 8; const float mul_ = mu[1536 + lcol];
    for (int tile = C.bid; tile < M / 16; tile += C.G) {
        const int m0 = tile * 16; const bool prompt = m0 < MP; const int sb = (m0 - MP) >> 3;
        const bool pfirst = prompt && ((m0 & (TP - 1)) == 0);
#pragma unroll
        for (int q = 0; q < 8; ++q) { const int id = tid + 512 * q;
            if (id < 17 * 224) { const int r = id / 224, ch = id - r * 224; v4u v = {0u, 0u, 0u, 0u};
                if (r > 0 || (prompt && !pfirst)) v = *(const v4u*)(PR + (size_t)(m0 - 1 + r) * RPROJ + ch * 8);
                *(LAS v4u*)(TILE + r * RPROJ + ch * 8) = v; } }
        if (!prompt) { const float* sh = C.in[3] + ((size_t)i * SB + sb) * RPROJ;
#pragma unroll
            for (int q = 0; q < 7; ++q) SH[tid + 512 * q] = sh[tid + 512 * q]; }
        __syncthreads();
        bf16x8 Bw[4][2], Ba[4][2];
#pragma unroll
        for (int nt = 0; nt < 4; ++nt) { const int n = h * 64 + fr * 4 + nt;
#pragma unroll
            for (int ks = 0; ks < 2; ++ks) { Bw[nt][ks] = *(const bf16x8*)(W2T + n * 64 + ks * 32 + fq * 8); Ba[nt][ks] = *(const bf16x8*)(A2T + n * 64 + ks * 32 + fq * 8); } }
#pragma unroll
        for (int t8 = 0; t8 < 8; ++t8) { const int t = ltg * 8 + t8;
            const float p = bf2f(TILE[(t + 1) * RPROJ + 1536 + lcol]);
            const float pv = (!prompt && t8 == 0) ? SH[ltg * RPROJ + 1536 + lcol] : bf2f(TILE[t * RPROJ + 1536 + lcol]);
            const float xs = p + mul_ * (pv - p);
            LIN[t * RP_LINS + lcol] = (bf16)f2bf((lcol < 64) ? tanhf_(xs) : ((lcol < 128) ? xs : sigmoidf_(xs))); }
        __syncthreads();
        pg8::f32x4 aw[4], aa[4], ag[4];
        {
            bf16x8 ax[4];
#pragma unroll
            for (int ks = 0; ks < 4; ++ks) ax[ks] = *(const LAS bf16x8*)(LIN + fr * RP_LINS + ks * 32 + fq * 8);
#pragma unroll
            for (int nt = 0; nt < 4; ++nt) {
                pg8::f32x4 z = {0.f, 0.f, 0.f, 0.f};
                aw[nt] = __builtin_amdgcn_mfma_f32_16x16x32_bf16(ax[0], Bw[nt][0], z, 0, 0, 0); aw[nt] = __builtin_amdgcn_mfma_f32_16x16x32_bf16(ax[1], Bw[nt][1], aw[nt], 0, 0, 0);
                aa[nt] = __builtin_amdgcn_mfma_f32_16x16x32_bf16(ax[2], Ba[nt][0], z, 0, 0, 0); aa[nt] = __builtin_amdgcn_mfma_f32_16x16x32_bf16(ax[3], Ba[nt][1], aa[nt], 0, 0, 0);
            }
        }
        asm volatile("" ::: "memory");
        {
            bf16x8 ax[4];
#pragma unroll
            for (int ks = 0; ks < 4; ++ks) ax[ks] = *(const LAS bf16x8*)(LIN + fr * RP_LINS + 128 + ks * 32 + fq * 8);
#pragma unroll
            for (int nt = 0; nt < 4; ++nt) { const int n = h * 64 + fr * 4 + nt;
                bf16x8 Bg[4];
#pragma unroll
                for (int ks = 0; ks < 4; ++ks) Bg[ks] = *(const bf16x8*)(G2T + n * 128 + ks * 32 + fq * 8);
                pg8::f32x4 z = {0.f, 0.f, 0.f, 0.f};
                ag[nt] = __builtin_amdgcn_mfma_f32_16x16x32_bf16(ax[0], Bg[0], z, 0, 0, 0);
#pragma unroll
                for (int ks = 1; ks < 4; ++ks) ag[nt] = __builtin_amdgcn_mfma_f32_16x16x32_bf16(ax[ks], Bg[ks], ag[nt], 0, 0, 0);
            }
        }
        asm volatile("" ::: "memory");
        const int c0 = h * 64 + fr * 4;
#define LD4(dst, p) do { const v2u w_ = *(const LAS v2u*)(p); dst[0] = bflo(w_.x); dst[1] = bfhi(w_.x); dst[2] = bflo(w_.y); dst[3] = bfhi(w_.y); } while (0)
#define LDF4(dst, p) do { const f32x4 w_ = *(const LAS f32x4*)(p); dst[0] = w_.x; dst[1] = w_.y; dst[2] = w_.z; dst[3] = w_.w; } while (0)
#pragma unroll
        for (int j = 0; j < 4; ++j) {
            const int tk = fq * 4 + j; const size_t m = (size_t)(m0 + tk);
            const bool sfirst = !prompt && ((tk & 7) == 0);
            float r4[4], k4[4], v4[4], pr[4], pk[4], pv[4], cm[4];
            LD4(r4, TILE + (tk + 1) * RPROJ + c0); LD4(k4, TILE + (tk + 1) * RPROJ + 512 + c0); LD4(v4, TILE + (tk + 1) * RPROJ + 1024 + c0);
            if (sfirst) { LDF4(pr, SH + (tk >> 3) * RPROJ + c0); LDF4(pk, SH + (tk >> 3) * RPROJ + 512 + c0); LDF4(pv, SH + (tk >> 3) * RPROJ + 1024 + c0); }
            else { LD4(pr, TILE + tk * RPROJ + c0); LD4(pk, TILE + tk * RPROJ + 512 + c0); LD4(pv, TILE + tk * RPROJ + 1024 + c0); }
            float xr[4], xk[4], xv[4], av[4], k2[4], krw[4]; float ssq = 0.f;
            LDF4(cm, CST + c0);
#pragma unroll
            for (int nt = 0; nt < 4; ++nt) xr[nt] = r4[nt] + cm[nt] * (pr[nt] - r4[nt]);
            LDF4(cm, CST + 512 + c0);
#pragma unroll
            for (int nt = 0; nt < 4; ++nt) xk[nt] = k4[nt] + cm[nt] * (pk[nt] - k4[nt]);
            LDF4(cm, CST + 1024 + c0);
#pragma unroll
            for (int nt = 0; nt < 4; ++nt) xv[nt] = v4[nt] + cm[nt] * (pv[nt] - v4[nt]);
            LDF4(cm, CST + 2560 + c0);
#pragma unroll
            for (int nt = 0; nt < 4; ++nt) { krw[nt] = xk[nt] * cm[nt]; ssq += krw[nt] * krw[nt]; }
            LDF4(cm, CST + 2048 + c0);
#pragma unroll
            for (int nt = 0; nt < 4; ++nt) av[nt] = sigmoidf_(cm[nt] + aa[nt][j]);
            LDF4(cm, CST + 3072 + c0);
#pragma unroll
            for (int nt = 0; nt < 4; ++nt) k2[nt] = xk[nt] * (1.0f + (av[nt] - 1.0f) * cm[nt]);
            ssq = allsum16(ssq);
            const float rn = rsqrtf(ssq + 1e-6f);
            float br = 0.f, kr = 0.f, rk = 0.f, w0v[4], rkv[4];
            LDF4(w0v, CST + 1536 + c0); LDF4(rkv, CST + 3584 + c0);
            float ou[4], oa[4], ob[4], ok[4], ow[4], og[4];
#pragma unroll
            for (int nt = 0; nt < 4; ++nt) {
                const float kk = krw[nt] * rn, bb = kk * av[nt], r = xr[nt];
                const float ew = 0.6065306597126334f * sigmoidf_(w0v[nt] + aw[nt][j]); const float dec = __expf(-ew);
                ob[nt] = bf2f((bf16)f2bf(bb)); ok[nt] = bf2f((bf16)f2bf(k2[nt]));
                br += ob[nt] * r; kr += ok[nt] * r; rk += r * k2[nt] * rkv[nt];
                ou[nt] = 1.0f - dec; oa[nt] = -kk; ow[nt] = dec * r; og[nt] = ag[nt][j]; }
            const size_t o = m * RW + c0;
#define ST4(ARR, f) do { v2u w_; w_.x = pk2(f[0], f[1]); w_.y = pk2(f[2], f[3]); *(v2u*)(ARR + o) = w_; } while (0)
            ST4(RU, ou); ST4(RA, oa); ST4(RB, ob); ST4(RK, ok); ST4(RWR, ow); ST4(RV, xv); ST4(RG, og);
#undef ST4
            br = allsum16(br); kr = allsum16(kr); rk = allsum16(rk);
            if (fr == 0) *(f32x4*)(RSC + (m * 8 + h) * 4) = (f32x4){br, kr, rk, 0.f};
        }
#undef LD4
#undef LDF4
        if (prompt) { if ((m0 & (TP - 1)) == TP - 16) { float* o = C.out + O_SH_P + ((size_t)i * NB + (m0 >> 11)) * RPROJ; for (int cc = tid; cc < RPROJ; cc += NTHR) o[cc] = bf2f(TILE[16 * RPROJ + cc]); } }
        else { float* o = C.out + O_SH_S + ((size_t)i * SB + sb) * RPROJ; for (int cc = tid; cc < 2 * RPROJ; cc += NTHR) { const int s = cc >= RPROJ ? 1 : 0; o[cc] = bf2f(TILE[(8 + 8 * s) * RPROJ + (cc - s * RPROJ)]); } }
        __syncthreads();
    }
}

__device__ __forceinline__ void unpack8(v4u c, float (&f)[8]) { f[0] = bflo(c.x); f[1] = bfhi(c.x); f[2] = bflo(c.y); f[3] = bfhi(c.y); f[4] = bflo(c.z); f[5] = bfhi(c.z); f[6] = bflo(c.w); f[7] = bfhi(c.w); }
__device__ __forceinline__ v4u pack8(const float (&f)[8]) { v4u o; o.x = pk2(f[0], f[1]); o.y = pk2(f[2], f[3]); o.z = pk2(f[4], f[5]); o.w = pk2(f[6], f[7]); return o; }
__device__ __forceinline__ void phase_gdn_prep(Ctx& C, int i) {
    PHASE_IDS
    LAS float* cwl = (LAS float*)C.lds;
    const bf16* PG = (const bf16*)(C.ws + WS_PROJ);
    bf16* GQ = (bf16*)(C.ws + WS_GQ); bf16* GK = (bf16*)(C.ws + WS_GK); bf16* GV = (bf16*)(C.ws + WS_GV); bf16* GZ = (bf16*)(C.ws + WS_GZ);
    float* GSC = (float*)(C.ws + WS_GSC); const float* P8 = (const float*)(C.ws + WS_P8);
    const float* cw = C.in[24] + (size_t)i * 4 * GQKV; const float* A_log = C.in[25] + i * GH; const float* dtb = C.in[26] + i * GH;
    for (int e = tid; e < 4 * GQKV; e += NTHR) cwl[e] = cw[e];
    __syncthreads();
    for (int tile = C.bid; tile < M / 8; tile += C.G) {
        const int m = tile * 8 + wave; const bool prompt = m < MP;
        const int t = prompt ? (m & (TP - 1)) : ((m - MP) & 7); const int b = prompt ? (m >> 11) : ((m - MP) >> 3);
        const bool last = prompt ? (t == TP - 1) : (t == 7);
        const bf16* P = PG + (size_t)m * GPR;
        const float* cs = C.in[5] + ((size_t)i * SB + (prompt ? 0 : b)) * 3 * GQKV;
        float* go = prompt ? C.out + O_GC_P + ((size_t)i * NB + b) * 3 * GQKV : C.out + O_GC_S + ((size_t)i * SB + b) * 3 * GQKV;
        float val[3][8];
#pragma unroll
        for (int blk = 0; blk < 3; ++blk) {
            const int col0 = blk * 512 + lane * 8;
            float xr[4][8];
            unpack8(*(const v4u*)(P + col0), xr[0]);
#pragma unroll
            for (int j = 1; j < 4; ++j) {
                if (t - j >= 0) unpack8(*(const v4u*)(P - (size_t)j * GPR + col0), xr[j]);
                else if (prompt) {
#pragma unroll
                    for (int e = 0; e < 8; ++e) xr[j][e] = 0.f; }
                else { const f32x4 a = *(const f32x4*)(cs + (3 + t - j) * GQKV + col0), c4 = *(const f32x4*)(cs + (3 + t - j) * GQKV + col0 + 4);
                    xr[j][0] = a.x; xr[j][1] = a.y; xr[j][2] = a.z; xr[j][3] = a.w; xr[j][4] = c4.x; xr[j][5] = c4.y; xr[j][6] = c4.z; xr[j][7] = c4.w; }
            }
#pragma unroll
            for (int h4 = 0; h4 < 2; ++h4) {
                const f32x4 w0 = *(const LAS f32x4*)(cwl + col0 + h4 * 4), w1 = *(const LAS f32x4*)(cwl + GQKV + col0 + h4 * 4), w2 = *(const LAS f32x4*)(cwl + 2 * GQKV + col0 + h4 * 4), w3 = *(const LAS f32x4*)(cwl + 3 * GQKV + col0 + h4 * 4);
#pragma unroll
                for (int e = 0; e < 4; ++e) { const int ee = h4 * 4 + e; val[blk][ee] = siluf_(w0[e] * xr[3][ee] + w1[e] * xr[2][ee] + w2[e] * xr[1][ee] + w3[e] * xr[0][ee]); }
            }
            if (last) {
#pragma unroll
                for (int j = 0; j < 3; ++j) { *(f32x4*)(go + j * GQKV + col0) = (f32x4){xr[2 - j][0], xr[2 - j][1], xr[2 - j][2], xr[2 - j][3]}; *(f32x4*)(go + j * GQKV + col0 + 4) = (f32x4){xr[2 - j][4], xr[2 - j][5], xr[2 - j][6], xr[2 - j][7]}; }
            }
        }
        float sq = 0.f, sk = 0.f;
#pragma unroll
        for (int e = 0; e < 8; ++e) { sq += val[0][e] * val[0][e]; sk += val[1][e] * val[1][e]; }
        sq = allsum16(sq); sk = allsum16(sk);
        const float nq = rsqrtf(sq + 1e-6f) * 0.08838834764831845f, nk = rsqrtf(sk + 1e-6f);
        float qh[8], kh[8];
#pragma unroll
        for (int e = 0; e < 8; ++e) { qh[e] = val[0][e] * nq; kh[e] = val[1][e] * nk; }
        const v4u qp = pack8(qh), kp = pack8(kh);
        const size_t o = (size_t)m * GW + lane * 8;
        *(v4u*)(GQ + o) = qp; *(v4u*)(GK + o) = kp; *(v4u*)(GV + o) = pack8(val[2]);
        float qr[8], kr[8]; unpack8(qp, qr); unpack8(kp, kr);
        float qk = 0.f;
#pragma unroll
        for (int e = 0; e < 8; ++e) qk += qr[e] * kr[e];
        qk = allsum16(qk);
        float z[8]; unpack8(*(const v4u*)(P + GQKV + lane * 8), z);
#pragma unroll
        for (int e = 0; e < 8; ++e) z[e] = siluf_(z[e]);
        *(v4u*)(GZ + o) = pack8(z);
        if ((lane & 15) == 0) { const int hh = lane >> 4;
            const float braw = P8[(size_t)m * 8 + hh], araw = P8[(size_t)m * 8 + 4 + hh];
            const float g = fmaxf(-__expf(A_log[hh]) * softplusf_(araw + dtb[hh]), -20.0f);
            *(f32x4*)(GSC + ((size_t)m * 4 + hh) * 4) = (f32x4){__expf(g), sigmoidf_(braw), qk, __expf(-g)}; }
    }
}

__device__ __forceinline__ void bf8_to_lds(LAS float* dst, v4u c) {
    *(LAS f32x4*)dst = (f32x4){bflo(c.x), bfhi(c.x), bflo(c.y), bfhi(c.y)};
    *(LAS f32x4*)(dst + 4) = (f32x4){bflo(c.z), bfhi(c.z), bflo(c.w), bfhi(c.w)};
}

__device__ __forceinline__ f32x2 fma2(f32x2 a, f32x2 b, f32x2 c) { return __builtin_elementwise_fma(a, b, c); }
constexpr int SCAN_UNR = 4;
struct ROps { f32x4 u, a, b, k, w; float v; f32x2 sc; };
__device__ __forceinline__ ROps r_ld(const LAS float* B, int t, int kq, int vidx) {
    ROps o; const LAS float* V = B + t * 320 + kq * 4;
    o.u = *(const LAS f32x4*)V; o.a = *(const LAS f32x4*)(V + 64); o.b = *(const LAS f32x4*)(V + 128); o.k = *(const LAS f32x4*)(V + 192); o.w = *(const LAS f32x4*)(V + 256);
    o.v = B[5120 + t * 16 + vidx]; o.sc = *(const LAS f32x2*)(B + 5376 + t * 2); return o;
}
template <int TB> __device__ __forceinline__ void rwkv_block(f32x4& S, const LAS float* B, int kq, int vidx, float* yo) {
    f32x2 S0 = {S.x, S.y}, S1 = {S.z, S.w}; float ykeep = 0.f;
    ROps c = r_ld(B, 0, kq, vidx);
#pragma unroll 1
    for (int t0 = 0; t0 < TB; t0 += SCAN_UNR)
#pragma unroll
    for (int tt = 0; tt < SCAN_UNR; ++tt) {
        const int t = t0 + tt;
        ROps n = r_ld(B, (t + 1) & 15, kq, vidx);
        const f32x2 a0 = {c.a.x, c.a.y}, a1 = {c.a.z, c.a.w}, w0 = {c.w.x, c.w.y}, w1 = {c.w.z, c.w.w};
        const f32x2 ps = fma2(S1, a1, S0 * a0), py = fma2(S1, w1, S0 * w0);
        const float sa = allsum16(ps.x + ps.y), yp = allsum16(py.x + py.y);
        const f32x2 u0 = {c.u.x, c.u.y}, u1 = {c.u.z, c.u.w}, b0 = {c.b.x, c.b.y}, b1 = {c.b.z, c.b.w}, k0 = {c.k.x, c.k.y}, k1 = {c.k.z, c.k.w};
        const f32x2 sa2 = {sa, sa}, v2 = {c.v, c.v};
        S0 = fma2(-u0, S0, S0); S1 = fma2(-u1, S1, S1);
        S0 = fma2(sa2, b0, S0); S1 = fma2(sa2, b1, S1);
        S0 = fma2(v2, k0, S0); S1 = fma2(v2, k1, S1);
        const float y = yp + sa * c.sc.x + c.v * c.sc.y;
        ykeep = (kq == t) ? y : ykeep;
        c = n;
    }
    if (TB == 16 || kq < TB) yo[(size_t)kq * RW] = ykeep;
    S = (f32x4){S0.x, S0.y, S1.x, S1.y};
}
struct GOps { f32x4 q0, q1, k0, k1; float v; f32x4 sc; };
__device__ __forceinline__ GOps g_ld(const LAS float* B, int t, int kq, int vidx) {
    GOps o; const LAS float* V = B + t * 256 + kq * 8;
    o.q0 = *(const LAS f32x4*)V; o.q1 = *(const LAS f32x4*)(V + 4); o.k0 = *(const LAS f32x4*)(V + 128); o.k1 = *(const LAS f32x4*)(V + 132);
    o.v = B[4096 + t * 16 + vidx]; o.sc = *(const LAS f32x4*)(B + 4352 + t * 4); return o;
}
template <int TB> __device__ __forceinline__ void gdn_block(f32x2 (&S)[4], const LAS float* B, int kq, int vidx, float* oo) {
    float okeep = 0.f;
    GOps c = g_ld(B, 0, kq, vidx);
#pragma unroll 1
    for (int t0 = 0; t0 < TB; t0 += SCAN_UNR)
#pragma unroll
    for (int tt = 0; tt < SCAN_UNR; ++tt) {
        const int t = t0 + tt;
        GOps n = g_ld(B, (t + 1) & 15, kq, vidx);
        const f32x2 k[4] = {{c.k0.x, c.k0.y}, {c.k0.z, c.k0.w}, {c.k1.x, c.k1.y}, {c.k1.z, c.k1.w}}, q[4] = {{c.q0.x, c.q0.y}, {c.q0.z, c.q0.w}, {c.q1.x, c.q1.y}, {c.q1.z, c.q1.w}};
        const f32x2 pk = fma2(S[3], k[3], fma2(S[2], k[2], fma2(S[1], k[1], S[0] * k[0]))), pq = fma2(S[3], q[3], fma2(S[2], q[2], fma2(S[1], q[1], S[0] * q[0])));
        const float kts = allsum16(pk.x + pk.y), qts = allsum16(pq.x + pq.y);
        const float alpha = c.sc.x, beta = c.sc.y, qk = c.sc.z;
        const float coef = beta * (c.v - alpha * kts);
        const f32x2 al2 = {alpha, alpha}, cf2 = {coef, coef};
#pragma unroll
        for (int e = 0; e < 4; ++e) S[e] = fma2(al2, S[e], k[e] * cf2);
        const float o = alpha * qts + qk * coef;
        okeep = (kq == t) ? o : okeep;
        c = n;
    }
    if (TB == 16 || kq < TB) oo[(size_t)kq * GW] = okeep;
}
__device__ __forceinline__ float sum8(float x) { x += dppf<0x141>(x); x += dppf<0x4E>(x); x += dppf<0xB1>(x); return x; }
struct ROps8 { f32x4 u[2], a[2], b[2], k[2], w[2]; float v; f32x2 sc; };
__device__ __forceinline__ ROps8 r_ld8(const LAS float* B, int t, int kq, int vidx) {
    ROps8 o; const LAS float* V = B + t * 320 + kq * 8;
#pragma unroll
    for (int h = 0; h < 2; ++h) { o.u[h] = *(const LAS f32x4*)(V + 4 * h); o.a[h] = *(const LAS f32x4*)(V + 64 + 4 * h); o.b[h] = *(const LAS f32x4*)(V + 128 + 4 * h); o.k[h] = *(const LAS f32x4*)(V + 192 + 4 * h); o.w[h] = *(const LAS f32x4*)(V + 256 + 4 * h); }
    o.v = B[5120 + t * 16 + vidx]; o.sc = *(const LAS f32x2*)(B + 5376 + t * 2); return o;
}
#define PAIRS(V_) {{V_[0].x, V_[0].y}, {V_[0].z, V_[0].w}, {V_[1].x, V_[1].y}, {V_[1].z, V_[1].w}}
template <int TB> __device__ __forceinline__ void rwkv_block8(f32x2 (&S)[4], const LAS float* B, int kq, int vidx, float* yo) {
    float ykA = 0.f, ykB = 0.f;
    ROps8 c = r_ld8(B, 0, kq, vidx);
#pragma unroll 1
    for (int t0 = 0; t0 < TB; t0 += SCAN_UNR)
#pragma unroll
    for (int tt = 0; tt < SCAN_UNR; ++tt) {
        const int t = t0 + tt;
        const ROps8 n = r_ld8(B, (t + 1) & 15, kq, vidx);
        const f32x2 a[4] = PAIRS(c.a), w[4] = PAIRS(c.w), u[4] = PAIRS(c.u), b[4] = PAIRS(c.b), k[4] = PAIRS(c.k);
        const f32x2 ps = fma2(S[3], a[3], fma2(S[2], a[2], fma2(S[1], a[1], S[0] * a[0]))), py = fma2(S[3], w[3], fma2(S[2], w[2], fma2(S[1], w[1], S[0] * w[0])));
        const float sa = sum8(ps.x + ps.y), yp = sum8(py.x + py.y);
        const f32x2 sa2 = {sa, sa}, v2 = {c.v, c.v};
#pragma unroll
        for (int e = 0; e < 4; ++e) { S[e] = fma2(-u[e], S[e], S[e]); S[e] = fma2(sa2, b[e], S[e]); S[e] = fma2(v2, k[e], S[e]); }
        const float y = yp + sa * c.sc.x + c.v * c.sc.y;
        ykA = (kq == t) ? y : ykA; ykB = (kq + 8 == t) ? y : ykB;
        c = n;
    }
    yo[(size_t)kq * RW] = ykA;
    if (TB == 16) yo[(size_t)(kq + 8) * RW] = ykB;
}
struct GOps8 { f32x4 q[4], k[4]; float v; f32x4 sc; };
__device__ __forceinline__ GOps8 g_ld8(const LAS float* B, int t, int kq, int vidx) {
    GOps8 o; const LAS float* V = B + t * 256 + kq * 16;
#pragma unroll
    for (int h = 0; h < 4; ++h) { o.q[h] = *(const LAS f32x4*)(V + 4 * h); o.k[h] = *(const LAS f32x4*)(V + 128 + 4 * h); }
    o.v = B[4096 + t * 16 + vidx]; o.sc = *(const LAS f32x4*)(B + 4352 + t * 4); return o;
}
#define PAIRS8(V_) {{V_[0].x, V_[0].y}, {V_[0].z, V_[0].w}, {V_[1].x, V_[1].y}, {V_[1].z, V_[1].w}, {V_[2].x, V_[2].y}, {V_[2].z, V_[2].w}, {V_[3].x, V_[3].y}, {V_[3].z, V_[3].w}}
template <int TB> __device__ __forceinline__ void gdn_block8(f32x2 (&S)[8], const LAS float* B, int kq, int vidx, float* oo) {
    float okA = 0.f, okB = 0.f;
    GOps8 c = g_ld8(B, 0, kq, vidx);
#pragma unroll 1
    for (int t0 = 0; t0 < TB; t0 += SCAN_UNR) {
        float P = 1.f, iP = 1.f;
#pragma unroll
        for (int tt = 0; tt < SCAN_UNR; ++tt) {
            const int t = t0 + tt;
            const GOps8 n = g_ld8(B, (t + 1) & 15, kq, vidx);
            const f32x2 k[8] = PAIRS8(c.k), q[8] = PAIRS8(c.q);
            f32x2 pk = S[0] * k[0], pq = S[0] * q[0];
#pragma unroll
            for (int e = 1; e < 8; ++e) { pk = fma2(S[e], k[e], pk); pq = fma2(S[e], q[e], pq); }
            const float dk = sum8(pk.x + pk.y), dq = sum8(pq.x + pq.y);
            P *= c.sc.x; iP *= c.sc.w;
            const float coef = c.sc.y * (c.v - P * dk);
            const float cs = coef * iP; const f32x2 cf2 = {cs, cs};
#pragma unroll
            for (int e = 0; e < 8; ++e) S[e] = fma2(k[e], cf2, S[e]);
            const float o = P * dq + c.sc.z * coef;
            okA = (kq == t) ? o : okA; okB = (kq + 8 == t) ? o : okB;
            c = n;
        }
        const f32x2 p2 = {P, P};
#pragma unroll
        for (int e = 0; e < 8; ++e) S[e] = S[e] * p2;
    }
    oo[(size_t)kq * GW] = okA;
    if (TB == 16) oo[(size_t)(kq + 8) * GW] = okB;
}
constexpr int SC_NBLK = 128 + 16;
constexpr int RBUF = 16 * 5 * 64 + 16 * 16 + 16 * 2;
constexpr int GBUF = 16 * 2 * 128 + 16 * 16 + 16 * 4;
__device__ __forceinline__ void phase_scan(Ctx& C, int i) {
    PHASE_IDS
    const int w = wave & 1; const bool cw = (wave < 2) || (wave >= 6);
    int sub = lane >> 3, kq = lane & 7, ht = tid & 255;
#define RELAUNDER do { int tl_ = tid; asm volatile("" : "+v"(tl_)); ht = tl_ & 255; sub = (tl_ & 63) >> 3; kq = tl_ & 7; } while (0)
    LAS float* const ldsf = (LAS float*)C.lds;
    if (wave < 4) {
        LAS float* const buf0 = ldsf;
        const unsigned char* SCN = C.ws + WS_SCN; const bf16* RV = (const bf16*)(C.ws + WS_RV); const float* RSC = (const float*)(C.ws + WS_RSC);
        float* YRAW = (float*)(C.ws + WS_YRAW);
        v4u st[5]; v4u stv; f32x2 sts; f32x4 Snext = {0.f, 0.f, 0.f, 0.f}, Snext1 = {0.f, 0.f, 0.f, 0.f};
#define R_DESC(blk, m0, tb, head, quarter, b, isprompt) \
        size_t m0; int tb, head, quarter, b; bool isprompt; \
        if ((blk) < 128) { isprompt = true; const int seq = C.bid >> 5; b = seq; head = (C.bid >> 2) & 7; quarter = C.bid & 3; m0 = (size_t)seq * TP + (size_t)(blk) * 16; tb = 16; } \
        else { isprompt = false; const int su = C.bid * 16 + ((blk) - 128); b = su >> 5; head = (su >> 2) & 7; quarter = su & 3; m0 = (size_t)MP + (size_t)b * TS; tb = 8; }
#define R_STAGE_LOAD(blk) do { R_DESC(blk, m0_, tb_, head_, quarter_, b_, ip_) \
        if (!cw) { const int hx = ht & 127; \
        _Pragma("unroll") for (int q = 0; q < 5; ++q) { const int id = hx + 128 * q; const int tok = id / 40, rem = id - tok * 40, vec = rem >> 3, part = rem & 7; \
            if (tok < tb_) st[q] = *(const v4u*)(SCN + (size_t)vec * A17 + ((m0_ + tok) * RW + head_ * 64 + part * 8) * 2); } \
        if (hx < 32) { const int tok = hx >> 1; if (tok < tb_) stv = *(const v4u*)(RV + (m0_ + tok) * RW + head_ * 64 + quarter_ * 16 + (hx & 1) * 8); } \
        else if (hx < 48) { const int tok = hx - 32; if (tok < tb_) sts = *(const f32x2*)(RSC + ((m0_ + tok) * 8 + head_) * 4); } } \
        if (!ip_ && cw) { const float* s0_ = C.in[2] + ((size_t)(i * SB + b_) * RH + head_) * 4096 + (quarter_ * 16 + w * 8 + sub) * 64 + kq * 8; Snext = *(const f32x4*)s0_; Snext1 = *(const f32x4*)(s0_ + 4); } else { Snext = (f32x4){0.f, 0.f, 0.f, 0.f}; Snext1 = Snext; } } while (0)
#define R_STAGE_WRITE(blk) do { LAS float* B = buf0 + ((blk) & 1) * RBUF; \
        if (!cw) { const int hx = ht & 127; \
        _Pragma("unroll") for (int q = 0; q < 5; ++q) { const int id = hx + 128 * q; const int tok = id / 40, rem = id - tok * 40, vec = rem >> 3, part = rem & 7; \
            bf8_to_lds(B + (tok * 5 + vec) * 64 + part * 8, st[q]); } \
        if (hx < 32) bf8_to_lds(B + 5120 + (hx >> 1) * 16 + (hx & 1) * 8, stv); \
        else if (hx < 48) *(LAS f32x2*)(B + 5376 + (hx - 32) * 2) = sts; } } while (0)
        R_STAGE_LOAD(0);
        f32x2 S[4] = {{Snext.x, Snext.y}, {Snext.z, Snext.w}, {Snext1.x, Snext1.y}, {Snext1.z, Snext1.w}};
        R_STAGE_WRITE(0);
        __syncthreads();
#pragma unroll 1
        for (int blk = 0; blk < SC_NBLK; ++blk) {
            RELAUNDER;
            R_DESC(blk, m0, tb, head, quarter, b, isprompt)
            const bool last = isprompt ? (blk == 127) : true;
            if (blk + 1 < SC_NBLK) R_STAGE_LOAD(blk + 1);
            const LAS float* B = buf0 + (blk & 1) * RBUF;
            const int row = quarter * 16 + w * 8 + sub;
            float* yo = YRAW + m0 * RW + head * 64 + row;
            if (cw) {
            if (tb == 16) rwkv_block8<16>(S, B, kq, w * 8 + sub, yo); else rwkv_block8<8>(S, B, kq, w * 8 + sub, yo);
            if (last) {
                float* So = (isprompt ? C.out + O_RWKV_P + ((size_t)(i * NB + b) * RH + head) * 4096 : C.out + O_RWKV_S + ((size_t)(i * SB + b) * RH + head) * 4096);
                *(f32x4*)(So + row * 64 + kq * 8) = (f32x4){S[0].x, S[0].y, S[1].x, S[1].y}; *(f32x4*)(So + row * 64 + kq * 8 + 4) = (f32x4){S[2].x, S[2].y, S[3].x, S[3].y};
                S[0] = (f32x2){Snext.x, Snext.y}; S[1] = (f32x2){Snext.z, Snext.w}; S[2] = (f32x2){Snext1.x, Snext1.y}; S[3] = (f32x2){Snext1.z, Snext1.w};
            }
            }
            if (blk + 1 < SC_NBLK) R_STAGE_WRITE(blk + 1);
            __syncthreads();
        }
#undef R_DESC
#undef R_STAGE_LOAD
#undef R_STAGE_WRITE
    } else {
        LAS float* const buf0 = ldsf + 2 * RBUF;
        const bf16* GQ = (const bf16*)(C.ws + WS_GQ); const bf16* GV = (const bf16*)(C.ws + WS_GV); const float* GSC = (const float*)(C.ws + WS_GSC);
        float* ORAW = (float*)(C.ws + WS_ORAW);
        v4u st[4]; v4u stv; f32x4 sts; float Snext[16];
#pragma unroll
        for (int e = 0; e < 16; ++e) Snext[e] = 0.f;
#define G_DESC(blk, m0, tb, head, cgp, b, isprompt) \
        size_t m0; int tb, head, cgp, b; bool isprompt; \
        if ((blk) < 128) { isprompt = true; const int seq = C.bid >> 5; b = seq; head = (C.bid >> 3) & 3; cgp = C.bid & 7; m0 = (size_t)seq * TP + (size_t)(blk) * 16; tb = 16; } \
        else { isprompt = false; const int su = C.bid * 16 + ((blk) - 128); b = su >> 5; head = (su >> 3) & 3; cgp = su & 7; m0 = (size_t)MP + (size_t)b * TS; tb = 8; }
#define G_STAGE_LOAD(blk) do { G_DESC(blk, m0_, tb_, head_, cgp_, b_, ip_) \
        if (!cw) { const int hx = ht & 127; \
        _Pragma("unroll") for (int q = 0; q < 4; ++q) { const int id = hx + 128 * q; const int tok = id >> 5, vec = (id >> 4) & 1, part = id & 15; \
            if (tok < tb_) st[q] = *(const v4u*)(GQ + (size_t)vec * (A17 / 2) + (m0_ + tok) * GW + head_ * 128 + part * 8); } \
        if (hx < 32) { const int tok = hx >> 1; if (tok < tb_) stv = *(const v4u*)(GV + (m0_ + tok) * GW + head_ * 128 + cgp_ * 16 + (hx & 1) * 8); } \
        else if (hx < 48) { const int tok = hx - 32; if (tok < tb_) sts = *(const f32x4*)(GSC + ((m0_ + tok) * 4 + head_) * 4); } } \
        if (!ip_ && cw) { const float* S0 = C.in[4] + ((size_t)(i * SB + b_) * GH + head_) * 16384 + cgp_ * 16 + w * 8 + sub; \
            _Pragma("unroll") for (int e = 0; e < 16; ++e) Snext[e] = S0[(size_t)(kq * 16 + e) * 128]; } \
        else { _Pragma("unroll") for (int e = 0; e < 16; ++e) Snext[e] = 0.f; } } while (0)
#define G_STAGE_WRITE(blk) do { LAS float* B = buf0 + ((blk) & 1) * GBUF; \
        if (!cw) { const int hx = ht & 127; \
        _Pragma("unroll") for (int q = 0; q < 4; ++q) { const int id = hx + 128 * q; const int tok = id >> 5, vec = (id >> 4) & 1, part = id & 15; \
            bf8_to_lds(B + (tok * 2 + vec) * 128 + part * 8, st[q]); } \
        if (hx < 32) bf8_to_lds(B + 4096 + (hx >> 1) * 16 + (hx & 1) * 8, stv); \
        else if (hx < 48) *(LAS f32x4*)(B + 4352 + (hx - 32) * 4) = sts; } } while (0)
        G_STAGE_LOAD(0);
        f32x2 S[8];
#pragma unroll
        for (int e = 0; e < 8; ++e) S[e] = (f32x2){Snext[2 * e], Snext[2 * e + 1]};
        G_STAGE_WRITE(0);
        __syncthreads();
#pragma unroll 1
        for (int blk = 0; blk < SC_NBLK; ++blk) {
            RELAUNDER;
            G_DESC(blk, m0, tb, head, cgp, b, isprompt)
            const bool last = isprompt ? (blk == 127) : true;
            if (blk + 1 < SC_NBLK) G_STAGE_LOAD(blk + 1);
            const LAS float* B = buf0 + (blk & 1) * GBUF;
            const int col = cgp * 16 + w * 8 + sub;
            float* oo = ORAW + m0 * GW + head * 128 + col;
            if (cw) {
            if (tb == 16) gdn_block8<16>(S, B, kq, w * 8 + sub, oo); else gdn_block8<8>(S, B, kq, w * 8 + sub, oo);
            if (last) {
                float* So = (isprompt ? C.out + O_GDN_P + ((size_t)(i * NB + b) * GH + head) * 16384 : C.out + O_GDN_S + ((size_t)(i * SB + b) * GH + head) * 16384) + col;
#pragma unroll
                for (int e = 0; e < 8; ++e) { So[(size_t)(kq * 16 + 2 * e) * 128] = S[e].x; So[(size_t)(kq * 16 + 2 * e + 1) * 128] = S[e].y; S[e] = (f32x2){Snext[2 * e], Snext[2 * e + 1]}; }
            }
            }
            if (blk + 1 < SC_NBLK) G_STAGE_WRITE(blk + 1);
            __syncthreads();
        }
#undef G_DESC
#undef G_STAGE_LOAD
#undef G_STAGE_WRITE
    }
}

__device__ __forceinline__ void phase_post(Ctx& C, int i) {
    PHASE_IDS
    const int gw = C.bid * NWAVES + wave, NGW = C.G * NWAVES;
    const float* YRAW = (const float*)(C.ws + WS_YRAW); const float* ORAW = (const float*)(C.ws + WS_ORAW);
    const bf16* RV = (const bf16*)(C.ws + WS_RV); const bf16* RG = (const bf16*)(C.ws + WS_RG); const float* RSC = (const float*)(C.ws + WS_RSC); const bf16* GZ = (const bf16*)(C.ws + WS_GZ);
    bf16* YM = (bf16*)(C.ws + WS_XN);
    const float* lnwp = C.in[22] + i * RW + lane * 8; const float* lnbp = C.in[23] + i * RW + lane * 8; const float* gnwp = C.in[27] + i * GHD + (lane & 15) * 8;
    float lnw[8], lnb[8], gnw[8];
#pragma unroll
    for (int e = 0; e < 8; ++e) { lnw[e] = lnwp[e]; lnb[e] = lnbp[e]; gnw[e] = gnwp[e]; }
    for (int m = gw; m < M; m += NGW) {
        const size_t mm = (size_t)m;
        const f32x4 y0 = *(const f32x4*)(YRAW + mm * RW + lane * 8), y1 = *(const f32x4*)(YRAW + mm * RW + lane * 8 + 4);
        const f32x4 o0 = *(const f32x4*)(ORAW + mm * GW + lane * 8), o1 = *(const f32x4*)(ORAW + mm * GW + lane * 8 + 4);
        const v4u vv = *(const v4u*)(RV + mm * RW + lane * 8), gg = *(const v4u*)(RG + mm * RW + lane * 8), zz = *(const v4u*)(GZ + mm * GW + lane * 8);
        const float rk = RSC[(mm * 8 + (lane >> 3)) * 4 + 2];
        float y[8] = {y0.x, y0.y, y0.z, y0.w, y1.x, y1.y, y1.z, y1.w}, v[8], g[8], o[8];
        unpack8(vv, v); unpack8(gg, g);
        float s = ((y[0] + y[1]) + (y[2] + y[3])) + ((y[4] + y[5]) + (y[6] + y[7]));
        const float mean = sum8(s) * (1.f / 64.f); float q = 0.f;
#pragma unroll
        for (int e = 0; e < 8; ++e) { y[e] -= mean; q += y[e] * y[e]; }
        const float rstd = rsqrtf(sum8(q) * (1.f / 64.f) + 64e-5f);
#pragma unroll
        for (int e = 0; e < 8; ++e) o[e] = (y[e] * rstd * lnw[e] + lnb[e] + rk * v[e]) * g[e];
        *(v4u*)(YM + mm * D + lane * 8) = pack8(o);
        float z[8]; unpack8(zz, z);
        float x[8] = {o0.x, o0.y, o0.z, o0.w, o1.x, o1.y, o1.z, o1.w}; float q2 = 0.f;
#pragma unroll
        for (int e = 0; e < 8; ++e) q2 += x[e] * x[e];
        const float rs = rsqrtf(allsum16(q2) * (1.f / 128.f) + 1e-6f);
#pragma unroll
        for (int e = 0; e < 8; ++e) o[e] = x[e] * rs * gnw[e] * z[e];
        *(v4u*)(YM + mm * D + 512 + lane * 8) = pack8(o);
    }
}

constexpr int XS = 1032;
__device__ __forceinline__ void phase_lru_prep(Ctx& C, int i) {
    PHASE_IDS
    LAS bf16* xc = (LAS bf16*)C.lds;
    const bf16* PO = (const bf16*)(C.ws + WS_PROJ);
    bf16* LP = (bf16*)(C.ws + WS_LP); bf16* LH = (bf16*)(C.ws + WS_LH); float* LT = (float*)(C.ws + WS_LTOT);
    const bf16* WA = (const bf16*)(C.ws + WS_WA) + wave * 16384; const bf16* WI = (const bf16*)(C.ws + WS_WI) + wave * 16384;
    const float* cw = C.in[30] + (size_t)i * 4 * D; const float* cb = C.in[31] + i * D;
    const float* ba = C.in[33] + i * D; const float* bi = C.in[35] + i * D; const float* Lp = C.in[36] + i * D;
    const int fr = lane & 15, fq = lane >> 4, h = wave;
    LAS float* CSTL = (LAS float*)(C.lds + 67584);
    for (int c = tid; c < D; c += NTHR) { CSTL[c] = ba[c]; CSTL[D + c] = bi[c]; CSTL[2 * D + c] = softplusf_(-Lp[c]); }
    for (int tile = C.bid; tile < M / 32; tile += C.G) {
        const int m0 = tile * 32; const bool prompt = m0 < MP;
        const bf16* P = PO + (size_t)m0 * 2048;
        bf16x8 Bc[4][2];
#pragma unroll
        for (int ks = 0; ks < 4; ++ks) { Bc[ks][0] = *(const bf16x8*)(WA + fr * 128 + ks * 32 + fq * 8); Bc[ks][1] = *(const bf16x8*)(WI + fr * 128 + ks * 32 + fq * 8); }
        {
            const int rg = tid >> 7;
            const bool seqstart = prompt ? (((m0 & (TP - 1)) == 0) && rg == 0) : true;
#pragma unroll 1
            for (int hh = 0; hh < 2; ++hh) {
                const int c0 = (tid & 127) * 8 + hh * 4;
                float xr[11][4];
#pragma unroll
                for (int r = 0; r < 11; ++r) { const int tr = rg * 8 - 3 + r;
                    if (r >= 3 || !seqstart) { const v2u w = *(const v2u*)(P + (ptrdiff_t)tr * 2048 + 1024 + c0); xr[r][0] = bflo(w.x); xr[r][1] = bfhi(w.x); xr[r][2] = bflo(w.y); xr[r][3] = bfhi(w.y); }
                    else if (prompt) { xr[r][0] = 0.f; xr[r][1] = 0.f; xr[r][2] = 0.f; xr[r][3] = 0.f; }
                    else { const f32x4 a = *(const f32x4*)(C.in[7] + ((size_t)i * SB + ((m0 - MP) >> 3) + rg) * 3 * D + r * D + c0); xr[r][0] = a.x; xr[r][1] = a.y; xr[r][2] = a.z; xr[r][3] = a.w; } }
                const f32x4 t0 = *(const f32x4*)(cw + c0), t1 = *(const f32x4*)(cw + D + c0), t2 = *(const f32x4*)(cw + 2 * D + c0), t3 = *(const f32x4*)(cw + 3 * D + c0), bs = *(const f32x4*)(cb + c0);
#pragma unroll
                for (int t8 = 0; t8 < 8; ++t8) { float y[4];
#pragma unroll
                    for (int e = 0; e < 4; ++e) y[e] = t0[e] * xr[t8][e] + t1[e] * xr[t8 + 1][e] + t2[e] * xr[t8 + 2][e] + t3[e] * xr[t8 + 3][e] + bs[e];
                    v2u o; o.x = pk2(y[0], y[1]); o.y = pk2(y[2], y[3]);
                    *(LAS v2u*)(xc + (rg * 8 + t8) * XS + c0) = o; }
            }
        }
        __syncthreads();
#pragma unroll
        for (int nt = 0; nt < 8; ++nt) {
            pg8::f32x4 aa[2] = {{0.f, 0.f, 0.f, 0.f}, {0.f, 0.f, 0.f, 0.f}}, ai[2] = {{0.f, 0.f, 0.f, 0.f}, {0.f, 0.f, 0.f, 0.f}};
            bf16x8 Bn[4][2];
            if (nt + 1 < 8) {
#pragma unroll
                for (int ks = 0; ks < 4; ++ks) { Bn[ks][0] = *(const bf16x8*)(WA + ((nt + 1) * 16 + fr) * 128 + ks * 32 + fq * 8); Bn[ks][1] = *(const bf16x8*)(WI + ((nt + 1) * 16 + fr) * 128 + ks * 32 + fq * 8); } }
#pragma unroll
            for (int ks = 0; ks < 4; ++ks) {
                const bf16x8 bfa = Bc[ks][0], bfi = Bc[ks][1];
#pragma unroll
                for (int mt = 0; mt < 2; ++mt) { const bf16x8 af = *(const LAS bf16x8*)(xc + (mt * 16 + fr) * XS + h * 128 + ks * 32 + fq * 8);
                    aa[mt] = __builtin_amdgcn_mfma_f32_16x16x32_bf16(af, bfa, aa[mt], 0, 0, 0); ai[mt] = __builtin_amdgcn_mfma_f32_16x16x32_bf16(af, bfi, ai[mt], 0, 0, 0); }
            }
            const int ch = h * 128 + nt * 16 + fr;
            const float bac = CSTL[ch], bic = CSTL[D + ch], spl = CSTL[2 * D + ch];
            float IA[2][4], IB[2][4], GA[2], GB[2], EA[2], EB[2];
#pragma unroll
            for (int mt = 0; mt < 2; ++mt) {
                float pa = 1.f, pb = 0.f;
#pragma unroll
                for (int j = 0; j < 4; ++j) {
                    const int tok = mt * 16 + fq * 4 + j; const float xv = bf2f(xc[tok * XS + ch]);
                    const float r = sigmoidf_(aa[mt][j] + bac), ig = sigmoidf_(ai[mt][j] + bic);
                    const float la = -8.0f * r * spl; const float A = __expf(la); const float x2 = 2.0f * la;
                    const float om_s = -x2 * (1.0f + x2 * (0.5f + x2 * (0.16666667f + x2 * (0.041666668f + x2 * 0.008333334f))));
                    const float om = (x2 > -0.25f) ? om_s : (1.0f - A * A); const float mult = __builtin_amdgcn_sqrtf(fmaxf(om, 0.f)); const float B = mult * ig * xv;
                    pb = A * pb + B; pa = pa * A; IA[mt][j] = pa; IB[mt][j] = pb;
                }
                float ga = pa, gb = pb;
                { const float qa = __shfl_up(ga, 16), qb = __shfl_up(gb, 16); const bool doit = prompt ? (fq >= 1) : ((fq & 1) != 0); if (doit) { gb = ga * qb + gb; ga = qa * ga; } }
                { const float qa = __shfl_up(ga, 32), qb = __shfl_up(gb, 32); if (prompt && fq >= 2) { gb = ga * qb + gb; ga = qa * ga; } }
                GA[mt] = ga; GB[mt] = gb;
                { const float qa = __shfl_up(ga, 16), qb = __shfl_up(gb, 16); const bool doit = prompt ? (fq >= 1) : ((fq & 1) != 0); EA[mt] = doit ? qa : 1.f; EB[mt] = doit ? qb : 0.f; }
            }
            { const float ta = __shfl(GA[0], fr + 48), tb = __shfl(GB[0], fr + 48); if (prompt) { EB[1] = EA[1] * tb + EB[1]; EA[1] = ta * EA[1]; } }
#pragma unroll
            for (int mt = 0; mt < 2; ++mt)
#pragma unroll
                for (int j = 0; j < 4; ++j) { const size_t m = (size_t)(m0 + mt * 16 + fq * 4 + j);
                    const float Pv = EA[mt] * IA[mt][j], Hv = IA[mt][j] * EB[mt] + IB[mt][j];
                    LP[m * D + ch] = (bf16)f2bf(Pv); LH[m * D + ch] = (bf16)f2bf(Hv);
                    if (mt == 1 && j == 3 && fq == 3) *(f32x2*)(LT + ((size_t)tile * D + ch) * 2) = (f32x2){Pv, Hv}; }
            if (nt + 1 < 8) {
#pragma unroll
                for (int ks = 0; ks < 4; ++ks) { Bc[ks][0] = Bn[ks][0]; Bc[ks][1] = Bn[ks][1]; } }
            asm volatile("" ::: "memory");
        }
        if (prompt) { if ((m0 & (TP - 1)) == TP - 32) { float* o = C.out + O_LC_P + ((size_t)i * NB + (m0 >> 11)) * 3 * D;
                for (int e = tid; e < 3 * D; e += NTHR) { const int j = e >> 10, cc = e & 1023; o[e] = bf2f(P[(29 + j) * 2048 + 1024 + cc]); } } }
        else { for (int e = tid; e < 4 * 3 * D; e += NTHR) { const int s = e / (3 * D), r = e - s * 3 * D, j = r >> 10, cc = r & 1023;
                C.out[O_LC_S + ((size_t)i * SB + ((m0 - MP) >> 3) + s) * 3 * D + r] = bf2f(P[(s * 8 + 5 + j) * 2048 + 1024 + cc]); } }
        __syncthreads();
    }
}

__device__ __forceinline__ float gelu_tanh(float x) { const float u = 0.7978845608028654f * (x + 0.044715f * x * x * x); return 0.5f * x * (1.0f + tanhf_(u)); }

__device__ __forceinline__ void phase_lru_fin(Ctx& C, int i) {
    PHASE_IDS
    LAS float* X = (LAS float*)C.lds;
    const bf16* PO = (const bf16*)(C.ws + WS_PROJ);
    const bf16* LP = (const bf16*)(C.ws + WS_LP); const bf16* LH = (const bf16*)(C.ws + WS_LH); const float* LT = (const float*)(C.ws + WS_LTOT);
    bf16* YM = (bf16*)(C.ws + WS_XN);
    const int rg = tid >> 7, cg = tid & 127, c0 = cg * 8;
    for (int unit = C.bid; unit < M / 16; unit += C.G) {
        const int m0 = unit * 16; const bool prompt = m0 < MP; const int tile = m0 >> 5;
        float carry[8];
        if (prompt) {
            const int tt0 = (m0 >> 11) * 64, n = tile - tt0, per = (n + 3) >> 2; const int lo = tt0 + rg * per; const int hi = (lo + per < tile) ? lo + per : tile;
            float A[8], B[8];
#pragma unroll
            for (int e = 0; e < 8; ++e) { A[e] = 1.f; B[e] = 0.f; }
#pragma unroll 4
            for (int tt = lo; tt < hi; ++tt) { const float* p = LT + ((size_t)tt * D + c0) * 2;
                const f32x4 v0 = *(const f32x4*)p, v1 = *(const f32x4*)(p + 4), v2 = *(const f32x4*)(p + 8), v3 = *(const f32x4*)(p + 12);
                const float P[8] = {v0.x, v0.z, v1.x, v1.z, v2.x, v2.z, v3.x, v3.z}, H[8] = {v0.y, v0.w, v1.y, v1.w, v2.y, v2.w, v3.y, v3.w};
#pragma unroll
                for (int e = 0; e < 8; ++e) { B[e] = P[e] * B[e] + H[e]; A[e] *= P[e]; } }
            LAS float* xp = X + (rg * 128 + cg) * 16;
            *(LAS f32x4*)xp = (f32x4){A[0], A[1], A[2], A[3]}; *(LAS f32x4*)(xp + 4) = (f32x4){A[4], A[5], A[6], A[7]};
            *(LAS f32x4*)(xp + 8) = (f32x4){B[0], B[1], B[2], B[3]}; *(LAS f32x4*)(xp + 12) = (f32x4){B[4], B[5], B[6], B[7]};
            __syncthreads();
#pragma unroll
            for (int e = 0; e < 8; ++e) carry[e] = 0.f;
#pragma unroll
            for (int q = 0; q < 4; ++q) { const LAS float* xq = X + (q * 128 + cg) * 16;
                const f32x4 a0 = *(const LAS f32x4*)xq, a1 = *(const LAS f32x4*)(xq + 4), b0 = *(const LAS f32x4*)(xq + 8), b1 = *(const LAS f32x4*)(xq + 12);
                carry[0] = a0.x * carry[0] + b0.x; carry[1] = a0.y * carry[1] + b0.y; carry[2] = a0.z * carry[2] + b0.z; carry[3] = a0.w * carry[3] + b0.w;
                carry[4] = a1.x * carry[4] + b1.x; carry[5] = a1.y * carry[5] + b1.y; carry[6] = a1.z * carry[6] + b1.z; carry[7] = a1.w * carry[7] + b1.w; }
        } else {
            const float* hp = C.in[6] + ((size_t)i * SB + ((m0 - MP) >> 3) + (rg >> 1)) * D + c0;
            const f32x4 h0 = *(const f32x4*)hp, h1 = *(const f32x4*)(hp + 4);
            carry[0] = h0.x; carry[1] = h0.y; carry[2] = h0.z; carry[3] = h0.w; carry[4] = h1.x; carry[5] = h1.y; carry[6] = h1.z; carry[7] = h1.w;
        }
#pragma unroll
        for (int t4 = 0; t4 < 4; ++t4) {
            const size_t m = (size_t)(m0 + rg * 4 + t4);
            float lh[8], lp[8], gt[8], y[8], hv[8];
            unpack8(*(const v4u*)(LH + m * D + c0), lh); unpack8(*(const v4u*)(LP + m * D + c0), lp); unpack8(*(const v4u*)(PO + m * 2048 + c0), gt);
#pragma unroll
            for (int e = 0; e < 8; ++e) { hv[e] = lh[e] + lp[e] * carry[e]; y[e] = hv[e] * gelu_tanh(gt[e]); }
            *(v4u*)(YM + m * D + c0) = pack8(y);
            const bool lastp = prompt && ((m & (TP - 1)) == TP - 1), lasts = !prompt && (((m - MP) & 7) == 7);
            if (lastp || lasts) { float* o = lastp ? C.out + O_LRU_P + ((size_t)i * NB + (m >> 11)) * D + c0 : C.out + O_LRU_S + ((size_t)i * SB + ((m - MP) >> 3)) * D + c0;
                *(f32x4*)o = (f32x4){hv[0], hv[1], hv[2], hv[3]}; *(f32x4*)(o + 4) = (f32x4){hv[4], hv[5], hv[6], hv[7]}; }
        }
        if (prompt) __syncthreads();
    }
}

__global__ void __launch_bounds__(NTHR, 2) hybrid_fwd(Args args) {
    extern __shared__ __attribute__((aligned(16))) unsigned char lds_raw[];
    cg::grid_group grid = cg::this_grid();
    Ctx C;
    C.lds = (LAS unsigned char*)lds_raw; C.in = args.in; C.out = args.out; C.ws = args.ws;
    C.bid = blockIdx.x; C.G = gridDim.x;
    const int lo = args.ph_lo, hi = args.ph_hi;
    volatile LAS unsigned* MISC = (volatile LAS unsigned*)(C.lds + MISC_OFF);
    if (threadIdx.x < 2) MISC[threadIdx.x] = 0u;
    __syncthreads();
    XcdBarrier xbar = xcd_barrier_post((unsigned*)(C.ws + WS_CTL), MISC);
    if (lo < 0) grid.sync();
#define GRID_BAR() xcd_barrier(xbar)
    int ph = 0;
    for (int es_ = 0; es_ < EXTRA_SYNCS; ++es_) GRID_BAR();
#define PH_BEGIN if (ph >= lo && ph < hi) { const int nrep_ = ((DUPMASK >> ph) & 1ull) ? 2 : 1; for (int rep_ = 0; rep_ < nrep_; ++rep_) { if (rep_) GRID_BAR();
#ifdef NOSYNC
#define PH_END } } ++ph;
#else
#define PH_END   } if (ph + 1 < hi) GRID_BAR(); } ++ph;
#endif
    bf16* XN = (bf16*)(C.ws + WS_XN); bf16* PROJ = (bf16*)(C.ws + WS_PROJ); bf16* HID = (bf16*)(C.ws + WS_HID);
    bf16* WIN = (bf16*)(C.ws + WS_WIN); bf16* WOUT = (bf16*)(C.ws + WS_WOUT); bf16* WUP = (bf16*)(C.ws + WS_WUP); bf16* WDN = (bf16*)(C.ws + WS_WDN);
#pragma unroll 1
    for (int l = 0; l < DEPTH; ++l) {
        const int i = l >> 1; const bool even = (l & 1) == 0;
        PH_BEGIN

#ifndef SKIP_CONV
phase_convert(C, l);
#endif

            __syncthreads();
            if (l == 0) phase_norm<true, true>(C, args.in[8] + l * D, args.in[11] + (size_t)i * D * EPROJ + 3840, EPROJ, 0);
            else if (even) phase_norm<false, true>(C, args.in[8] + l * D, args.in[11] + (size_t)i * D * EPROJ + 3840, EPROJ, 16);
            else phase_norm<false, false>(C, args.in[8] + l * D, nullptr, 0, 16);
            __syncthreads();
        PH_END
        if (even) {

#ifndef SKIP_G1
PH_BEGIN { pg8::Gemm g{XN, WIN, M, 3840, D}; ProjAOrder S; S.init(C.G, C.bid); EpiProjA E{PROJ}; pg8::gemm_phase<EpiProjA, ProjAOrder, true, true>(C.lds, g, S, E); } PH_END
#endif

            PH_BEGIN
#ifndef SKIP_RPREP
phase_rwkv_prep(C, i); __syncthreads();
#endif
 PH_END

#ifndef SKIP_G2
PH_BEGIN { pg8::EpiBf16<0> E{PROJ, GPR, nullptr, 0, 0, 1.f}; pg8::Gemm g{XN, WIN + (size_t)RPROJ * D, MP, GPR, D}; pg8::StaticOrder S; S.init(MP, GPR, C.G, C.bid, D);
              pg8::gemm_phase<pg8::EpiBf16<0>, pg8::StaticOrder, true, true>(C.lds, g, S, E); } PH_END
#endif

            PH_BEGIN
#ifndef SKIP_GPREP
phase_gdn_prep(C, i); __syncthreads();
#endif
 PH_END
            PH_BEGIN
#ifndef SKIP_SCAN
phase_scan(C, i);
#endif
 PH_END
            PH_BEGIN
#ifndef SKIP_POST
phase_post(C, i);
#endif
 PH_END
        } else {

#ifndef SKIP_G3
PH_BEGIN { pg8::EpiBf16<0> E{PROJ, 2048, nullptr, 0, 0, 1.f}; run_gemm(C, XN, WIN, 2048, D, E); } PH_END
#endif

            PH_BEGIN
#ifndef SKIP_LPREP
phase_lru_prep(C, i);
#endif
 PH_END
            PH_BEGIN
#ifndef SKIP_LFIN
phase_lru_fin(C, i);
#endif
 PH_END
        }

#ifndef SKIP_GOUT
PH_BEGIN run_gemm_res(C, XN, WOUT, D, 4, l == 0 ? args.in[0] : nullptr); PH_END
#endif

        PH_BEGIN phase_norm<false, false>(C, args.in[9] + l * D, nullptr, 0, 4); PH_END

#ifndef SKIP_GUP
PH_BEGIN { pg8::EpiBf16<2> E{HID, FF, nullptr, 0, 0, 1.f}; run_gemm(C, XN, WUP, FF, D, E); } PH_END
#endif


#ifndef SKIP_GDN
PH_BEGIN run_gemm_res(C, HID, WDN, FF, 16, nullptr); PH_END
#endif

    }
    PH_BEGIN phase_final(C); PH_END
#undef PH_BEGIN
#undef PH_END
}
constexpr int NPHASES = 2 * (11 + 8) + 1;

#ifndef N_LAUNCH_MODE
#define N_LAUNCH_MODE 1
#endif

extern "C" void kernel_launch(void* const* d_in, const int* in_sizes, int n_in, void* d_out, int out_size, void* d_ws, size_t ws_size, hipStream_t stream) {
    static int grid = 0;
    if (grid == 0) {
        if (n_in != 39 || out_size != (int)O_END || ws_size < WS_TOTAL) { fprintf(stderr, "kernel_launch: unexpected shapes: n_in %d out %d ws %zu (need %zu)\n", n_in, out_size, ws_size, (size_t)WS_TOTAL); grid = -1; return; }
        int dev = 0, cus = 0, per_cu = 0;
        hipGetDevice(&dev); hipDeviceGetAttribute(&cus, hipDeviceAttributeMultiprocessorCount, dev);
        hipFuncSetAttribute((const void*)hybrid_fwd, hipFuncAttributeMaxDynamicSharedMemorySize, LDS_BYTES);
        hipOccupancyMaxActiveBlocksPerMultiprocessor(&per_cu, (const void*)hybrid_fwd, NTHR, LDS_BYTES);
        if (per_cu < 1) { fprintf(stderr, "kernel_launch: occupancy query says %d blocks per CU\n", per_cu); per_cu = 1; }
        (void)hipGetLastError();
        grid = cus;
    }
    if (grid < 0) return;
    if (hipMemsetAsync((char*)d_ws + WS_CTL, 0, CTL_BYTES, stream) != hipSuccess) { fprintf(stderr, "kernel_launch: memset of the barrier words failed\n"); return; }
    Args a{};
    for (int k = 0; k < 39; ++k) a.in[k] = (const float*)d_in[k];
    a.out = (float*)d_out; a.ws = (unsigned char*)d_ws;
#if N_LAUNCH_MODE == 1
    a.ph_lo = 0; a.ph_hi = NPHASES;
    void* kargs[] = {&a};
    hipError_t e = hipLaunchCooperativeKernel((const void*)hybrid_fwd, dim3(grid), dim3(NTHR), kargs, LDS_BYTES, stream);
    if (e != hipSuccess) fprintf(stderr, "cooperative launch failed: %s (grid %d)\n", hipGetErrorString(e), grid);
#else
    for (int p = 0; p < NPHASES; ++p) { a.ph_lo = p; a.ph_hi = p + 1; hipLaunchKernelGGL(hybrid_fwd, dim3(grid), dim3(NTHR), LDS_BYTES, stream, a); }
#endif
}
```

```cpp
#include <hip/hip_runtime.h>
#include <hip/hip_cooperative_groups.h>
#include <cstdio>
#include <cstdint>
namespace cg = cooperative_groups;
#define DUPMASK 0ull
#define EXTRA_SYNCS 0
namespace pg8 {
#define PG8_LAS __attribute__((address_space(3)))
typedef unsigned short bf16_t;
typedef short bf16x8 __attribute__((ext_vector_type(8)));
typedef float f32x4 __attribute__((ext_vector_type(4)));
typedef unsigned u32x4 __attribute__((ext_vector_type(4)));
constexpr int BM = 256, BK = 64, HALF = 128, HTB = HALF * BK * 2  , STAGE_BYTES = 8 * HTB, NXCD = 8, WGM = 8;

__host__ __device__ __forceinline__ int lds_byte(int r, int c) { const int st = (r >> 4) * 2 + (c >> 5), rr = r & 15, cc = c & 31, ob = rr * 64 + cc * 2; return st * 1024 + (ob ^ (((ob >> 9) & 1) << 5)); }
__host__ __device__ __forceinline__ void stage_rc(int b, int& R, int& C) { const int st = b / 1024, sb = b % 1024, swz = sb ^ (((sb >> 9) & 1) << 5); R = (st >> 1) * 16 + swz / 64; C = (st & 1) * 32 + (swz % 64) / 2; }
__host__ __device__ __forceinline__ int perm32(int rho) { const int n = rho >> 4, i = rho & 15; return 8 * (i >> 2) + 4 * n + (i & 3); }

struct Unit { int pm, pn, kofs, nt, atomic; };
struct Gemm { const bf16_t* A; const bf16_t* Bt; int M, N, K; };

struct StaticOrder {
    int nM, nN, nwg, G, c, ntK;
    __host__ __device__ void init(int M, int N, int G_, int c_, int K_) { nM = M / BM; nN = N / BM; nwg = nM * nN; G = G_; c = c_; ntK = K_ / BK; }
    __host__ __device__ bool next(int i, Unit& u) const {
        const long L = (long)i * G + c; if (L >= nwg) return false;
        int wgid = (int)L; { const int q = nwg / NXCD, r = nwg % NXCD, xcd = wgid % NXCD, off = wgid / NXCD; wgid = (xcd < r ? xcd * (q + 1) : r * (q + 1) + (xcd - r) * q) + off; }
        const int nig = WGM * nN, gid = wgid / nig, fm = gid * WGM, gsz = (nM - fm) < WGM ? (nM - fm) : WGM;
        u.pm = fm + ((wgid % nig) % gsz); u.pn = (wgid % nig) / gsz; u.kofs = 0; u.nt = ntK; u.atomic = 0; return true;
    }
    __device__ __forceinline__ void a_ready(const Unit&) const {}
    __device__ __forceinline__ void done(const Unit&) const {}
};

__device__ __forceinline__ unsigned cvt_pk_bf16(float lo, float hi) { unsigned r; asm volatile("v_cvt_pk_bf16_f32 %0, %1, %2" : "=v"(r) : "v"(lo), "v"(hi)); return r; }
typedef float f32x2 __attribute__((ext_vector_type(2)));
__device__ __forceinline__ f32x2 gelu_pk(f32x2 v) {
    const f32x2 av = __builtin_elementwise_abs(v), d = av * 0.2316418882f + 1.0f;
    f32x2 t; t.x = __builtin_amdgcn_rcpf(d.x); t.y = __builtin_amdgcn_rcpf(d.y);
    f32x2 q = t * 0.5307027145f + (-0.7265760135f); q = q * t + 0.7107068705f; q = q * t + (-0.142248368f); q = q * t + 0.127414796f; q = q * t;
    const f32x2 s = (v * v) * (-0.72134752044f);
    f32x2 e; e.x = __builtin_amdgcn_exp2f(s.x); e.y = __builtin_amdgcn_exp2f(s.y);
    const f32x2 m = v * (q * e), r = v - m;
    f32x2 o; o.x = v.x < 0.f ? m.x : r.x; o.y = v.y < 0.f ? m.y : r.y; return o;
}

template <int ACT  > struct EpiBf16 {
    static constexpr bool PERM = true, AFTER_DRAIN = false, HAS_INIT = false; static_assert(ACT == 0 || ACT == 1 || ACT == 2, "EpiBf16: ACT is 0 (none), 1 (gelu_pk) or 2 (squared relu)");
    bf16_t* O; int ldc; const float* bias; int split_cols; size_t split_stride; float scale0;
    __device__ __forceinline__ void operator()(const f32x4 (&acc)[2][2][4][2], const Unit& u, int wr, int wc, int fr, int fq) const {
        const int row0 = u.pm * BM + wr * 64 + fr; int colt = u.pn * BM; bf16_t* base = O;
        float sc = 1.f; if (split_cols) { const int t = colt / split_cols; base += (size_t)t * split_stride; colt -= t * split_cols; if (t == 0) sc = scale0; }
        const int col0 = colt + wc * 32 + 8 * fq, bcol0 = u.pn * BM + wc * 32 + 8 * fq;
        f32x4 bv[2][2];
#pragma unroll
        for (int bj = 0; bj < 2; ++bj)
#pragma unroll
            for (int n = 0; n < 2; ++n) bv[bj][n] = bias ? *(const f32x4*)(bias + bcol0 + bj * HALF + 4 * n) : (f32x4){0.f, 0.f, 0.f, 0.f};
#pragma unroll
        for (int ai = 0; ai < 2; ++ai)
#pragma unroll
            for (int m = 0; m < 4; ++m) { bf16_t* rowp = base + (size_t)(row0 + ai * HALF + m * 16) * ldc + col0;
#pragma unroll
                for (int bj = 0; bj < 2; ++bj) { f32x4 v0 = acc[ai][bj][m][0] + bv[bj][0], v1 = acc[ai][bj][m][1] + bv[bj][1];
                    if (ACT == 1) { f32x2 a = gelu_pk((f32x2){v0[0], v0[1]}), b = gelu_pk((f32x2){v0[2], v0[3]}), c = gelu_pk((f32x2){v1[0], v1[1]}), d = gelu_pk((f32x2){v1[2], v1[3]});
                        v0 = (f32x4){a.x, a.y, b.x, b.y}; v1 = (f32x4){c.x, c.y, d.x, d.y}; }
                    if (ACT == 2) {
#pragma unroll
                        for (int e = 0; e < 4; ++e) { const float p0 = v0[e] > 0.f ? v0[e] : 0.f, p1 = v1[e] > 0.f ? v1[e] : 0.f; v0[e] = p0 * p0; v1[e] = p1 * p1; } }
                    v0 = v0 * sc; v1 = v1 * sc; u32x4 w; w.x = cvt_pk_bf16(v0[0], v0[1]); w.y = cvt_pk_bf16(v0[2], v0[3]); w.z = cvt_pk_bf16(v1[0], v1[1]); w.w = cvt_pk_bf16(v1[2], v1[3]);
                    *(u32x4*)(rowp + bj * HALF) = w; } }
    }
};
template <class Epi, class Sched, bool ALIGN_EPI = false, bool SP2 = false>
__device__ __forceinline__ void gemm_phase(PG8_LAS unsigned char* lds, const Gemm g, const Sched& S, const Epi& E) {
    int tid_ = threadIdx.x; asm volatile("" : "+v"(tid_));
    const int tid = tid_, wid = __builtin_amdgcn_readfirstlane(tid >> 6), lane = tid & 63, wr = wid >> 2, wc = wid & 3, fr = lane & 15, fq = lane >> 4;
    const int K = g.K;
    unsigned voffA[2], voffB[2];
#pragma unroll
    for (int i = 0; i < 2; ++i) { int R, C; stage_rc(tid * 16 + i * 8192, R, C); const int Rb = Epi::PERM ? ((R & ~31) + perm32(R & 31)) : R;
        voffA[i] = (unsigned)(R * K + C) * 2u; voffB[i] = (unsigned)(Rb * K + C) * 2u; }
    const size_t kstep = (size_t)(BK * 2);
    const size_t hstep = (size_t)HALF * K * 2;
    const size_t tstep = 2 * hstep;
    const unsigned ldsw = (unsigned)wid * 1024u;
    const int aoff = lds_byte(wr * 64 + fr, fq * 8), boff = lds_byte(wc * 32 + fr, fq * 8);
#define PG8_SA(b, h) (((b) * 2 + (h)) * HTB)
#define PG8_SB(b, h) ((4 + (b) * 2 + (h)) * HTB)
#define PG8_STAGE(bufoff, gbase, voff) do { _Pragma("unroll") for (int _i = 0; _i < 2; ++_i) \
        __builtin_amdgcn_global_load_lds((const unsigned*)((const char*)(gbase) + (voff)[_i]), (PG8_LAS unsigned*)(lds + (bufoff) + ldsw + _i * 8192), 16, 0, 0); } while (0)
#define PG8_LDA(dst, b, h) do { _Pragma("unroll") for (int m = 0; m < 4; ++m) _Pragma("unroll") for (int k = 0; k < 2; ++k) dst[m][k] = *(const PG8_LAS bf16x8*)(lds + PG8_SA(b, h) + aoff + m * 2048 + k * 1024); } while (0)
#define PG8_LDB(dst, b, h) do { _Pragma("unroll") for (int n = 0; n < 2; ++n) _Pragma("unroll") for (int k = 0; k < 2; ++k) dst[n][k] = *(const PG8_LAS bf16x8*)(lds + PG8_SB(b, h) + boff + n * 2048 + k * 1024); } while (0)
#define PG8_MMA(ai, bj, At, Bt) do { __builtin_amdgcn_s_setprio(1); _Pragma("unroll") for (int m = 0; m < 4; ++m) _Pragma("unroll") for (int n = 0; n < 2; ++n) _Pragma("unroll") for (int k = 0; k < 2; ++k) \
        acc[ai][bj][m][n] = __builtin_amdgcn_mfma_f32_16x16x32_bf16(Bt[n][k], At[m][k], acc[ai][bj][m][n], 0, 0, 0); __builtin_amdgcn_s_setprio(0); } while (0)
#define PG8_WAIT_V(n) asm volatile("s_waitcnt vmcnt(" #n ")" ::: "memory")
#define PG8_WAIT_L(n) asm volatile("s_waitcnt lgkmcnt(" #n ")" ::: "memory")
#define PG8_BAR __builtin_amdgcn_s_barrier()
#define PG8_SCHED __builtin_amdgcn_sched_barrier(0)
    Unit cur, nxt; int ui = 0;
    if (!S.next(0, cur)) return;
    f32x4 acc[2][2][4][2];
    if constexpr (Epi::HAS_INIT) E.init(acc, cur, wr, wc, fr, fq);
    else {
#pragma unroll
    for (int a = 0; a < 2; ++a)
#pragma unroll
        for (int b = 0; b < 2; ++b)
#pragma unroll
            for (int m = 0; m < 4; ++m)
#pragma unroll
                for (int n = 0; n < 2; ++n) acc[a][b][m][n] = (f32x4){0.f, 0.f, 0.f, 0.f};
    }
    bf16x8 At[4][2], B0[2][2], B1[2][2];
    const char* cA = (const char*)g.A + (size_t)cur.pm * tstep + (size_t)cur.kofs * 2; const char* cB = (const char*)g.Bt + (size_t)cur.pn * tstep + (size_t)cur.kofs * 2;
    S.a_ready(cur);
    if constexpr (SP2) {
        PG8_STAGE(PG8_SB(0, 0), cB, voffB); PG8_STAGE(PG8_SB(0, 1), cB + hstep, voffB); PG8_STAGE(PG8_SA(0, 0), cA, voffA); PG8_STAGE(PG8_SA(0, 1), cA + hstep, voffA);
        if (wr == 1) PG8_BAR;
        PG8_WAIT_V(2); PG8_BAR;
        PG8_STAGE(PG8_SB(1, 0), cB + kstep, voffB); PG8_STAGE(PG8_SA(1, 0), cA + kstep, voffA); PG8_STAGE(PG8_SB(1, 1), cB + hstep + kstep, voffB);
        PG8_WAIT_V(6); PG8_BAR;
    } else {
        PG8_STAGE(PG8_SB(0, 0), cB, voffB); PG8_STAGE(PG8_SA(0, 0), cA, voffA); PG8_STAGE(PG8_SB(0, 1), cB + hstep, voffB); PG8_STAGE(PG8_SA(0, 1), cA + hstep, voffA);
        if (wr == 1) PG8_BAR;
        PG8_WAIT_V(4); PG8_BAR;
        PG8_STAGE(PG8_SB(1, 0), cB + kstep, voffB); PG8_STAGE(PG8_SA(1, 0), cA + kstep, voffA); PG8_STAGE(PG8_SB(1, 1), cB + hstep + kstep, voffB);
        PG8_WAIT_V(6); PG8_BAR;
    }
    for (;;) {
        const bool has_next = S.next(ui + 1, nxt);
        const char* nA = has_next ? (const char*)g.A + (size_t)nxt.pm * tstep + (size_t)nxt.kofs * 2 : cA; const char* nB = has_next ? (const char*)g.Bt + (size_t)nxt.pn * tstep + (size_t)nxt.kofs * 2 : cB;
        const int nt = cur.nt;
        for (int t = 0; t < nt; t += 2) {
            const bool last = (t == nt - 2);
            const char* a1 = cA + (size_t)(t + 1) * kstep;
            const char* a2 = last ? nA : cA + (size_t)(t + 2) * kstep; const char* b2 = last ? nB : cB + (size_t)(t + 2) * kstep;
            const char* a3 = a2 + kstep; const char* b3 = b2 + kstep;
            if (last && has_next) S.a_ready(nxt);
            if constexpr (SP2) {
            PG8_LDB(B0, 0, 0); PG8_LDB(B1, 0, 1); PG8_SCHED; PG8_LDA(At, 0, 0); PG8_STAGE(PG8_SA(1, 1), a1 + hstep, voffA);
            PG8_WAIT_V(8); PG8_WAIT_L(0); PG8_BAR; PG8_MMA(0, 0, At, B0); PG8_MMA(0, 1, At, B1); PG8_BAR; PG8_SCHED;
            PG8_LDA(At, 0, 1); PG8_STAGE(PG8_SB(0, 0), b2, voffB); PG8_STAGE(PG8_SB(0, 1), b2 + hstep, voffB); PG8_STAGE(PG8_SA(0, 0), a2, voffA);
            PG8_WAIT_V(8); PG8_WAIT_L(0); PG8_BAR; PG8_MMA(1, 0, At, B0); PG8_MMA(1, 1, At, B1); PG8_BAR; PG8_SCHED;
            PG8_LDB(B0, 1, 0); PG8_LDB(B1, 1, 1); PG8_SCHED; PG8_LDA(At, 1, 0); PG8_STAGE(PG8_SA(0, 1), a2 + hstep, voffA);
            PG8_WAIT_V(8); PG8_WAIT_L(0); PG8_BAR; PG8_MMA(0, 0, At, B0); PG8_MMA(0, 1, At, B1); PG8_BAR; PG8_SCHED;
            PG8_LDA(At, 1, 1); PG8_STAGE(PG8_SB(1, 0), b3, voffB); PG8_STAGE(PG8_SB(1, 1), b3 + hstep, voffB); PG8_STAGE(PG8_SA(1, 0), a3, voffA);
            PG8_WAIT_V(8); PG8_WAIT_L(0); PG8_BAR; PG8_MMA(1, 0, At, B0); PG8_MMA(1, 1, At, B1); PG8_BAR; PG8_SCHED;
            } else {
            PG8_LDB(B0, 0, 0); PG8_SCHED; PG8_LDA(At, 0, 0); PG8_STAGE(PG8_SA(1, 1), a1 + hstep, voffA);
            PG8_WAIT_L(8); PG8_BAR; PG8_WAIT_L(0); PG8_MMA(0, 0, At, B0); PG8_BAR; PG8_SCHED;
            PG8_LDB(B1, 0, 1); PG8_STAGE(PG8_SB(0, 0), b2, voffB);
            PG8_BAR; PG8_WAIT_L(0); PG8_MMA(0, 1, At, B1); PG8_BAR;
            PG8_LDA(At, 0, 1); PG8_STAGE(PG8_SA(0, 0), a2, voffA);
            PG8_BAR; PG8_WAIT_L(0); PG8_MMA(1, 0, At, B0); PG8_BAR; PG8_SCHED;
            PG8_STAGE(PG8_SB(0, 1), b2 + hstep, voffB);
            PG8_WAIT_V(6); PG8_BAR; PG8_MMA(1, 1, At, B1); PG8_BAR;
            PG8_LDB(B0, 1, 0); PG8_SCHED; PG8_LDA(At, 1, 0); PG8_STAGE(PG8_SA(0, 1), a2 + hstep, voffA);
            PG8_WAIT_L(8); PG8_BAR; PG8_WAIT_L(0); PG8_MMA(0, 0, At, B0); PG8_BAR; PG8_SCHED;
            PG8_LDB(B1, 1, 1); PG8_STAGE(PG8_SB(1, 0), b3, voffB);
            PG8_BAR; PG8_WAIT_L(0); PG8_MMA(0, 1, At, B1); PG8_BAR;
            PG8_LDA(At, 1, 1); PG8_STAGE(PG8_SA(1, 0), a3, voffA);
            PG8_BAR; PG8_WAIT_L(0); PG8_MMA(1, 0, At, B0); PG8_BAR; PG8_SCHED;
            PG8_STAGE(PG8_SB(1, 1), b3 + hstep, voffB);
            PG8_WAIT_V(6); PG8_BAR; PG8_MMA(1, 1, At, B1); PG8_BAR;
            }
        }
        if constexpr (ALIGN_EPI) { if (wr == 0) PG8_BAR; }
        if constexpr (!Epi::AFTER_DRAIN) { E(acc, cur, wr, wc, fr, fq); S.done(cur); }
        if (!has_next) break;
        if constexpr (Epi::HAS_INIT) E.init(acc, nxt, wr, wc, fr, fq);
        else {
#pragma unroll
        for (int a = 0; a < 2; ++a)
#pragma unroll
            for (int b = 0; b < 2; ++b)
#pragma unroll
                for (int m = 0; m < 4; ++m)
#pragma unroll
                    for (int n = 0; n < 2; ++n) acc[a][b][m][n] = (f32x4){0.f, 0.f, 0.f, 0.f};
        }
        cur = nxt; cA = nA; cB = nB; ++ui;
        if constexpr (ALIGN_EPI) { if (wr == 1) PG8_BAR; }
    }
    PG8_WAIT_V(0);
    if constexpr (!ALIGN_EPI) { if (wr == 0) PG8_BAR; }
    PG8_BAR;
    if constexpr (Epi::AFTER_DRAIN) { E.fused(acc, cur, wr, wc, fr, fq, lds, wid, lane); S.done(cur); }
#undef PG8_SA
#undef PG8_SB
#undef PG8_STAGE
#undef PG8_LDA
#undef PG8_LDB
#undef PG8_MMA
#undef PG8_WAIT_V
#undef PG8_WAIT_L
#undef PG8_BAR
#undef PG8_SCHED
}
}

#define LAS __attribute__((address_space(3)))
typedef unsigned short bf16;
typedef unsigned v4u __attribute__((ext_vector_type(4)));
typedef unsigned v2u __attribute__((ext_vector_type(2)));
typedef float f32x4 __attribute__((ext_vector_type(4)));
typedef float f32x2 __attribute__((ext_vector_type(2)));
typedef short bf16x8 __attribute__((ext_vector_type(8)));

constexpr int NWAVES = 8, NTHR = 512;
constexpr int D = 1024, MP = 16384, MS = 1024, M = MP + MS, TP = 2048, NB = 8, SB = 128, TS = 8, DEPTH = 4;
constexpr int RH = 8, RHD = 64, RW = 512, RPROJ = 1792;
constexpr int GH = 4, GHD = 128, GW = 512, GQKV = 1536, GPR = 2048;
constexpr int EPROJ = 3848, FF = 4096;
constexpr int NSEQ = NB + SB;

constexpr size_t O_Y = 0;
constexpr size_t O_RWKV_P = (size_t)M * D;
constexpr size_t O_RWKV_S = O_RWKV_P + (size_t)2 * NB * RH * 4096;
constexpr size_t O_SH_P = O_RWKV_S + (size_t)2 * SB * RH * 4096;
constexpr size_t O_SH_S = O_SH_P + (size_t)2 * NB * RPROJ;
constexpr size_t O_GDN_P = O_SH_S + (size_t)2 * SB * RPROJ;
constexpr size_t O_GDN_S = O_GDN_P + (size_t)2 * NB * GH * 16384;
constexpr size_t O_GC_P = O_GDN_S + (size_t)2 * SB * GH * 16384;
constexpr size_t O_GC_S = O_GC_P + (size_t)2 * NB * 3 * GQKV;
constexpr size_t O_LRU_P = O_GC_S + (size_t)2 * SB * 3 * GQKV;
constexpr size_t O_LRU_S = O_LRU_P + (size_t)2 * NB * D;
constexpr size_t O_LC_P = O_LRU_S + (size_t)2 * SB * D;
constexpr size_t O_LC_S = O_LC_P + (size_t)2 * NB * 3 * D;
constexpr size_t O_END = O_LC_S + (size_t)2 * SB * 3 * D;
static_assert(O_END == 47419392, "output size");

constexpr size_t MiB = 1u << 20;
constexpr size_t WS_WIN = 0, WS_WOUT = 8 * MiB, WS_WUP = 10 * MiB, WS_WDN = 18 * MiB, WS_WA = 26 * MiB, WS_WI = 26 * MiB + 512 * 1024;
constexpr size_t WS_CTL = 27 * MiB, CTL_BYTES = 16384;
constexpr size_t WS_W2T = 26 * MiB, WS_A2T = 26 * MiB + 65536, WS_G2T = 26 * MiB + 131072;
constexpr size_t WS_XN = 28 * MiB;
constexpr size_t WS_PROJ = 62 * MiB;
constexpr size_t WS_YRAW = WS_PROJ, WS_ORAW = WS_PROJ + 34 * MiB;
constexpr size_t WS_SCN = 130 * MiB;
constexpr size_t A17 = 17 * MiB;
constexpr size_t WS_RU = WS_SCN, WS_RA = WS_SCN + A17, WS_RB = WS_SCN + 2 * A17, WS_RK = WS_SCN + 3 * A17, WS_RWR = WS_SCN + 4 * A17, WS_RV = WS_SCN + 5 * A17, WS_RG = WS_SCN + 6 * A17;
constexpr size_t WS_GQ = WS_SCN + 7 * A17, WS_GK = WS_SCN + 8 * A17, WS_GV = WS_SCN + 9 * A17, WS_GZ = WS_SCN + 10 * A17;
constexpr size_t WS_RSC = WS_SCN + 11 * A17;
constexpr size_t WS_GSC = WS_RSC + 3 * MiB;
constexpr size_t WS_P8 = WS_GSC + 2 * MiB;
constexpr size_t WS_END_EVEN = WS_P8 + 1 * MiB;
constexpr size_t WS_LP = WS_SCN, WS_LH = WS_SCN + 68 * MiB, WS_LTOT = WS_SCN + 136 * MiB;
constexpr size_t WS_HID = WS_PROJ;
constexpr size_t WS_PART = 200 * MiB;
constexpr size_t WS_H = WS_END_EVEN;
constexpr size_t WS_TOTAL = WS_H + 34 * MiB;
static_assert(WS_PART >= WS_HID + (size_t)M * FF * 2 && WS_PART + 64 * MiB <= WS_TOTAL, "PART placement");
static_assert(WS_HID + (size_t)M * FF * 2 <= WS_TOTAL && WS_LTOT + 544 * 1024 * 8 <= WS_TOTAL, "ws map");

constexpr int LDS_BYTES = 147456, MISC_OFF = 131072 + 256;

struct Args { const float* in[39]; float* out; unsigned char* ws; int ph_lo, ph_hi; };

__device__ __forceinline__ float bf2f(bf16 b) { return __builtin_bit_cast(float, (unsigned)b << 16); }
__device__ __forceinline__ float bflo(unsigned w) { return __builtin_bit_cast(float, w << 16); }
__device__ __forceinline__ float bfhi(unsigned w) { return __builtin_bit_cast(float, w & 0xffff0000u); }
__device__ __forceinline__ unsigned f2bf(float f) { unsigned u = __builtin_bit_cast(unsigned, f); return (u + 0x7fffu + ((u >> 16) & 1u)) >> 16; }
__device__ __forceinline__ unsigned pk2(float lo, float hi) { return f2bf(lo) | (f2bf(hi) << 16); }
__device__ __forceinline__ float wave_sum(float v) {
#pragma unroll
    for (int o = 1; o < 64; o <<= 1) v += __shfl_xor(v, o);
    return v;
}
template <int CTRL> __device__ __forceinline__ float dppf(float x) { return __builtin_bit_cast(float, __builtin_amdgcn_update_dpp(0, __builtin_bit_cast(int, x), CTRL, 0xf, 0xf, false)); }
__device__ __forceinline__ float allsum16(float x) { x += dppf<0x128>(x); x += dppf<0x124>(x); x += dppf<0x122>(x); x += dppf<0x121>(x); return x; }
__device__ __forceinline__ float sigmoidf_(float x) { return __builtin_amdgcn_rcpf(1.0f + __expf(-x)); }
__device__ __forceinline__ float softplusf_(float x) { return fmaxf(x, 0.f) + log1pf(__expf(-fabsf(x))); }
__device__ __forceinline__ float siluf_(float x) { return x * __builtin_amdgcn_rcpf(1.0f + __expf(-x)); }
__device__ __forceinline__ float tanhf_(float x) { return 1.0f - 2.0f * __builtin_amdgcn_rcpf(1.0f + __expf(2.0f * x)); }
#define LDS_WAIT() asm volatile("s_waitcnt lgkmcnt(0)" ::: "memory")

#define XB_TMO      128
#define XB_XCNT(j)  (256  + 64 * (j))
#define XB_XSUB(j)  (1280 + 64 * (j))
#define XB_XGEN(j)  (2304 + 64 * (j))
#define XB_TOP      3328
#define XB_TOPGEN   3392
#define XCD_BAR_WORDS 3456
#define XB_SPIN_CAP (1u << 18)

__device__ __forceinline__ unsigned xb_ld(unsigned* p)              { return __hip_atomic_load(p, __ATOMIC_RELAXED, __HIP_MEMORY_SCOPE_AGENT); }
__device__ __forceinline__ unsigned xb_add(unsigned* p, unsigned v) { return __hip_atomic_fetch_add(p, v, __ATOMIC_RELAXED, __HIP_MEMORY_SCOPE_AGENT); }
__device__ __forceinline__ unsigned xb_xcc_id() { return (unsigned)__builtin_amdgcn_s_getreg((3 << 11) | 20) & 0xFu; }
#define XB_SPIN(cond, bar) do { unsigned _sp = 0; while (cond) { __builtin_amdgcn_s_sleep(1); \
    if ((++_sp & 255u) == 0u) { if (xb_ld(&(bar)[XB_TMO])) break; if (_sp > XB_SPIN_CAP) { atomicAdd(&(bar)[XB_TMO], 1u); break; } } } } while (0)

struct XcdBarrier {
    unsigned* bar; unsigned x;
    volatile LAS unsigned* st;
};

__device__ __forceinline__ XcdBarrier xcd_barrier_post(unsigned* bar, volatile LAS unsigned* st) {
    XcdBarrier b; b.bar = bar; b.x = xb_xcc_id(); b.st = st;
    if (threadIdx.x == 0) (void)xb_add(&bar[XB_XCNT(b.x)], 1u);
    return b;
}
__device__ __forceinline__ void xcd_barrier_complete(unsigned* bar, unsigned x, unsigned& nloc, unsigned& nx) {
    const unsigned G = gridDim.x * gridDim.y * gridDim.z;
    unsigned sum, cnt, mine, sp = 0u;
    for (;;) {
        sum = 0u; cnt = 0u; mine = 0u;
#pragma unroll
        for (unsigned j = 0; j < 16; ++j) { const unsigned c = xb_ld(&bar[XB_XCNT(j)]); sum += c; cnt += (c > 0u) ? 1u : 0u; mine = (j == x) ? c : mine; }
        if (sum == G) break;
        __builtin_amdgcn_s_sleep(1);
        if ((++sp & 255u) == 0u) { if (xb_ld(&bar[XB_TMO])) break; if (sp > XB_SPIN_CAP) { atomicAdd(&bar[XB_TMO], 1u); break; } }
    }
    nloc = mine > 0u ? mine : 1u; nx = cnt > 0u ? cnt : 1u;
}

__device__ __forceinline__ void xcd_barrier(const XcdBarrier& b) {
    asm volatile("s_waitcnt vmcnt(0)" ::: "memory");
    __syncthreads();
    if (threadIdx.x == 0) {
        unsigned* bar = b.bar;
        __builtin_amdgcn_s_waitcnt(0);
        unsigned nloc = b.st[0], nx = b.st[1];
        if (nloc == 0u) { xcd_barrier_complete(bar, b.x, nloc, nx); b.st[0] = nloc; b.st[1] = nx; }
        const unsigned old = xb_add(&bar[XB_XSUB(b.x)], 1u);
        const unsigned gen = old / nloc;
        if (old + 1u == (gen + 1u) * nloc) {
            __builtin_amdgcn_fence(__ATOMIC_RELEASE, "agent");
            asm volatile("s_waitcnt vmcnt(0)" ::: "memory");
            const unsigned og = xb_add(&bar[XB_TOP], 1u);
            const unsigned tg = og / nx;
            if (og + 1u == (tg + 1u) * nx) xb_add(&bar[XB_TOPGEN], 1u);
            else XB_SPIN(xb_ld(&bar[XB_TOPGEN]) == tg, bar);
            __builtin_amdgcn_fence(__ATOMIC_ACQUIRE, "agent");
            xb_add(&bar[XB_XGEN(b.x)], 1u);
            asm volatile("s_waitcnt vmcnt(0)" ::: "memory");
        } else {
            XB_SPIN(xb_ld(&bar[XB_XGEN(b.x)]) == gen, bar);
            __builtin_amdgcn_fence(__ATOMIC_ACQUIRE, "agent");
            asm volatile("s_waitcnt vmcnt(0)" ::: "memory");
        }
    }
    __syncthreads();
}

struct Ctx {
    LAS unsigned char* lds;
    const float* const* in;
    float* out; unsigned char* ws;
    int bid, G;
};
#define PHASE_IDS int tid = threadIdx.x; asm volatile("" : "+v"(tid)); const int lane = tid & 63; const int wave = __builtin_amdgcn_readfirstlane(tid >> 6); (void)lane; (void)wave;

__device__ __forceinline__ void transpose_item(const float* W, int ldw, int K, int N, bf16* WT, LAS float* scr, int item, int lane) {
    const int nblk = N / 32, kb = item / nblk, nb = item % nblk, k0 = 64 * kb, n0 = 32 * nb;
#pragma unroll 8
    for (int i = 0; i < 32; ++i) { const int kk = 2 * i + (lane >> 5); scr[kk * 33 + (lane & 31)] = W[(size_t)(k0 + kk) * ldw + n0 + (lane & 31)]; }
    LDS_WAIT(); asm volatile("" ::: "memory");
    const int c = lane & 7;
#pragma unroll
    for (int j = 0; j < 4; ++j) { const int n = (lane >> 3) + 8 * j; const LAS float* s = scr + (8 * c) * 33 + n;
        v4u o; o.x = pk2(s[0 * 33], s[1 * 33]); o.y = pk2(s[2 * 33], s[3 * 33]); o.z = pk2(s[4 * 33], s[5 * 33]); o.w = pk2(s[6 * 33], s[7 * 33]);
        *(v4u*)(WT + (size_t)(n0 + n) * K + k0 + 8 * c) = o; }
    LDS_WAIT(); asm volatile("" ::: "memory");
}

__device__ __forceinline__ void phase_convert(Ctx& C, int l) {
    PHASE_IDS
    const int i = l >> 1; const bool even = (l & 1) == 0;
    LAS float* scr = (LAS float*)(C.lds + wave * 8448);
    const int gw = C.bid * NWAVES + wave, NGW = C.G * NWAVES;
    bf16* WIN = (bf16*)(C.ws + WS_WIN); bf16* WOUT = (bf16*)(C.ws + WS_WOUT); bf16* WUP = (bf16*)(C.ws + WS_WUP); bf16* WDN = (bf16*)(C.ws + WS_WDN);
    const float* up = C.in[37] + (size_t)l * D * FF; const float* dn = C.in[38] + (size_t)l * FF * D;
    const int NIN = even ? 3840 : 2048, LDIN = even ? EPROJ : 2048;
    const float* win = even ? C.in[11] + (size_t)i * D * EPROJ : C.in[28] + (size_t)i * D * 2048;
    const float* wout = even ? C.in[12] + (size_t)i * D * D : C.in[29] + (size_t)i * D * D;
    const int I_IN = (D / 64) * (NIN / 32), I_OUT = (D / 64) * (D / 32), I_UP = (D / 64) * (FF / 32), I_DN = (FF / 64) * (D / 32), I_G = even ? 0 : 8 * 8, I_L = even ? 16 : 0;
    const int NITEMS = I_IN + I_OUT + I_UP + I_DN + 2 * I_G + 4 * I_L;
    for (int it = gw; it < NITEMS; it += NGW) {
        int r = it;
        if (r < I_IN) { transpose_item(win, LDIN, D, NIN, WIN, scr, r, lane); continue; } r -= I_IN;
        if (r < I_OUT) { transpose_item(wout, D, D, D, WOUT, scr, r, lane); continue; } r -= I_OUT;
        if (r < I_UP) { transpose_item(up, FF, D, FF, WUP, scr, r, lane); continue; } r -= I_UP;
        if (r < I_DN) { transpose_item(dn, D, FF, D, WDN, scr, r, lane); continue; } r -= I_DN;
        if (even) {
            if (r < I_L) { transpose_item(C.in[15] + (size_t)i * 64 * RW, RW, 64, RW, (bf16*)(C.ws + WS_W2T), scr, r, lane); continue; } r -= I_L;
            if (r < I_L) { transpose_item(C.in[17] + (size_t)i * 64 * RW, RW, 64, RW, (bf16*)(C.ws + WS_A2T), scr, r, lane); continue; } r -= I_L;
            transpose_item(C.in[18] + (size_t)i * 128 * RW, RW, 128, RW, (bf16*)(C.ws + WS_G2T), scr, r, lane); continue;
        }
        if (r < I_G) { const int h = r >> 3; transpose_item(C.in[32] + (size_t)(i * 8 + h) * 16384, 128, 128, 128, (bf16*)(C.ws + WS_WA) + h * 16384, scr, r & 7, lane); continue; } r -= I_G;
        { const int h = r >> 3; transpose_item(C.in[34] + (size_t)(i * 8 + h) * 16384, 128, 128, 128, (bf16*)(C.ws + WS_WI) + h * 16384, scr, r & 7, lane); }
    }
}

template <bool FIRST, bool P8>
__device__ __forceinline__ void phase_norm(Ctx& C, const float* nw, const float* w8src  , int ld8, int npart) {
    PHASE_IDS
    LAS float* w8 = (LAS float*)(C.lds + 96 * 1024);
    if (P8) {
        for (int idx = tid; idx < 8192; idx += NTHR) w8[idx] = w8src[(size_t)(idx >> 3) * ld8 + (idx & 7)];
        __syncthreads();
    }
    const int gw = C.bid * NWAVES + wave, NGW = C.G * NWAVES;
    bf16* XN = (bf16*)(C.ws + WS_XN); float* P8o = (float*)(C.ws + WS_P8);
    f32x4 wv[4];
#pragma unroll
    for (int j = 0; j < 4; ++j) wv[j] = *(const f32x4*)(nw + 4 * lane + 256 * j);
    for (int m = gw; m < M; m += NGW) {
        bf16* hrow = (bf16*)(C.ws + WS_H) + (size_t)m * D + 4 * lane;
        f32x4 v[4]; float ss = 0.f;
        if (FIRST) { const float* src = (m < MP ? C.in[0] + (size_t)m * D : C.in[1] + (size_t)(m - MP) * D);
#pragma unroll
            for (int j = 0; j < 4; ++j) v[j] = *(const f32x4*)(src + 4 * lane + 256 * j); }
        else {
#pragma unroll
            for (int j = 0; j < 4; ++j) { const v2u hw = *(const v2u*)(hrow + 256 * j); v[j] = (f32x4){bflo(hw.x), bfhi(hw.x), bflo(hw.y), bfhi(hw.y)}; } }
        if (!FIRST && m >= MP && npart > 0) {
            const bf16* pp = (const bf16*)(C.ws + WS_PART) + (size_t)(m - MP) * D + 4 * lane;
            for (int ks = 0; ks < npart; ++ks) {
#pragma unroll
                for (int j = 0; j < 4; ++j) { const v2u pw = *(const v2u*)(pp + (size_t)ks * MS * D + 256 * j); v[j] += (f32x4){bflo(pw.x), bfhi(pw.x), bflo(pw.y), bfhi(pw.y)}; } }
#pragma unroll
            for (int j = 0; j < 4; ++j) { v2u hw; hw.x = pk2(v[j].x, v[j].y); hw.y = pk2(v[j].z, v[j].w); *(v2u*)(hrow + 256 * j) = hw; }
        }
#pragma unroll
        for (int j = 0; j < 4; ++j) ss += (v[j].x * v[j].x + v[j].y * v[j].y) + (v[j].z * v[j].z + v[j].w * v[j].w);
        if (FIRST && m >= MP) {
#pragma unroll
            for (int j = 0; j < 4; ++j) { v2u hw; hw.x = pk2(v[j].x, v[j].y); hw.y = pk2(v[j].z, v[j].w); *(v2u*)(hrow + 256 * j) = hw; }
        }
        const float rs = rsqrtf(wave_sum(ss) * (1.f / D) + 1e-6f);
        float d8[8];
#pragma unroll
        for (int q = 0; q < 8; ++q) d8[q] = 0.f;
#pragma unroll
        for (int j = 0; j < 4; ++j) {
            v[j] = v[j] * rs * wv[j];
            v2u o; o.x = pk2(v[j].x, v[j].y); o.y = pk2(v[j].z, v[j].w);
            *(v2u*)(XN + (size_t)m * D + 4 * lane + 256 * j) = o;
            if (P8) {
#pragma unroll
                for (int e = 0; e < 4; ++e) { const int k = 4 * lane + 256 * j + e; const f32x4 a = *(const LAS f32x4*)(w8 + k * 8), b = *(const LAS f32x4*)(w8 + k * 8 + 4); const float x = v[j][e];
                    d8[0] += x * a.x; d8[1] += x * a.y; d8[2] += x * a.z; d8[3] += x * a.w; d8[4] += x * b.x; d8[5] += x * b.y; d8[6] += x * b.z; d8[7] += x * b.w; }
            }
        }
        if (P8) {
#pragma unroll
            for (int q = 0; q < 8; ++q) d8[q] = wave_sum(d8[q]);
            if (lane == 0) { *(f32x4*)(P8o + (size_t)m * 8) = (f32x4){d8[0], d8[1], d8[2], d8[3]}; *(f32x4*)(P8o + (size_t)m * 8 + 4) = (f32x4){d8[4], d8[5], d8[6], d8[7]}; }
        }
    }
}

__device__ __forceinline__ void phase_final(Ctx& C) {
    PHASE_IDS
    const int gw = C.bid * NWAVES + wave, NGW = C.G * NWAVES; const float* nw = C.in[10];
    f32x4 wv[4];
#pragma unroll
    for (int j = 0; j < 4; ++j) wv[j] = *(const f32x4*)(nw + 4 * lane + 256 * j);
    for (int m = gw; m < M; m += NGW) {
        float* row = C.out + (size_t)m * D; f32x4 v[4]; float ss = 0.f; const bf16* hrow = (const bf16*)(C.ws + WS_H) + (size_t)m * D + 4 * lane;
#pragma unroll
        for (int j = 0; j < 4; ++j) { const v2u hw = *(const v2u*)(hrow + 256 * j); v[j] = (f32x4){bflo(hw.x), bfhi(hw.x), bflo(hw.y), bfhi(hw.y)}; }
        if (m >= MP) { const bf16* pp = (const bf16*)(C.ws + WS_PART) + (size_t)(m - MP) * D + 4 * lane;
            for (int ks = 0; ks < 16; ++ks) {
#pragma unroll
                for (int j = 0; j < 4; ++j) { const v2u pw = *(const v2u*)(pp + (size_t)ks * MS * D + 256 * j); v[j] += (f32x4){bflo(pw.x), bfhi(pw.x), bflo(pw.y), bfhi(pw.y)}; } } }
#pragma unroll
        for (int j = 0; j < 4; ++j) ss += (v[j].x * v[j].x + v[j].y * v[j].y) + (v[j].z * v[j].z + v[j].w * v[j].w);
        const float rs = rsqrtf(wave_sum(ss) * (1.f / D) + 1e-6f);
#pragma unroll
        for (int j = 0; j < 4; ++j) *(f32x4*)(row + 4 * lane + 256 * j) = v[j] * rs * wv[j];
    }
}

struct EpiRes {
    static constexpr bool PERM = false, AFTER_DRAIN = false, HAS_INIT = true;
    bf16* H; bf16* PART; const float* Hin;
    __device__ __forceinline__ void init(pg8::f32x4 (&acc)[2][2][4][2], const pg8::Unit& u, int wr, int wc, int fr, int fq) const {
        const size_t uo = (size_t)(u.pm * 256 + wr * 64) * D + u.pn * 256 + wc * 32;
        const float* ub = Hin + uo; const bf16* ubh = H + uo;
        const int loff = fr * D + 4 * fq;
#pragma unroll
        for (int ai = 0; ai < 2; ++ai)
#pragma unroll
            for (int m = 0; m < 4; ++m) { const float* rowp = ub + (size_t)(ai * 128 + m * 16) * D; const bf16* rowh = ubh + (size_t)(ai * 128 + m * 16) * D;
#pragma unroll
                for (int bj = 0; bj < 2; ++bj)
#pragma unroll
                    for (int n = 0; n < 2; ++n) { if (u.atomic) acc[ai][bj][m][n] = (pg8::f32x4){0.f, 0.f, 0.f, 0.f}; else if (Hin) { const f32x4 o = *(const f32x4*)(rowp + loff + bj * 128 + n * 16); acc[ai][bj][m][n] = (pg8::f32x4){o.x, o.y, o.z, o.w}; }
                        else { const v2u hw = *(const v2u*)(rowh + loff + bj * 128 + n * 16); acc[ai][bj][m][n] = (pg8::f32x4){bflo(hw.x), bfhi(hw.x), bflo(hw.y), bfhi(hw.y)}; } } }
    }
    __device__ __forceinline__ void operator()(const pg8::f32x4 (&acc)[2][2][4][2], const pg8::Unit& u, int wr, int wc, int fr, int fq) const {
        const int row0 = u.pm * 256 + wr * 64 + fr, col0 = u.pn * 256 + wc * 32 + 4 * fq;
#pragma unroll
        for (int ai = 0; ai < 2; ++ai)
#pragma unroll
            for (int m = 0; m < 4; ++m) { const size_t ro = (size_t)(row0 + ai * 128 + m * 16) * D + col0;
#pragma unroll
                for (int bj = 0; bj < 2; ++bj)
#pragma unroll
                    for (int n = 0; n < 2; ++n) { const size_t eo = ro + bj * 128 + n * 16; const pg8::f32x4 a = acc[ai][bj][m][n]; v2u pw; pw.x = pk2(a[0], a[1]); pw.y = pk2(a[2], a[3]);
                        if (u.atomic) { *(v2u*)(PART + ((size_t)(u.atomic - 1) * MS * D) + eo - (size_t)MP * D) = pw; }
                        else { *(v2u*)(H + eo) = pw; } } }
    }
};

struct SplitOrder {
    pg8::StaticOrder base; int nsplit, K, c;
    __device__ void init(int N, int G_, int c_, int K_, int nsplit_) { base.init(MP, N, G_, c_, K_); nsplit = nsplit_; K = K_; c = c_; }
    __device__ bool next(int i, pg8::Unit& u) const {
        if (i == 0) return base.next(0, u);
        if (i == 1 && c < 16 * nsplit) { const int tile = c / nsplit, ks = c - tile * nsplit; u.pm = 64 + (tile >> 2); u.pn = tile & 3; u.kofs = ks * (K / nsplit); u.nt = K / nsplit / 64; u.atomic = ks + 1; return true; }
        return false;
    }
    __device__ __forceinline__ void a_ready(const pg8::Unit&) const {}
    __device__ __forceinline__ void done(const pg8::Unit&) const {}
};
__device__ __forceinline__ void run_gemm_res(Ctx& C, const bf16* A, const bf16* Bt, int K, int nsplit, const float* hin) {
    pg8::Gemm g{A, Bt, M, D, K}; SplitOrder S; S.init(D, C.G, C.bid, K, nsplit); EpiRes E{(bf16*)(C.ws + WS_H), (bf16*)(C.ws + WS_PART), hin};
    pg8::gemm_phase<EpiRes, SplitOrder, true, true>(C.lds, g, S, E);
}
struct ProjAOrder {
    pg8::StaticOrder base; int G, c;
    __device__ void init(int G_, int c_) { base.init(M, RPROJ, G_, c_, D); G = G_; c = c_; }
    __device__ bool next(int i, pg8::Unit& u) const {
        if (base.next(i, u)) return true;
        const int L = i * G + c;
        if (L < 476 + 32) { const int idx = L - 476; u.pm = 64 + (idx >> 3); u.pn = 7 + (idx & 7); u.kofs = 0; u.nt = D / 64; u.atomic = 0; return true; }
        return false;
    }
    __device__ __forceinline__ void a_ready(const pg8::Unit&) const {}
    __device__ __forceinline__ void done(const pg8::Unit&) const {}
};
struct EpiProjA {
    static constexpr bool PERM = true, AFTER_DRAIN = false, HAS_INIT = false;
    pg8::bf16_t* O;
    __device__ __forceinline__ void operator()(const pg8::f32x4 (&acc)[2][2][4][2], const pg8::Unit& u, int wr, int wc, int fr, int fq) const {
        const int gt = __builtin_amdgcn_readfirstlane(u.pn >= 7 ? 1 : 0); const int ldc = RPROJ + gt * 256; const int colt = (u.pn - 7 * gt) * 256;
        const int row0 = u.pm * 256 + wr * 64 + fr, col0 = colt + wc * 32 + 8 * fq;
#pragma unroll
        for (int ai = 0; ai < 2; ++ai)
#pragma unroll
            for (int m = 0; m < 4; ++m) { pg8::bf16_t* rowp = O + (size_t)(row0 + ai * 128 + m * 16) * ldc + col0;
#pragma unroll
                for (int bj = 0; bj < 2; ++bj) { const pg8::f32x4 v0 = acc[ai][bj][m][0], v1 = acc[ai][bj][m][1];
                    pg8::u32x4 w; w.x = pg8::cvt_pk_bf16(v0[0], v0[1]); w.y = pg8::cvt_pk_bf16(v0[2], v0[3]); w.z = pg8::cvt_pk_bf16(v1[0], v1[1]); w.w = pg8::cvt_pk_bf16(v1[2], v1[3]);
                    *(pg8::u32x4*)(rowp + bj * 128) = w; } }
    }
};
template <class Epi>
__device__ __forceinline__ void run_gemm(Ctx& C, const bf16* A, const bf16* Bt, int N, int K, const Epi& E) {
    pg8::Gemm g{A, Bt, M, N, K}; pg8::StaticOrder S; S.init(M, N, C.G, C.bid, K);
    pg8::gemm_phase<Epi, pg8::StaticOrder, true, true>(C.lds, g, S, E);
}

constexpr int RP_TILE = 0, RP_SH = 61440, RP_LIN = 76800, RP_LINS = 264, RP_CST = 86016;
__device__ __forceinline__ void phase_rwkv_prep(Ctx& C, int i) {
    PHASE_IDS
    LAS bf16* TILE = (LAS bf16*)(C.lds + RP_TILE); LAS float* SH = (LAS float*)(C.lds + RP_SH); LAS bf16* LIN = (LAS bf16*)(C.lds + RP_LIN);
    const bf16* PR = (const bf16*)(C.ws + WS_PROJ);
    bf16* RU = (bf16*)(C.ws + WS_RU); bf16* RA = (bf16*)(C.ws + WS_RA); bf16* RB = (bf16*)(C.ws + WS_RB); bf16* RK = (bf16*)(C.ws + WS_RK);
    bf16* RWR = (bf16*)(C.ws + WS_RWR); bf16* RV = (bf16*)(C.ws + WS_RV); bf16* RG = (bf16*)(C.ws + WS_RG); float* RSC = (float*)(C.ws + WS_RSC);
    const bf16* W2T = (const bf16*)(C.ws + WS_W2T); const bf16* A2T = (const bf16*)(C.ws + WS_A2T); const bf16* G2T = (const bf16*)(C.ws + WS_G2T);
    const float* mu = C.in[13] + (size_t)i * RPROJ; const float* w0 = C.in[14] + i * RW; const float* a0 = C.in[16] + i * RW;
    const float* k_k = C.in[19] + i * RW; const float* k_a = C.in[20] + i * RW; const float* r_k = C.in[21] + i * RW;
    const int fr = lane & 15, fq = lane >> 4, h = wave;
    LAS float* CST = (LAS float*)(C.lds + RP_CST);
    { const int c = tid; CST[c] = mu[c]; CST[512 + c] = mu[512 + c]; CST[1024 + c] = mu[1024 + c]; CST[1536 + c] = w0[c]; CST[2048 + c] = a0[c]; CST[2560 + c] = k_k[c]; CST[3072 + c] = k_a[c]; CST[3584 + c] = r_k[c]; }
    const int lcol = tid & 255, ltg = tid >> 8; const float mul_ = mu[1536 + lcol];
    for (int tile = C.bid; tile < M / 16; tile += C.G) {
        const int m0 = tile * 16; const bool prompt = m0 < MP; const int sb = (m0 - MP) >> 3;
        const bool pfirst = prompt && ((m0 & (TP - 1)) == 0);
#pragma unroll
        for (int q = 0; q < 8; ++q) { const int id = tid + 512 * q;
            if (id < 17 * 224) { const int r = id / 224, ch = id - r * 224; v4u v = {0u, 0u, 0u, 0u};
                if (r > 0 || (prompt && !pfirst)) v = *(const v4u*)(PR + (size_t)(m0 - 1 + r) * RPROJ + ch * 8);
                *(LAS v4u*)(TILE + r * RPROJ + ch * 8) = v; } }
        if (!prompt) { const float* sh = C.in[3] + ((size_t)i * SB + sb) * RPROJ;
#pragma unroll
            for (int q = 0; q < 7; ++q) SH[tid + 512 * q] = sh[tid + 512 * q]; }
        __syncthreads();
        bf16x8 Bw[4][2], Ba[4][2];
#pragma unroll
        for (int nt = 0; nt < 4; ++nt) { const int n = h * 64 + fr * 4 + nt;
#pragma unroll
            for (int ks = 0; ks < 2; ++ks) { Bw[nt][ks] = *(const bf16x8*)(W2T + n * 64 + ks * 32 + fq * 8); Ba[nt][ks] = *(const bf16x8*)(A2T + n * 64 + ks * 32 + fq * 8); } }
#pragma unroll
        for (int t8 = 0; t8 < 8; ++t8) { const int t = ltg * 8 + t8;
            const float p = bf2f(TILE[(t + 1) * RPROJ + 1536 + lcol]);
            const float pv = (!prompt && t8 == 0) ? SH[ltg * RPROJ + 1536 + lcol] : bf2f(TILE[t * RPROJ + 1536 + lcol]);
            const float xs = p + mul_ * (pv - p);
            LIN[t * RP_LINS + lcol] = (bf16)f2bf((lcol < 64) ? tanhf_(xs) : ((lcol < 128) ? xs : sigmoidf_(xs))); }
        __syncthreads();
        pg8::f32x4 aw[4], aa[4], ag[4];
        {
            bf16x8 ax[4];
#pragma unroll
            for (int ks = 0; ks < 4; ++ks) ax[ks] = *(const LAS bf16x8*)(LIN + fr * RP_LINS + ks * 32 + fq * 8);
#pragma unroll
            for (int nt = 0; nt < 4; ++nt) {
                pg8::f32x4 z = {0.f, 0.f, 0.f, 0.f};
                aw[nt] = __builtin_amdgcn_mfma_f32_16x16x32_bf16(ax[0], Bw[nt][0], z, 0, 0, 0); aw[nt] = __builtin_amdgcn_mfma_f32_16x16x32_bf16(ax[1], Bw[nt][1], aw[nt], 0, 0, 0);
                aa[nt] = __builtin_amdgcn_mfma_f32_16x16x32_bf16(ax[2], Ba[nt][0], z, 0, 0, 0); aa[nt] = __builtin_amdgcn_mfma_f32_16x16x32_bf16(ax[3], Ba[nt][1], aa[nt], 0, 0, 0);
            }
        }
        asm volatile("" ::: "memory");
        {
            bf16x8 ax[4];
#pragma unroll
            for (int ks = 0; ks < 4; ++ks) ax[ks] = *(const LAS bf16x8*)(LIN + fr * RP_LINS + 128 + ks * 32 + fq * 8);
#pragma unroll
            for (int nt = 0; nt < 4; ++nt) { const int n = h * 64 + fr * 4 + nt;
                bf16x8 Bg[4];
#pragma unroll
                for (int ks = 0; ks < 4; ++ks) Bg[ks] = *(const bf16x8*)(G2T + n * 128 + ks * 32 + fq * 8);
                pg8::f32x4 z = {0.f, 0.f, 0.f, 0.f};
                ag[nt] = __builtin_amdgcn_mfma_f32_16x16x32_bf16(ax[0], Bg[0], z, 0, 0, 0);
#pragma unroll
                for (int ks = 1; ks < 4; ++ks) ag[nt] = __builtin_amdgcn_mfma_f32_16x16x32_bf16(ax[ks], Bg[ks], ag[nt], 0, 0, 0);
            }
        }
        asm volatile("" ::: "memory");
        const int c0 = h * 64 + fr * 4;
#define LD4(dst, p) do { const v2u w_ = *(const LAS v2u*)(p); dst[0] = bflo(w_.x); dst[1] = bfhi(w_.x); dst[2] = bflo(w_.y); dst[3] = bfhi(w_.y); } while (0)
#define LDF4(dst, p) do { const f32x4 w_ = *(const LAS f32x4*)(p); dst[0] = w_.x; dst[1] = w_.y; dst[2] = w_.z; dst[3] = w_.w; } while (0)
#pragma unroll
        for (int j = 0; j < 4; ++j) {
            const int tk = fq * 4 + j; const size_t m = (size_t)(m0 + tk);
            const bool sfirst = !prompt && ((tk & 7) == 0);
            float r4[4], k4[4], v4[4], pr[4], pk[4], pv[4], cm[4];
            LD4(r4, TILE + (tk + 1) * RPROJ + c0); LD4(k4, TILE + (tk + 1) * RPROJ + 512 + c0); LD4(v4, TILE + (tk + 1) * RPROJ + 1024 + c0);
            if (sfirst) { LDF4(pr, SH + (tk >> 3) * RPROJ + c0); LDF4(pk, SH + (tk >> 3) * RPROJ + 512 + c0); LDF4(pv, SH + (tk >> 3) * RPROJ + 1024 + c0); }
            else { LD4(pr, TILE + tk * RPROJ + c0); LD4(pk, TILE + tk * RPROJ + 512 + c0); LD4(pv, TILE + tk * RPROJ + 1024 + c0); }
            float xr[4], xk[4], xv[4], av[4], k2[4], krw[4]; float ssq = 0.f;
            LDF4(cm, CST + c0);
#pragma unroll
            for (int nt = 0; nt < 4; ++nt) xr[nt] = r4[nt] + cm[nt] * (pr[nt] - r4[nt]);
            LDF4(cm, CST + 512 + c0);
#pragma unroll
            for (int nt = 0; nt < 4; ++nt) xk[nt] = k4[nt] + cm[nt] * (pk[nt] - k4[nt]);
            LDF4(cm, CST + 1024 + c0);
#pragma unroll
            for (int nt = 0; nt < 4; ++nt) xv[nt] = v4[nt] + cm[nt] * (pv[nt] - v4[nt]);
            LDF4(cm, CST + 2560 + c0);
#pragma unroll
            for (int nt = 0; nt < 4; ++nt) { krw[nt] = xk[nt] * cm[nt]; ssq += krw[nt] * krw[nt]; }
            LDF4(cm, CST + 2048 + c0);
#pragma unroll
            for (int nt = 0; nt < 4; ++nt) av[nt] = sigmoidf_(cm[nt] + aa[nt][j]);
            LDF4(cm, CST + 3072 + c0);
#pragma unroll
            for (int nt = 0; nt < 4; ++nt) k2[nt] = xk[nt] * (1.0f + (av[nt] - 1.0f) * cm[nt]);
            ssq = allsum16(ssq);
            const float rn = rsqrtf(ssq + 1e-6f);
            float br = 0.f, kr = 0.f, rk = 0.f, w0v[4], rkv[4];
            LDF4(w0v, CST + 1536 + c0); LDF4(rkv, CST + 3584 + c0);
            float ou[4], oa[4], ob[4], ok[4], ow[4], og[4];
#pragma unroll
            for (int nt = 0; nt < 4; ++nt) {
                const float kk = krw[nt] * rn, bb = kk * av[nt], r = xr[nt];
                const float ew = 0.6065306597126334f * sigmoidf_(w0v[nt] + aw[nt][j]); const float dec = __expf(-ew);
                ob[nt] = bf2f((bf16)f2bf(bb)); ok[nt] = bf2f((bf16)f2bf(k2[nt]));
                br += ob[nt] * r; kr += ok[nt] * r; rk += r * k2[nt] * rkv[nt];
                ou[nt] = 1.0f - dec; oa[nt] = -kk; ow[nt] = dec * r; og[nt] = ag[nt][j]; }
            const size_t o = m * RW + c0;
#define ST4(ARR, f) do { v2u w_; w_.x = pk2(f[0], f[1]); w_.y = pk2(f[2], f[3]); *(v2u*)(ARR + o) = w_; } while (0)
            ST4(RU, ou); ST4(RA, oa); ST4(RB, ob); ST4(RK, ok); ST4(RWR, ow); ST4(RV, xv); ST4(RG, og);
#undef ST4
            br = allsum16(br); kr = allsum16(kr); rk = allsum16(rk);
            if (fr == 0) *(f32x4*)(RSC + (m * 8 + h) * 4) = (f32x4){br, kr, rk, 0.f};
        }
#undef LD4
#undef LDF4
        if (prompt) { if ((m0 & (TP - 1)) == TP - 16) { float* o = C.out + O_SH_P + ((size_t)i * NB + (m0 >> 11)) * RPROJ; for (int cc = tid; cc < RPROJ; cc += NTHR) o[cc] = bf2f(TILE[16 * RPROJ + cc]); } }
        else { float* o = C.out + O_SH_S + ((size_t)i * SB + sb) * RPROJ; for (int cc = tid; cc < 2 * RPROJ; cc += NTHR) { const int s = cc >= RPROJ ? 1 : 0; o[cc] = bf2f(TILE[(8 + 8 * s) * RPROJ + (cc - s * RPROJ)]); } }
        __syncthreads();
    }
}

__device__ __forceinline__ void unpack8(v4u c, float (&f)[8]) { f[0] = bflo(c.x); f[1] = bfhi(c.x); f[2] = bflo(c.y); f[3] = bfhi(c.y); f[4] = bflo(c.z); f[5] = bfhi(c.z); f[6] = bflo(c.w); f[7] = bfhi(c.w); }
__device__ __forceinline__ v4u pack8(const float (&f)[8]) { v4u o; o.x = pk2(f[0], f[1]); o.y = pk2(f[2], f[3]); o.z = pk2(f[4], f[5]); o.w = pk2(f[6], f[7]); return o; }
__device__ __forceinline__ void phase_gdn_prep(Ctx& C, int i) {
    PHASE_IDS
    LAS float* cwl = (LAS float*)C.lds;
    const bf16* PG = (const bf16*)(C.ws + WS_PROJ);
    bf16* GQ = (bf16*)(C.ws + WS_GQ); bf16* GK = (bf16*)(C.ws + WS_GK); bf16* GV = (bf16*)(C.ws + WS_GV); bf16* GZ = (bf16*)(C.ws + WS_GZ);
    float* GSC = (float*)(C.ws + WS_GSC); const float* P8 = (const float*)(C.ws + WS_P8);
    const float* cw = C.in[24] + (size_t)i * 4 * GQKV; const float* A_log = C.in[25] + i * GH; const float* dtb = C.in[26] + i * GH;
    for (int e = tid; e < 4 * GQKV; e += NTHR) cwl[e] = cw[e];
    __syncthreads();
    for (int tile = C.bid; tile < M / 8; tile += C.G) {
        const int m = tile * 8 + wave; const bool prompt = m < MP;
        const int t = prompt ? (m & (TP - 1)) : ((m - MP) & 7); const int b = prompt ? (m >> 11) : ((m - MP) >> 3);
        const bool last = prompt ? (t == TP - 1) : (t == 7);
        const bf16* P = PG + (size_t)m * GPR;
        const float* cs = C.in[5] + ((size_t)i * SB + (prompt ? 0 : b)) * 3 * GQKV;
        float* go = prompt ? C.out + O_GC_P + ((size_t)i * NB + b) * 3 * GQKV : C.out + O_GC_S + ((size_t)i * SB + b) * 3 * GQKV;
        float val[3][8];
#pragma unroll
        for (int blk = 0; blk < 3; ++blk) {
            const int col0 = blk * 512 + lane * 8;
            float xr[4][8];
            unpack8(*(const v4u*)(P + col0), xr[0]);
#pragma unroll
            for (int j = 1; j < 4; ++j) {
                if (t - j >= 0) unpack8(*(const v4u*)(P - (size_t)j * GPR + col0), xr[j]);
                else if (prompt) {
#pragma unroll
                    for (int e = 0; e < 8; ++e) xr[j][e] = 0.f; }
                else { const f32x4 a = *(const f32x4*)(cs + (3 + t - j) * GQKV + col0), c4 = *(const f32x4*)(cs + (3 + t - j) * GQKV + col0 + 4);
                    xr[j][0] = a.x; xr[j][1] = a.y; xr[j][2] = a.z; xr[j][3] = a.w; xr[j][4] = c4.x; xr[j][5] = c4.y; xr[j][6] = c4.z; xr[j][7] = c4.w; }
            }
#pragma unroll
            for (int h4 = 0; h4 < 2; ++h4) {
                const f32x4 w0 = *(const LAS f32x4*)(cwl + col0 + h4 * 4), w1 = *(const LAS f32x4*)(cwl + GQKV + col0 + h4 * 4), w2 = *(const LAS f32x4*)(cwl + 2 * GQKV + col0 + h4 * 4), w3 = *(const LAS f32x4*)(cwl + 3 * GQKV + col0 + h4 * 4);
#pragma unroll
                for (int e = 0; e < 4; ++e) { const int ee = h4 * 4 + e; val[blk][ee] = siluf_(w0[e] * xr[3][ee] + w1[e] * xr[2][ee] + w2[e] * xr[1][ee] + w3[e] * xr[0][ee]); }
            }
            if (last) {
#pragma unroll
                for (int j = 0; j < 3; ++j) { *(f32x4*)(go + j * GQKV + col0) = (f32x4){xr[2 - j][0], xr[2 - j][1], xr[2 - j][2], xr[2 - j][3]}; *(f32x4*)(go + j * GQKV + col0 + 4) = (f32x4){xr[2 - j][4], xr[2 - j][5], xr[2 - j][6], xr[2 - j][7]}; }
            }
        }
        float sq = 0.f, sk = 0.f;
#pragma unroll
        for (int e = 0; e < 8; ++e) { sq += val[0][e] * val[0][e]; sk += val[1][e] * val[1][e]; }
        sq = allsum16(sq); sk = allsum16(sk);
        const float nq = rsqrtf(sq + 1e-6f) * 0.08838834764831845f, nk = rsqrtf(sk + 1e-6f);
        float qh[8], kh[8];
#pragma unroll
        for (int e = 0; e < 8; ++e) { qh[e] = val[0][e] * nq; kh[e] = val[1][e] * nk; }
        const v4u qp = pack8(qh), kp = pack8(kh);
        const size_t o = (size_t)m * GW + lane * 8;
        *(v4u*)(GQ + o) = qp; *(v4u*)(GK + o) = kp; *(v4u*)(GV + o) = pack8(val[2]);
        float qr[8], kr[8]; unpack8(qp, qr); unpack8(kp, kr);
        float qk = 0.f;
#pragma unroll
        for (int e = 0; e < 8; ++e) qk += qr[e] * kr[e];
        qk = allsum16(qk);
        float z[8]; unpack8(*(const v4u*)(P + GQKV + lane * 8), z);
#pragma unroll
        for (int e = 0; e < 8; ++e) z[e] = siluf_(z[e]);
        *(v4u*)(GZ + o) = pack8(z);
        if ((lane & 15) == 0) { const int hh = lane >> 4;
            const float braw = P8[(size_t)m * 8 + hh], araw = P8[(size_t)m * 8 + 4 + hh];
            const float g = fmaxf(-__expf(A_log[hh]) * softplusf_(araw + dtb[hh]), -20.0f);
            *(f32x4*)(GSC + ((size_t)m * 4 + hh) * 4) = (f32x4){__expf(g), sigmoidf_(braw), qk, __expf(-g)}; }
    }
}

__device__ __forceinline__ void bf8_to_lds(LAS float* dst, v4u c) {
    *(LAS f32x4*)dst = (f32x4){bflo(c.x), bfhi(c.x), bflo(c.y), bfhi(c.y)};
    *(LAS f32x4*)(dst + 4) = (f32x4){bflo(c.z), bfhi(c.z), bflo(c.w), bfhi(c.w)};
}

__device__ __forceinline__ f32x2 fma2(f32x2 a, f32x2 b, f32x2 c) { return __builtin_elementwise_fma(a, b, c); }
constexpr int SCAN_UNR = 4;
struct ROps { f32x4 u, a, b, k, w; float v; f32x2 sc; };
__device__ __forceinline__ ROps r_ld(const LAS float* B, int t, int kq, int vidx) {
    ROps o; const LAS float* V = B + t * 320 + kq * 4;
    o.u = *(const LAS f32x4*)V; o.a = *(const LAS f32x4*)(V + 64); o.b = *(const LAS f32x4*)(V + 128); o.k = *(const LAS f32x4*)(V + 192); o.w = *(const LAS f32x4*)(V + 256);
    o.v = B[5120 + t * 16 + vidx]; o.sc = *(const LAS f32x2*)(B + 5376 + t * 2); return o;
}
template <int TB> __device__ __forceinline__ void rwkv_block(f32x4& S, const LAS float* B, int kq, int vidx, float* yo) {
    f32x2 S0 = {S.x, S.y}, S1 = {S.z, S.w}; float ykeep = 0.f;
    ROps c = r_ld(B, 0, kq, vidx);
#pragma unroll 1
    for (int t0 = 0; t0 < TB; t0 += SCAN_UNR)
#pragma unroll
    for (int tt = 0; tt < SCAN_UNR; ++tt) {
        const int t = t0 + tt;
        ROps n = r_ld(B, (t + 1) & 15, kq, vidx);
        const f32x2 a0 = {c.a.x, c.a.y}, a1 = {c.a.z, c.a.w}, w0 = {c.w.x, c.w.y}, w1 = {c.w.z, c.w.w};
        const f32x2 ps = fma2(S1, a1, S0 * a0), py = fma2(S1, w1, S0 * w0);
        const float sa = allsum16(ps.x + ps.y), yp = allsum16(py.x + py.y);
        const f32x2 u0 = {c.u.x, c.u.y}, u1 = {c.u.z, c.u.w}, b0 = {c.b.x, c.b.y}, b1 = {c.b.z, c.b.w}, k0 = {c.k.x, c.k.y}, k1 = {c.k.z, c.k.w};
        const f32x2 sa2 = {sa, sa}, v2 = {c.v, c.v};
        S0 = fma2(-u0, S0, S0); S1 = fma2(-u1, S1, S1);
        S0 = fma2(sa2, b0, S0); S1 = fma2(sa2, b1, S1);
        S0 = fma2(v2, k0, S0); S1 = fma2(v2, k1, S1);
        const float y = yp + sa * c.sc.x + c.v * c.sc.y;
        ykeep = (kq == t) ? y : ykeep;
        c = n;
    }
    if (TB == 16 || kq < TB) yo[(size_t)kq * RW] = ykeep;
    S = (f32x4){S0.x, S0.y, S1.x, S1.y};
}
struct GOps { f32x4 q0, q1, k0, k1; float v; f32x4 sc; };
__device__ __forceinline__ GOps g_ld(const LAS float* B, int t, int kq, int vidx) {
    GOps o; const LAS float* V = B + t * 256 + kq * 8;
    o.q0 = *(const LAS f32x4*)V; o.q1 = *(const LAS f32x4*)(V + 4); o.k0 = *(const LAS f32x4*)(V + 128); o.k1 = *(const LAS f32x4*)(V + 132);
    o.v = B[4096 + t * 16 + vidx]; o.sc = *(const LAS f32x4*)(B + 4352 + t * 4); return o;
}
template <int TB> __device__ __forceinline__ void gdn_block(f32x2 (&S)[4], const LAS float* B, int kq, int vidx, float* oo) {
    float okeep = 0.f;
    GOps c = g_ld(B, 0, kq, vidx);
#pragma unroll 1
    for (int t0 = 0; t0 < TB; t0 += SCAN_UNR)
#pragma unroll
    for (int tt = 0; tt < SCAN_UNR; ++tt) {
        const int t = t0 + tt;
        GOps n = g_ld(B, (t + 1) & 15, kq, vidx);
        const f32x2 k[4] = {{c.k0.x, c.k0.y}, {c.k0.z, c.k0.w}, {c.k1.x, c.k1.y}, {c.k1.z, c.k1.w}}, q[4] = {{c.q0.x, c.q0.y}, {c.q0.z, c.q0.w}, {c.q1.x, c.q1.y}, {c.q1.z, c.q1.w}};
        const f32x2 pk = fma2(S[3], k[3], fma2(S[2], k[2], fma2(S[1], k[1], S[0] * k[0]))), pq = fma2(S[3], q[3], fma2(S[2], q[2], fma2(S[1], q[1], S[0] * q[0])));
        const float kts = allsum16(pk.x + pk.y), qts = allsum16(pq.x + pq.y);
        const float alpha = c.sc.x, beta = c.sc.y, qk = c.sc.z;
        const float coef = beta * (c.v - alpha * kts);
        const f32x2 al2 = {alpha, alpha}, cf2 = {coef, coef};
#pragma unroll
        for (int e = 0; e < 4; ++e) S[e] = fma2(al2, S[e], k[e] * cf2);
        const float o = alpha * qts + qk * coef;
        okeep = (kq == t) ? o : okeep;
        c = n;
    }
    if (TB == 16 || kq < TB) oo[(size_t)kq * GW] = okeep;
}
__device__ __forceinline__ float sum8(float x) { x += dppf<0x141>(x); x += dppf<0x4E>(x); x += dppf<0xB1>(x); return x; }
struct ROps8 { f32x4 u[2], a[2], b[2], k[2], w[2]; float v; f32x2 sc; };
__device__ __forceinline__ ROps8 r_ld8(const LAS float* B, int t, int kq, int vidx) {
    ROps8 o; const LAS float* V = B + t * 320 + kq * 8;
#pragma unroll
    for (int h = 0; h < 2; ++h) { o.u[h] = *(const LAS f32x4*)(V + 4 * h); o.a[h] = *(const LAS f32x4*)(V + 64 + 4 * h); o.b[h] = *(const LAS f32x4*)(V + 128 + 4 * h); o.k[h] = *(const LAS f32x4*)(V + 192 + 4 * h); o.w[h] = *(const LAS f32x4*)(V + 256 + 4 * h); }
    o.v = B[5120 + t * 16 + vidx]; o.sc = *(const LAS f32x2*)(B + 5376 + t * 2); return o;
}
#define PAIRS(V_) {{V_[0].x, V_[0].y}, {V_[0].z, V_[0].w}, {V_[1].x, V_[1].y}, {V_[1].z, V_[1].w}}
template <int TB> __device__ __forceinline__ void rwkv_block8(f32x2 (&S)[4], const LAS float* B, int kq, int vidx, float* yo) {
    float ykA = 0.f, ykB = 0.f;
    ROps8 c = r_ld8(B, 0, kq, vidx);
#pragma unroll 1
    for (int t0 = 0; t0 < TB; t0 += SCAN_UNR)
#pragma unroll
    for (int tt = 0; tt < SCAN_UNR; ++tt) {
        const int t = t0 + tt;
        const ROps8 n = r_ld8(B, (t + 1) & 15, kq, vidx);
        const f32x2 a[4] = PAIRS(c.a), w[4] = PAIRS(c.w), u[4] = PAIRS(c.u), b[4] = PAIRS(c.b), k[4] = PAIRS(c.k);
        const f32x2 ps = fma2(S[3], a[3], fma2(S[2], a[2], fma2(S[1], a[1], S[0] * a[0]))), py = fma2(S[3], w[3], fma2(S[2], w[2], fma2(S[1], w[1], S[0] * w[0])));
        const float sa = sum8(ps.x + ps.y), yp = sum8(py.x + py.y);
        const f32x2 sa2 = {sa, sa}, v2 = {c.v, c.v};
#pragma unroll
        for (int e = 0; e < 4; ++e) { S[e] = fma2(-u[e], S[e], S[e]); S[e] = fma2(sa2, b[e], S[e]); S[e] = fma2(v2, k[e], S[e]); }
        const float y = yp + sa * c.sc.x + c.v * c.sc.y;
        ykA = (kq == t) ? y : ykA; ykB = (kq + 8 == t) ? y : ykB;
        c = n;
    }
    yo[(size_t)kq * RW] = ykA;
    if (TB == 16) yo[(size_t)(kq + 8) * RW] = ykB;
}
struct GOps8 { f32x4 q[4], k[4]; float v; f32x4 sc; };
__device__ __forceinline__ GOps8 g_ld8(const LAS float* B, int t, int kq, int vidx) {
    GOps8 o; const LAS float* V = B + t * 256 + kq * 16;
#pragma unroll
    for (int h = 0; h < 4; ++h) { o.q[h] = *(const LAS f32x4*)(V + 4 * h); o.k[h] = *(const LAS f32x4*)(V + 128 + 4 * h); }
    o.v = B[4096 + t * 16 + vidx]; o.sc = *(const LAS f32x4*)(B + 4352 + t * 4); return o;
}
#define PAIRS8(V_) {{V_[0].x, V_[0].y}, {V_[0].z, V_[0].w}, {V_[1].x, V_[1].y}, {V_[1].z, V_[1].w}, {V_[2].x, V_[2].y}, {V_[2].z, V_[2].w}, {V_[3].x, V_[3].y}, {V_[3].z, V_[3].w}}
template <int TB> __device__ __forceinline__ void gdn_block8(f32x2 (&S)[8], const LAS float* B, int kq, int vidx, float* oo) {
    float okA = 0.f, okB = 0.f;
    GOps8 c = g_ld8(B, 0, kq, vidx);
#pragma unroll 1
    for (int t0 = 0; t0 < TB; t0 += SCAN_UNR) {
        float P = 1.f, iP = 1.f;
#pragma unroll
        for (int tt = 0; tt < SCAN_UNR; ++tt) {
            const int t = t0 + tt;
            const GOps8 n = g_ld8(B, (t + 1) & 15, kq, vidx);
            const f32x2 k[8] = PAIRS8(c.k), q[8] = PAIRS8(c.q);
            f32x2 pk = S[0] * k[0], pq = S[0] * q[0];
#pragma unroll
            for (int e = 1; e < 8; ++e) { pk = fma2(S[e], k[e], pk); pq = fma2(S[e], q[e], pq); }
            const float dk = sum8(pk.x + pk.y), dq = sum8(pq.x + pq.y);
            P *= c.sc.x; iP *= c.sc.w;
            const float coef = c.sc.y * (c.v - P * dk);
            const float cs = coef * iP; const f32x2 cf2 = {cs, cs};
#pragma unroll
            for (int e = 0; e < 8; ++e) S[e] = fma2(k[e], cf2, S[e]);
            const float o = P * dq + c.sc.z * coef;
            okA = (kq == t) ? o : okA; okB = (kq + 8 == t) ? o : okB;
            c = n;
        }
        const f32x2 p2 = {P, P};
#pragma unroll
        for (int e = 0; e < 8; ++e) S[e] = S[e] * p2;
    }
    oo[(size_t)kq * GW] = okA;
    if (TB == 16) oo[(size_t)(kq + 8) * GW] = okB;
}
constexpr int SC_NBLK = 128 + 16;
constexpr int RBUF = 16 * 5 * 64 + 16 * 16 + 16 * 2;
constexpr int GBUF = 16 * 2 * 128 + 16 * 16 + 16 * 4;
__device__ __forceinline__ void phase_scan(Ctx& C, int i) {
    PHASE_IDS
    const int w = wave & 1; const bool cw = (wave < 2) || (wave >= 6);
    int sub = lane >> 3, kq = lane & 7, ht = tid & 255;
#define RELAUNDER do { int tl_ = tid; asm volatile("" : "+v"(tl_)); ht = tl_ & 255; sub = (tl_ & 63) >> 3; kq = tl_ & 7; } while (0)
    LAS float* const ldsf = (LAS float*)C.lds;
    if (cw) __builtin_amdgcn_s_setprio(3);
    if (wave < 4) {
        LAS float* const buf0 = ldsf;
        const unsigned char* SCN = C.ws + WS_SCN; const bf16* RV = (const bf16*)(C.ws + WS_RV); const float* RSC = (const float*)(C.ws + WS_RSC);
        float* YRAW = (float*)(C.ws + WS_YRAW);
        v4u st[5]; v4u stv; f32x2 sts; f32x4 Snext = {0.f, 0.f, 0.f, 0.f}, Snext1 = {0.f, 0.f, 0.f, 0.f};
#define R_DESC(blk, m0, tb, head, quarter, b, isprompt) \
        size_t m0; int tb, head, quarter, b; bool isprompt; \
        if ((blk) < 128) { isprompt = true; const int seq = C.bid >> 5; b = seq; head = (C.bid >> 2) & 7; quarter = C.bid & 3; m0 = (size_t)seq * TP + (size_t)(blk) * 16; tb = 16; } \
        else { isprompt = false; const int su = C.bid * 16 + ((blk) - 128); b = su >> 5; head = (su >> 2) & 7; quarter = su & 3; m0 = (size_t)MP + (size_t)b * TS; tb = 8; }
#define R_STAGE_LOAD(blk) do { R_DESC(blk, m0_, tb_, head_, quarter_, b_, ip_) \
        if (!cw) { const int hx = ht & 127; \
        _Pragma("unroll") for (int q = 0; q < 5; ++q) { const int id = hx + 128 * q; const int tok = id / 40, rem = id - tok * 40, vec = rem >> 3, part = rem & 7; \
            if (tok < tb_) st[q] = *(const v4u*)(SCN + (size_t)vec * A17 + ((m0_ + tok) * RW + head_ * 64 + part * 8) * 2); } \
        if (hx < 32) { const int tok = hx >> 1; if (tok < tb_) stv = *(const v4u*)(RV + (m0_ + tok) * RW + head_ * 64 + quarter_ * 16 + (hx & 1) * 8); } \
        else if (hx < 48) { const int tok = hx - 32; if (tok < tb_) sts = *(const f32x2*)(RSC + ((m0_ + tok) * 8 + head_) * 4); } } \
        if (!ip_ && cw) { const float* s0_ = C.in[2] + ((size_t)(i * SB + b_) * RH + head_) * 4096 + (quarter_ * 16 + w * 8 + sub) * 64 + kq * 8; Snext = *(const f32x4*)s0_; Snext1 = *(const f32x4*)(s0_ + 4); } else { Snext = (f32x4){0.f, 0.f, 0.f, 0.f}; Snext1 = Snext; } } while (0)
#define R_STAGE_WRITE(blk) do { LAS float* B = buf0 + ((blk) & 1) * RBUF; \
        if (!cw) { const int hx = ht & 127; \
        _Pragma("unroll") for (int q = 0; q < 5; ++q) { const int id = hx + 128 * q; const int tok = id / 40, rem = id - tok * 40, vec = rem >> 3, part = rem & 7; \
            bf8_to_lds(B + (tok * 5 + vec) * 64 + part * 8, st[q]); } \
        if (hx < 32) bf8_to_lds(B + 5120 + (hx >> 1) * 16 + (hx & 1) * 8, stv); \
        else if (hx < 48) *(LAS f32x2*)(B + 5376 + (hx - 32) * 2) = sts; } } while (0)
        R_STAGE_LOAD(0);
        f32x2 S[4] = {{Snext.x, Snext.y}, {Snext.z, Snext.w}, {Snext1.x, Snext1.y}, {Snext1.z, Snext1.w}};
        R_STAGE_WRITE(0);
        __syncthreads();
#pragma unroll 1
        for (int blk = 0; blk < SC_NBLK; ++blk) {
            RELAUNDER;
            R_DESC(blk, m0, tb, head, quarter, b, isprompt)
            const bool last = isprompt ? (blk == 127) : true;
            if (blk + 1 < SC_NBLK) R_STAGE_LOAD(blk + 1);
            const LAS float* B = buf0 + (blk & 1) * RBUF;
            const int row = quarter * 16 + w * 8 + sub;
            float* yo = YRAW + m0 * RW + head * 64 + row;
            if (cw) {
            if (tb == 16) rwkv_block8<16>(S, B, kq, w * 8 + sub, yo); else rwkv_block8<8>(S, B, kq, w * 8 + sub, yo);
            if (last) {
                float* So = (isprompt ? C.out + O_RWKV_P + ((size_t)(i * NB + b) * RH + head) * 4096 : C.out + O_RWKV_S + ((size_t)(i * SB + b) * RH + head) * 4096);
                *(f32x4*)(So + row * 64 + kq * 8) = (f32x4){S[0].x, S[0].y, S[1].x, S[1].y}; *(f32x4*)(So + row * 64 + kq * 8 + 4) = (f32x4){S[2].x, S[2].y, S[3].x, S[3].y};
                S[0] = (f32x2){Snext.x, Snext.y}; S[1] = (f32x2){Snext.z, Snext.w}; S[2] = (f32x2){Snext1.x, Snext1.y}; S[3] = (f32x2){Snext1.z, Snext1.w};
            }
            }
            if (blk + 1 < SC_NBLK) R_STAGE_WRITE(blk + 1);
            __syncthreads();
        }
#undef R_DESC
#undef R_STAGE_LOAD
#undef R_STAGE_WRITE
    } else {
        LAS float* const buf0 = ldsf + 2 * RBUF;
        const bf16* GQ = (const bf16*)(C.ws + WS_GQ); const bf16* GV = (const bf16*)(C.ws + WS_GV); const float* GSC = (const float*)(C.ws + WS_GSC);
        float* ORAW = (float*)(C.ws + WS_ORAW);
        v4u st[4]; v4u stv; f32x4 sts; float Snext[16];
#pragma unroll
        for (int e = 0; e < 16; ++e) Snext[e] = 0.f;
#define G_DESC(blk, m0, tb, head, cgp, b, isprompt) \
        size_t m0; int tb, head, cgp, b; bool isprompt; \
        if ((blk) < 128) { isprompt = true; const int seq = C.bid >> 5; b = seq; head = (C.bid >> 3) & 3; cgp = C.bid & 7; m0 = (size_t)seq * TP + (size_t)(blk) * 16; tb = 16; } \
        else { isprompt = false; const int su = C.bid * 16 + ((blk) - 128); b = su >> 5; head = (su >> 3) & 3; cgp = su & 7; m0 = (size_t)MP + (size_t)b * TS; tb = 8; }
#define G_STAGE_LOAD(blk) do { G_DESC(blk, m0_, tb_, head_, cgp_, b_, ip_) \
        if (!cw) { const int hx = ht & 127; \
        _Pragma("unroll") for (int q = 0; q < 4; ++q) { const int id = hx + 128 * q; const int tok = id >> 5, vec = (id >> 4) & 1, part = id & 15; \
            if (tok < tb_) st[q] = *(const v4u*)(GQ + (size_t)vec * (A17 / 2) + (m0_ + tok) * GW + head_ * 128 + part * 8); } \
        if (hx < 32) { const int tok = hx >> 1; if (tok < tb_) stv = *(const v4u*)(GV + (m0_ + tok) * GW + head_ * 128 + cgp_ * 16 + (hx & 1) * 8); } \
        else if (hx < 48) { const int tok = hx - 32; if (tok < tb_) sts = *(const f32x4*)(GSC + ((m0_ + tok) * 4 + head_) * 4); } } \
        if (!ip_ && cw) { const float* S0 = C.in[4] + ((size_t)(i * SB + b_) * GH + head_) * 16384 + cgp_ * 16 + w * 8 + sub; \
            _Pragma("unroll") for (int e = 0; e < 16; ++e) Snext[e] = S0[(size_t)(kq * 16 + e) * 128]; } \
        else { _Pragma("unroll") for (int e = 0; e < 16; ++e) Snext[e] = 0.f; } } while (0)
#define G_STAGE_WRITE(blk) do { LAS float* B = buf0 + ((blk) & 1) * GBUF; \
        if (!cw) { const int hx = ht & 127; \
        _Pragma("unroll") for (int q = 0; q < 4; ++q) { const int id = hx + 128 * q; const int tok = id >> 5, vec = (id >> 4) & 1, part = id & 15; \
            bf8_to_lds(B + (tok * 2 + vec) * 128 + part * 8, st[q]); } \
        if (hx < 32) bf8_to_lds(B + 4096 + (hx >> 1) * 16 + (hx & 1) * 8, stv); \
        else if (hx < 48) *(LAS f32x4*)(B + 4352 + (hx - 32) * 4) = sts; } } while (0)
        G_STAGE_LOAD(0);
        f32x2 S[8];
#pragma unroll
        for (int e = 0; e < 8; ++e) S[e] = (f32x2){Snext[2 * e], Snext[2 * e + 1]};
        G_STAGE_WRITE(0);
        __syncthreads();
#pragma unroll 1
        for (int blk = 0; blk < SC_NBLK; ++blk) {
            RELAUNDER;
            G_DESC(blk, m0, tb, head, cgp, b, isprompt)
            const bool last = isprompt ? (blk == 127) : true;
            if (blk + 1 < SC_NBLK) G_STAGE_LOAD(blk + 1);
            const LAS float* B = buf0 + (blk & 1) * GBUF;
            const int col = cgp * 16 + w * 8 + sub;
            float* oo = ORAW + m0 * GW + head * 128 + col;
            if (cw) {
            if (tb == 16) gdn_block8<16>(S, B, kq, w * 8 + sub, oo); else gdn_block8<8>(S, B, kq, w * 8 + sub, oo);
            if (last) {
                float* So = (isprompt ? C.out + O_GDN_P + ((size_t)(i * NB + b) * GH + head) * 16384 : C.out + O_GDN_S + ((size_t)(i * SB + b) * GH + head) * 16384) + col;
#pragma unroll
                for (int e = 0; e < 8; ++e) { So[(size_t)(kq * 16 + 2 * e) * 128] = S[e].x; So[(size_t)(kq * 16 + 2 * e + 1) * 128] = S[e].y; S[e] = (f32x2){Snext[2 * e], Snext[2 * e + 1]}; }
            }
            }
            if (blk + 1 < SC_NBLK) G_STAGE_WRITE(blk + 1);
            __syncthreads();
        }
#undef G_DESC
#undef G_STAGE_LOAD
#undef G_STAGE_WRITE
    }
    __builtin_amdgcn_s_setprio(0);
}

__device__ __forceinline__ void phase_post(Ctx& C, int i) {
    PHASE_IDS
    const int gw = C.bid * NWAVES + wave, NGW = C.G * NWAVES;
    const float* YRAW = (const float*)(C.ws + WS_YRAW); const float* ORAW = (const float*)(C.ws + WS_ORAW);
    const bf16* RV = (const bf16*)(C.ws + WS_RV); const bf16* RG = (const bf16*)(C.ws + WS_RG); const float* RSC = (const float*)(C.ws + WS_RSC); const bf16* GZ = (const bf16*)(C.ws + WS_GZ);
    bf16* YM = (bf16*)(C.ws + WS_XN);
    const float* lnwp = C.in[22] + i * RW + lane * 8; const float* lnbp = C.in[23] + i * RW + lane * 8; const float* gnwp = C.in[27] + i * GHD + (lane & 15) * 8;
    float lnw[8], lnb[8], gnw[8];
#pragma unroll
    for (int e = 0; e < 8; ++e) { lnw[e] = lnwp[e]; lnb[e] = lnbp[e]; gnw[e] = gnwp[e]; }
    for (int m = gw; m < M; m += NGW) {
        const size_t mm = (size_t)m;
        const f32x4 y0 = *(const f32x4*)(YRAW + mm * RW + lane * 8), y1 = *(const f32x4*)(YRAW + mm * RW + lane * 8 + 4);
        const f32x4 o0 = *(const f32x4*)(ORAW + mm * GW + lane * 8), o1 = *(const f32x4*)(ORAW + mm * GW + lane * 8 + 4);
        const v4u vv = *(const v4u*)(RV + mm * RW + lane * 8), gg = *(const v4u*)(RG + mm * RW + lane * 8), zz = *(const v4u*)(GZ + mm * GW + lane * 8);
        const float rk = RSC[(mm * 8 + (lane >> 3)) * 4 + 2];
        float y[8] = {y0.x, y0.y, y0.z, y0.w, y1.x, y1.y, y1.z, y1.w}, v[8], g[8], o[8];
        unpack8(vv, v); unpack8(gg, g);
        float s = ((y[0] + y[1]) + (y[2] + y[3])) + ((y[4] + y[5]) + (y[6] + y[7]));
        const float mean = sum8(s) * (1.f / 64.f); float q = 0.f;
#pragma unroll
        for (int e = 0; e < 8; ++e) { y[e] -= mean; q += y[e] * y[e]; }
        const float rstd = rsqrtf(sum8(q) * (1.f / 64.f) + 64e-5f);
#pragma unroll
        for (int e = 0; e < 8; ++e) o[e] = (y[e] * rstd * lnw[e] + lnb[e] + rk * v[e]) * g[e];
        *(v4u*)(YM + mm * D + lane * 8) = pack8(o);
        float z[8]; unpack8(zz, z);
        float x[8] = {o0.x, o0.y, o0.z, o0.w, o1.x, o1.y, o1.z, o1.w}; float q2 = 0.f;
#pragma unroll
        for (int e = 0; e < 8; ++e) q2 += x[e] * x[e];
        const float rs = rsqrtf(allsum16(q2) * (1.f / 128.f) + 1e-6f);
#pragma unroll
        for (int e = 0; e < 8; ++e) o[e] = x[e] * rs * gnw[e] * z[e];
        *(v4u*)(YM + mm * D + 512 + lane * 8) = pack8(o);
    }
}

constexpr int XS = 1032;
__device__ __forceinline__ void phase_lru_prep(Ctx& C, int i) {
    PHASE_IDS
    LAS bf16* xc = (LAS bf16*)C.lds;
    const bf16* PO = (const bf16*)(C.ws + WS_PROJ);
    bf16* LP = (bf16*)(C.ws + WS_LP); bf16* LH = (bf16*)(C.ws + WS_LH); float* LT = (float*)(C.ws + WS_LTOT);
    const bf16* WA = (const bf16*)(C.ws + WS_WA) + wave * 16384; const bf16* WI = (const bf16*)(C.ws + WS_WI) + wave * 16384;
    const float* cw = C.in[30] + (size_t)i * 4 * D; const float* cb = C.in[31] + i * D;
    const float* ba = C.in[33] + i * D; const float* bi = C.in[35] + i * D; const float* Lp = C.in[36] + i * D;
    const int fr = lane & 15, fq = lane >> 4, h = wave;
    LAS float* CSTL = (LAS float*)(C.lds + 67584);
    for (int c = tid; c < D; c += NTHR) { CSTL[c] = ba[c]; CSTL[D + c] = bi[c]; CSTL[2 * D + c] = softplusf_(-Lp[c]); }
    for (int tile = C.bid; tile < M / 32; tile += C.G) {
        const int m0 = tile * 32; const bool prompt = m0 < MP;
        const bf16* P = PO + (size_t)m0 * 2048;
        bf16x8 Bc[4][2];
#pragma unroll
        for (int ks = 0; ks < 4; ++ks) { Bc[ks][0] = *(const bf16x8*)(WA + fr * 128 + ks * 32 + fq * 8); Bc[ks][1] = *(const bf16x8*)(WI + fr * 128 + ks * 32 + fq * 8); }
        {
            const int rg = tid >> 7;
            const bool seqstart = prompt ? (((m0 & (TP - 1)) == 0) && rg == 0) : true;
#pragma unroll 1
            for (int hh = 0; hh < 2; ++hh) {
                const int c0 = (tid & 127) * 8 + hh * 4;
                float xr[11][4];
#pragma unroll
                for (int r = 0; r < 11; ++r) { const int tr = rg * 8 - 3 + r;
                    if (r >= 3 || !seqstart) { const v2u w = *(const v2u*)(P + (ptrdiff_t)tr * 2048 + 1024 + c0); xr[r][0] = bflo(w.x); xr[r][1] = bfhi(w.x); xr[r][2] = bflo(w.y); xr[r][3] = bfhi(w.y); }
                    else if (prompt) { xr[r][0] = 0.f; xr[r][1] = 0.f; xr[r][2] = 0.f; xr[r][3] = 0.f; }
                    else { const f32x4 a = *(const f32x4*)(C.in[7] + ((size_t)i * SB + ((m0 - MP) >> 3) + rg) * 3 * D + r * D + c0); xr[r][0] = a.x; xr[r][1] = a.y; xr[r][2] = a.z; xr[r][3] = a.w; } }
                const f32x4 t0 = *(const f32x4*)(cw + c0), t1 = *(const f32x4*)(cw + D + c0), t2 = *(const f32x4*)(cw + 2 * D + c0), t3 = *(const f32x4*)(cw + 3 * D + c0), bs = *(const f32x4*)(cb + c0);
#pragma unroll
                for (int t8 = 0; t8 < 8; ++t8) { float y[4];
#pragma unroll
                    for (int e = 0; e < 4; ++e) y[e] = t0[e] * xr[t8][e] + t1[e] * xr[t8 + 1][e] + t2[e] * xr[t8 + 2][e] + t3[e] * xr[t8 + 3][e] + bs[e];
                    v2u o; o.x = pk2(y[0], y[1]); o.y = pk2(y[2], y[3]);
                    *(LAS v2u*)(xc + (rg * 8 + t8) * XS + c0) = o; }
            }
        }
        __syncthreads();
#pragma unroll
        for (int nt = 0; nt < 8; ++nt) {
            pg8::f32x4 aa[2] = {{0.f, 0.f, 0.f, 0.f}, {0.f, 0.f, 0.f, 0.f}}, ai[2] = {{0.f, 0.f, 0.f, 0.f}, {0.f, 0.f, 0.f, 0.f}};
            bf16x8 Bn[4][2];
            if (nt + 1 < 8) {
#pragma unroll
                for (int ks = 0; ks < 4; ++ks) { Bn[ks][0] = *(const bf16x8*)(WA + ((nt + 1) * 16 + fr) * 128 + ks * 32 + fq * 8); Bn[ks][1] = *(const bf16x8*)(WI + ((nt + 1) * 16 + fr) * 128 + ks * 32 + fq * 8); } }
#pragma unroll
            for (int ks = 0; ks < 4; ++ks) {
                const bf16x8 bfa = Bc[ks][0], bfi = Bc[ks][1];
#pragma unroll
                for (int mt = 0; mt < 2; ++mt) { const bf16x8 af = *(const LAS bf16x8*)(xc + (mt * 16 + fr) * XS + h * 128 + ks * 32 + fq * 8);
                    aa[mt] = __builtin_amdgcn_mfma_f32_16x16x32_bf16(af, bfa, aa[mt], 0, 0, 0); ai[mt] = __builtin_amdgcn_mfma_f32_16x16x32_bf16(af, bfi, ai[mt], 0, 0, 0); }
            }
            const int ch = h * 128 + nt * 16 + fr;
            const float bac = CSTL[ch], bic = CSTL[D + ch], spl = CSTL[2 * D + ch];
            float IA[2][4], IB[2][4], GA[2], GB[2], EA[2], EB[2];
#pragma unroll
            for (int mt = 0; mt < 2; ++mt) {
                float pa = 1.f, pb = 0.f;
#pragma unroll
                for (int j = 0; j < 4; ++j) {
                    const int tok = mt * 16 + fq * 4 + j; const float xv = bf2f(xc[tok * XS + ch]);
                    const float r = sigmoidf_(aa[mt][j] + bac), ig = sigmoidf_(ai[mt][j] + bic);
                    const float la = -8.0f * r * spl; const float A = __expf(la); const float x2 = 2.0f * la;
                    const float om_s = -x2 * (1.0f + x2 * (0.5f + x2 * (0.16666667f + x2 * (0.041666668f + x2 * 0.008333334f))));
                    const float om = (x2 > -0.25f) ? om_s : (1.0f - A * A); const float mult = __builtin_amdgcn_sqrtf(fmaxf(om, 0.f)); const float B = mult * ig * xv;
                    pb = A * pb + B; pa = pa * A; IA[mt][j] = pa; IB[mt][j] = pb;
                }
                float ga = pa, gb = pb;
                { const float qa = __shfl_up(ga, 16), qb = __shfl_up(gb, 16); const bool doit = prompt ? (fq >= 1) : ((fq & 1) != 0); if (doit) { gb = ga * qb + gb; ga = qa * ga; } }
                { const float qa = __shfl_up(ga, 32), qb = __shfl_up(gb, 32); if (prompt && fq >= 2) { gb = ga * qb + gb; ga = qa * ga; } }
                GA[mt] = ga; GB[mt] = gb;
                { const float qa = __shfl_up(ga, 16), qb = __shfl_up(gb, 16); const bool doit = prompt ? (fq >= 1) : ((fq & 1) != 0); EA[mt] = doit ? qa : 1.f; EB[mt] = doit ? qb : 0.f; }
            }
            { const float ta = __shfl(GA[0], fr + 48), tb = __shfl(GB[0], fr + 48); if (prompt) { EB[1] = EA[1] * tb + EB[1]; EA[1] = ta * EA[1]; } }
#pragma unroll
            for (int mt = 0; mt < 2; ++mt)
#pragma unroll
                for (int j = 0; j < 4; ++j) { const size_t m = (size_t)(m0 + mt * 16 + fq * 4 + j);
                    const float Pv = EA[mt] * IA[mt][j], Hv = IA[mt][j] * EB[mt] + IB[mt][j];
                    LP[m * D + ch] = (bf16)f2bf(Pv); LH[m * D + ch] = (bf16)f2bf(Hv);
                    if (mt == 1 && j == 3 && fq == 3) *(f32x2*)(LT + ((size_t)tile * D + ch) * 2) = (f32x2){Pv, Hv}; }
            if (nt + 1 < 8) {
#pragma unroll
                for (int ks = 0; ks < 4; ++ks) { Bc[ks][0] = Bn[ks][0]; Bc[ks][1] = Bn[ks][1]; } }
            asm volatile("" ::: "memory");
        }
        if (prompt) { if ((m0 & (TP - 1)) == TP - 32) { float* o = C.out + O_LC_P + ((size_t)i * NB + (m0 >> 11)) * 3 * D;
                for (int e = tid; e < 3 * D; e += NTHR) { const int j = e >> 10, cc = e & 1023; o[e] = bf2f(P[(29 + j) * 2048 + 1024 + cc]); } } }
        else { for (int e = tid; e < 4 * 3 * D; e += NTHR) { const int s = e / (3 * D), r = e - s * 3 * D, j = r >> 10, cc = r & 1023;
                C.out[O_LC_S + ((size_t)i * SB + ((m0 - MP) >> 3) + s) * 3 * D + r] = bf2f(P[(s * 8 + 5 + j) * 2048 + 1024 + cc]); } }
        __syncthreads();
    }
}

__device__ __forceinline__ float gelu_tanh(float x) { const float u = 0.7978845608028654f * (x + 0.044715f * x * x * x); return 0.5f * x * (1.0f + tanhf_(u)); }

__device__ __forceinline__ void phase_lru_fin(Ctx& C, int i) {
    PHASE_IDS
    LAS float* X = (LAS float*)C.lds;
    const bf16* PO = (const bf16*)(C.ws + WS_PROJ);
    const bf16* LP = (const bf16*)(C.ws + WS_LP); const bf16* LH = (const bf16*)(C.ws + WS_LH); const float* LT = (const float*)(C.ws + WS_LTOT);
    bf16* YM = (bf16*)(C.ws + WS_XN);
    const int rg = tid >> 7, cg = tid & 127, c0 = cg * 8;
    for (int unit = C.bid; unit < M / 16; unit += C.G) {
        const int m0 = unit * 16; const bool prompt = m0 < MP; const int tile = m0 >> 5;
        float carry[8];
        if (prompt) {
            const int tt0 = (m0 >> 11) * 64, n = tile - tt0, per = (n + 3) >> 2; const int lo = tt0 + rg * per; const int hi = (lo + per < tile) ? lo + per : tile;
            float A[8], B[8];
#pragma unroll
            for (int e = 0; e < 8; ++e) { A[e] = 1.f; B[e] = 0.f; }
#pragma unroll 4
            for (int tt = lo; tt < hi; ++tt) { const float* p = LT + ((size_t)tt * D + c0) * 2;
                const f32x4 v0 = *(const f32x4*)p, v1 = *(const f32x4*)(p + 4), v2 = *(const f32x4*)(p + 8), v3 = *(const f32x4*)(p + 12);
                const float P[8] = {v0.x, v0.z, v1.x, v1.z, v2.x, v2.z, v3.x, v3.z}, H[8] = {v0.y, v0.w, v1.y, v1.w, v2.y, v2.w, v3.y, v3.w};
#pragma unroll
                for (int e = 0; e < 8; ++e) { B[e] = P[e] * B[e] + H[e]; A[e] *= P[e]; } }
            LAS float* xp = X + (rg * 128 + cg) * 16;
            *(LAS f32x4*)xp = (f32x4){A[0], A[1], A[2], A[3]}; *(LAS f32x4*)(xp + 4) = (f32x4){A[4], A[5], A[6], A[7]};
            *(LAS f32x4*)(xp + 8) = (f32x4){B[0], B[1], B[2], B[3]}; *(LAS f32x4*)(xp + 12) = (f32x4){B[4], B[5], B[6], B[7]};
            __syncthreads();
#pragma unroll
            for (int e = 0; e < 8; ++e) carry[e] = 0.f;
#pragma unroll
            for (int q = 0; q < 4; ++q) { const LAS float* xq = X + (q * 128 + cg) * 16;
                const f32x4 a0 = *(const LAS f32x4*)xq, a1 = *(const LAS f32x4*)(xq + 4), b0 = *(const LAS f32x4*)(xq + 8), b1 = *(const LAS f32x4*)(xq + 12);
                carry[0] = a0.x * carry[0] + b0.x; carry[1] = a0.y * carry[1] + b0.y; carry[2] = a0.z * carry[2] + b0.z; carry[3] = a0.w * carry[3] + b0.w;
                carry[4] = a1.x * carry[4] + b1.x; carry[5] = a1.y * carry[5] + b1.y; carry[6] = a1.z * carry[6] + b1.z; carry[7] = a1.w * carry[7] + b1.w; }
        } else {
            const float* hp = C.in[6] + ((size_t)i * SB + ((m0 - MP) >> 3) + (rg >> 1)) * D + c0;
            const f32x4 h0 = *(const f32x4*)hp, h1 = *(const f32x4*)(hp + 4);
            carry[0] = h0.x; carry[1] = h0.y; carry[2] = h0.z; carry[3] = h0.w; carry[4] = h1.x; carry[5] = h1.y; carry[6] = h1.z; carry[7] = h1.w;
        }
#pragma unroll
        for (int t4 = 0; t4 < 4; ++t4) {
            const size_t m = (size_t)(m0 + rg * 4 + t4);
            float lh[8], lp[8], gt[8], y[8], hv[8];
            unpack8(*(const v4u*)(LH + m * D + c0), lh); unpack8(*(const v4u*)(LP + m * D + c0), lp); unpack8(*(const v4u*)(PO + m * 2048 + c0), gt);
#pragma unroll
            for (int e = 0; e < 8; ++e) { hv[e] = lh[e] + lp[e] * carry[e]; y[e] = hv[e] * gelu_tanh(gt[e]); }
            *(v4u*)(YM + m * D + c0) = pack8(y);
            const bool lastp = prompt && ((m & (TP - 1)) == TP - 1), lasts = !prompt && (((m - MP) & 7) == 7);
            if (lastp || lasts) { float* o = lastp ? C.out + O_LRU_P + ((size_t)i * NB + (m >> 11)) * D + c0 : C.out + O_LRU_S + ((size_t)i * SB + ((m - MP) >> 3)) * D + c0;
                *(f32x4*)o = (f32x4){hv[0], hv[1], hv[2], hv[3]}; *(f32x4*)(o + 4) = (f32x4){hv[4], hv[5], hv[6], hv[7]}; }
        }
        if (prompt) __syncthreads();
    }
}

__global__ void __launch_bounds__(NTHR, 2) hybrid_fwd(Args args) {
    extern __shared__ __attribute__((aligned(16))) unsigned char lds_raw[];
    cg::grid_group grid = cg::this_grid();
    Ctx C;
    C.lds = (LAS unsigned char*)lds_raw; C.in = args.in; C.out = args.out; C.ws = args.ws;
    C.bid = blockIdx.x; C.G = gridDim.x;
    const int lo = args.ph_lo, hi = args.ph_hi;
    volatile LAS unsigned* MISC = (volatile LAS unsigned*)(C.lds + MISC_OFF);
    if (threadIdx.x < 2) MISC[threadIdx.x] = 0u;
    __syncthreads();
    XcdBarrier xbar = xcd_barrier_post((unsigned*)(C.ws + WS_CTL), MISC);
    if (lo < 0) grid.sync();
#define GRID_BAR() xcd_barrier(xbar)
    int ph = 0;
    for (int es_ = 0; es_ < EXTRA_SYNCS; ++es_) GRID_BAR();
#define PH_BEGIN if (ph >= lo && ph < hi) { const int nrep_ = ((DUPMASK >> ph) & 1ull) ? 2 : 1; for (int rep_ = 0; rep_ < nrep_; ++rep_) { if (rep_) GRID_BAR();
#ifdef NOSYNC
#define PH_END } } ++ph;
#else
#define PH_END   } if (ph + 1 < hi) GRID_BAR(); } ++ph;
#endif
    bf16* XN = (bf16*)(C.ws + WS_XN); bf16* PROJ = (bf16*)(C.ws + WS_PROJ); bf16* HID = (bf16*)(C.ws + WS_HID);
    bf16* WIN = (bf16*)(C.ws + WS_WIN); bf16* WOUT = (bf16*)(C.ws + WS_WOUT); bf16* WUP = (bf16*)(C.ws + WS_WUP); bf16* WDN = (bf16*)(C.ws + WS_WDN);
#pragma unroll 1
    for (int l = 0; l < DEPTH; ++l) {
        const int i = l >> 1; const bool even = (l & 1) == 0;
        PH_BEGIN

#ifndef SKIP_CONV
phase_convert(C, l);
#endif

            __syncthreads();
            if (l == 0) phase_norm<true, true>(C, args.in[8] + l * D, args.in[11] + (size_t)i * D * EPROJ + 3840, EPROJ, 0);
            else if (even) phase_norm<false, true>(C, args.in[8] + l * D, args.in[11] + (size_t)i * D * EPROJ + 3840, EPROJ, 16);
            else phase_norm<false, false>(C, args.in[8] + l * D, nullptr, 0, 16);
            __syncthreads();
        PH_END
        if (even) {

#ifndef SKIP_G1
PH_BEGIN { pg8::Gemm g{XN, WIN, M, 3840, D}; ProjAOrder S; S.init(C.G, C.bid); EpiProjA E{PROJ}; pg8::gemm_phase<EpiProjA, ProjAOrder, true, true>(C.lds, g, S, E); } PH_END
#endif

            PH_BEGIN
#ifndef SKIP_RPREP
phase_rwkv_prep(C, i); __syncthreads();
#endif
 PH_END

#ifndef SKIP_G2
PH_BEGIN { pg8::EpiBf16<0> E{PROJ, GPR, nullptr, 0, 0, 1.f}; pg8::Gemm g{XN, WIN + (size_t)RPROJ * D, MP, GPR, D}; pg8::StaticOrder S; S.init(MP, GPR, C.G, C.bid, D);
              pg8::gemm_phase<pg8::EpiBf16<0>, pg8::StaticOrder, true, true>(C.lds, g, S, E); } PH_END
#endif

            PH_BEGIN
#ifndef SKIP_GPREP
phase_gdn_prep(C, i); __syncthreads();
#endif
 PH_END
            PH_BEGIN
#ifndef SKIP_SCAN
phase_scan(C, i);
#endif
 PH_END
            PH_BEGIN
#ifndef SKIP_POST
phase_post(C, i);
#endif
 PH_END
        } else {

#ifndef SKIP_G3
PH_BEGIN { pg8::EpiBf16<0> E{PROJ, 2048, nullptr, 0, 0, 1.f}; run_gemm(C, XN, WIN, 2048, D, E); } PH_END
#endif

            PH_BEGIN
#ifndef SKIP_LPREP
phase_lru_prep(C, i);
#endif
 PH_END
            PH_BEGIN
#ifndef SKIP_LFIN
phase_lru_fin(C, i);
#endif
 PH_END
        }

#ifndef SKIP_GOUT
PH_BEGIN run_gemm_res(C, XN, WOUT, D, 4, l == 0 ? args.in[0] : nullptr); PH_END
#endif

        PH_BEGIN phase_norm<false, false>(C, args.in[9] + l * D, nullptr, 0, 4); PH_END

#ifndef SKIP_GUP
PH_BEGIN { pg8::EpiBf16<2> E{HID, FF, nullptr, 0, 0, 1.f}; run_gemm(C, XN, WUP, FF, D, E); } PH_END
#endif


#ifndef SKIP_GDN
PH_BEGIN run_gemm_res(C, HID, WDN, FF, 16, nullptr); PH_END
#endif

    }
    PH_BEGIN phase_final(C); PH_END
#undef PH_BEGIN
#undef PH_END
}
constexpr int NPHASES = 2 * (11 + 8) + 1;

#ifndef N_LAUNCH_MODE
#define N_LAUNCH_MODE 1
#endif

extern "C" void kernel_launch(void* const* d_in, const int* in_sizes, int n_in, void* d_out, int out_size, void* d_ws, size_t ws_size, hipStream_t stream) {
    static int grid = 0;
    if (grid == 0) {
        if (n_in != 39 || out_size != (int)O_END || ws_size < WS_TOTAL) { fprintf(stderr, "kernel_launch: unexpected shapes: n_in %d out %d ws %zu (need %zu)\n", n_in, out_size, ws_size, (size_t)WS_TOTAL); grid = -1; return; }
        int dev = 0, cus = 0, per_cu = 0;
        hipGetDevice(&dev); hipDeviceGetAttribute(&cus, hipDeviceAttributeMultiprocessorCount, dev);
        hipFuncSetAttribute((const void*)hybrid_fwd, hipFuncAttributeMaxDynamicSharedMemorySize, LDS_BYTES);
        hipOccupancyMaxActiveBlocksPerMultiprocessor(&per_cu, (const void*)hybrid_fwd, NTHR, LDS_BYTES);
        if (per_cu < 1) { fprintf(stderr, "kernel_launch: occupancy query says %d blocks per CU\n", per_cu); per_cu = 1; }
        (void)hipGetLastError();
        grid = cus;
    }
    if (grid < 0) return;
    if (hipMemsetAsync((char*)d_ws + WS_CTL, 0, CTL_BYTES, stream) != hipSuccess) { fprintf(stderr, "kernel_launch: memset of the barrier words failed\n"); return; }
    Args a{};
    for (int k = 0; k < 39; ++k) a.in[k] = (const float*)d_in[k];
    a.out = (float*)d_out; a.ws = (unsigned char*)d_ws;
#if N_LAUNCH_MODE == 1
    a.ph_lo = 0; a.ph_hi = NPHASES;
    void* kargs[] = {&a};
    hipError_t e = hipLaunchCooperativeKernel((const void*)hybrid_fwd, dim3(grid), dim3(NTHR), kargs, LDS_BYTES, stream);
    if (e != hipSuccess) fprintf(stderr, "cooperative launch failed: %s (grid %d)\n", hipGetErrorString(e), grid);
#else
    for (int p = 0; p < NPHASES; ++p) { a.ph_lo = p; a.ph_hi = p + 1; hipLaunchKernelGGL(hybrid_fwd, dim3(grid), dim3(NTHR), LDS_BYTES, stream, a); }
#endif
}
```
